# Optimizing an MI355X kernel written in HIP

```python
import math
import jax, jax.numpy as jnp
from jax import lax
import numpy as np

D_MODEL = 1024
BATCH = 8
SEQ = 4096
DEPTH = 1

GRID_W = 64
CTX_LEN = 256
NORM_EPS = 1e-6

N_HEADS = 8
HEAD_DIM = 64
V_DIM = 2 * HEAD_DIM
ATTN_QK_W = N_HEADS * 2 * HEAD_DIM
ATTN_V_W = N_HEADS * V_DIM
ROPE_AXIS_DIM = HEAD_DIM // 2
ROPE_THETA = 10000.0
Q_BLOCK = 128

HYENA_W = 1024
HYENA_ORDER = 2
FILTER_EMB = 33
FILTER_BANDS = (FILTER_EMB - 1) // 2
FILTER_HIDDEN = 64
DECAY_TARGET = 1e-2
FAST_DECAY_PCT = 0.3
SLOW_DECAY_PCT = 1.5

K_OFF = 0
V_OFF = K_OFF + ATTN_QK_W
Q_OFF = V_OFF + ATTN_V_W
HY_OFF = Q_OFF + ATTN_QK_W
GATE_OFF = HY_OFF + 3 * HYENA_W
IN_W = GATE_OFF + 2 * D_MODEL

N_EXPERTS = 64
N_GROUPS = 8
TOPK_GROUPS = 4
TOP_K = 8
EXPERT_HIDDEN = 256
SHARED_HIDDEN = 256
ROUTED_SCALE = 2.5
MOE_BLOCK = 128

kernel_name = "hybrid_diffattn_hyena_moe_dit"


def rmsnorm(x, g):
    xf = x.astype(jnp.float32)
    y = xf * lax.rsqrt(jnp.mean(xf * xf, axis=-1, keepdims=True) + NORM_EPS)
    return (y * g.astype(jnp.float32)).astype(x.dtype)


def adaln(cond, w, b, n_chunks):
    m = jax.nn.silu(cond) @ w[:, :n_chunks * D_MODEL] + b[:n_chunks * D_MODEL]
    return jnp.split(m[..., None, :], n_chunks, axis=-1)


def modulate(h, shift, scale):
    return h * (1 + scale) + shift


def rope_2d(rows):
    f32 = jnp.float32
    row = jnp.repeat(jnp.arange(rows), GRID_W).astype(f32)
    col = jnp.tile(jnp.arange(GRID_W), rows).astype(f32)
    inv = ROPE_THETA ** (-jnp.arange(0, ROPE_AXIS_DIM, 2, dtype=f32) / ROPE_AXIS_DIM)
    ang = jnp.stack([row[:, None] * inv, col[:, None] * inv], axis=1)
    return jnp.cos(ang), jnp.sin(ang)


def apply_rope_2d(x, cos, sin):
    L = x.shape[1]
    xa = x.reshape(*x.shape[:-1], 2, 2, ROPE_AXIS_DIM // 2)
    x1, x2 = xa[..., 0, :], xa[..., 1, :]
    c = cos[None, :, None, None]
    s = sin[None, :, None, None]
    out = jnp.stack([x1 * c - x2 * s, x2 * c + x1 * s], axis=-2)
    return out.reshape(x.shape).astype(x.dtype)


def qk_heads(p):
    return p.reshape(*p.shape[:-1], N_HEADS, 2, HEAD_DIM)


def v_heads(p):
    return p.reshape(*p.shape[:-1], N_HEADS, V_DIM)


def diff_attend(q, k, v, lam):
    s = jnp.einsum('bqhmd,bkhmd->bhmqk', q, k).astype(jnp.float32) * (HEAD_DIM ** -0.5)
    p = jax.nn.softmax(s, axis=-1)
    a = p[:, :, 0] - lam * p[:, :, 1]
    return jnp.einsum('bhqk,bkhe->bqhe', a.astype(v.dtype), v)


def diff_attention_blocked(q, k_all, v_all, lam):
    B, L = q.shape[:2]
    nb = L // Q_BLOCK
    qb = jnp.moveaxis(q.reshape(B, nb, Q_BLOCK, *q.shape[2:]), 1, 0)
    o = lax.map(lambda qq: diff_attend(qq, k_all, v_all, lam), qb)
    return jnp.moveaxis(o, 0, 1).reshape(B, L, N_HEADS, V_DIM)


def diff_sub_norm(o, g, lam_init):
    o = rmsnorm(o, g) * (1 - lam_init)
    return o.reshape(*o.shape[:-2], N_HEADS * V_DIM)


def implicit_filters(n, w1, b1, freq, w2, b2, w3):
    f32 = jnp.float32
    pos = jnp.arange(n, dtype=f32)[:, None]
    t = jnp.linspace(0.0, 1.0, n, dtype=f32)[:, None]
    w = 2 * math.pi * pos / n
    bands = jnp.linspace(1e-4, FILTER_BANDS - 1, FILTER_BANDS, dtype=f32)
    z = jnp.concatenate([t, jnp.cos(bands * w), -jnp.sin(bands * w)], axis=-1)
    fr = freq.astype(f32)
    hdn = jnp.sin(fr * (z @ w1.astype(f32) + b1.astype(f32)))
    hdn = jnp.sin(fr * (hdn @ w2.astype(f32) + b2.astype(f32)))
    h = (hdn @ w3.astype(f32)).reshape(n, HYENA_ORDER, 2, HYENA_W)
    deltas = jnp.abs(jnp.linspace(math.log(DECAY_TARGET) / SLOW_DECAY_PCT,
                                  math.log(DECAY_TARGET) / FAST_DECAY_PCT, HYENA_W, dtype=f32))
    h = h * jnp.exp(-t[:, :, None, None] * deltas)
    kern = jnp.concatenate([h[:, :, 0], jnp.zeros((1, HYENA_ORDER, HYENA_W), f32), h[:0:-1, :, 1]], axis=0)
    return kern / jnp.sum(jnp.abs(kern), axis=0, keepdims=True)


def long_conv(z, kern, bias):
    n = z.shape[1]
    zf32 = z.astype(jnp.float32)
    zf = jnp.fft.rfft(zf32, n=2 * n, axis=1)
    kf = jnp.fft.rfft(kern, axis=0)
    y = jnp.fft.irfft(zf * kf[None], n=2 * n, axis=1)[:, :n]
    return (y + zf32 * bias.astype(jnp.float32)).astype(z.dtype)


def hyena(u, conv_w, conv_b, filt, hy_bias):
    n = u.shape[1]
    up = jnp.pad(u, ((0, 0), (1, 1), (0, 0)))
    u = up[:, :-2] * conv_w[0] + up[:, 1:-1] * conv_w[1] + up[:, 2:] * conv_w[2] + conv_b
    v, x1, x2 = jnp.split(u, 3, axis=-1)
    kern = implicit_filters(n, *filt)
    z = x1 * long_conv(v, kern[:, 0], hy_bias[0])
    return x2 * long_conv(z, kern[:, 1], hy_bias[1])


def merge_branches(attn, hy, gates, w_pa, w_ph, w_out):
    g_a, g_h = jnp.split(gates, 2, axis=-1)
    y = jax.nn.sigmoid(g_a) * (attn @ w_pa) + jax.nn.sigmoid(g_h) * (hy @ w_ph)
    return y @ w_out


def swiglu(t, w_g, w_u, w_d):
    return (jax.nn.silu(t @ w_g) * (t @ w_u)) @ w_d


def moe(h, router_w, router_bias, w_g, w_u, w_d, s_g, s_u, s_d):
    B_, L_, D = h.shape
    t = h.reshape(-1, D)
    N = t.shape[0]
    scores = jax.nn.sigmoid((t @ router_w).astype(jnp.float32))
    choice = scores + router_bias.astype(jnp.float32)
    grp = choice.reshape(N, N_GROUPS, N_EXPERTS // N_GROUPS)
    grp_score = lax.top_k(grp, 2)[0].sum(-1)
    _, gidx = lax.top_k(grp_score, TOPK_GROUPS)
    gmask = jax.nn.one_hot(gidx, N_GROUPS, dtype=jnp.float32).sum(1) > 0
    masked = jnp.where(jnp.repeat(gmask, N_EXPERTS // N_GROUPS, axis=1), choice, -jnp.inf)
    _, eidx = lax.top_k(masked, TOP_K)
    wsel = jnp.take_along_axis(scores, eidx, axis=1)
    wsel = wsel / jnp.sum(wsel, axis=-1, keepdims=True) * ROUTED_SCALE
    NK = N * TOP_K
    flat_e = eidx.reshape(-1)
    flat_tok = jnp.repeat(jnp.arange(N, dtype=jnp.int32), TOP_K)
    flat_w = wsel.reshape(-1)
    order = jnp.argsort(flat_e)
    sorted_e = flat_e[order]
    counts = jnp.zeros((N_EXPERTS,), jnp.int32).at[flat_e].add(1)
    padded = (counts + MOE_BLOCK - 1) // MOE_BLOCK * MOE_BLOCK
    pad_end = jnp.cumsum(padded)
    pad_start = pad_end - padded
    start = jnp.cumsum(counts) - counts
    dest = pad_start[sorted_e] + jnp.arange(NK, dtype=jnp.int32) - start[sorted_e]
    NB = -(-(NK + N_EXPERTS * (MOE_BLOCK - 1)) // MOE_BLOCK)
    P = NB * MOE_BLOCK
    row_tok = jnp.full((P,), N, jnp.int32).at[dest].set(flat_tok[order])
    row_w = jnp.zeros((P,), jnp.float32).at[dest].set(flat_w[order])
    blk_e = jnp.minimum(jnp.searchsorted(pad_end, jnp.arange(NB, dtype=jnp.int32) * MOE_BLOCK, side='right'),
                        N_EXPERTS - 1)
    t_pad = jnp.concatenate([t, jnp.zeros((1, D), t.dtype)], axis=0)

    def expert_block(args):
        tok, e = args
        xb = jnp.take(t_pad, tok, axis=0)
        return swiglu(xb, w_g[e], w_u[e], w_d[e])

    yb = lax.map(expert_block, (row_tok.reshape(NB, MOE_BLOCK), blk_e))
    routed = jnp.zeros((N + 1, D), jnp.float32).at[row_tok].add(
        yb.reshape(P, D).astype(jnp.float32) * row_w[:, None])[:N]
    out = routed.astype(t.dtype) + swiglu(t, s_g, s_u, s_d)
    return out.reshape(B_, L_, D)


def setup_inputs(seed: int = 0) -> dict:
    key = jax.random.key(seed)
    ks = jax.random.split(key, 40)
    f32 = jnp.float32
    D, Lr = D_MODEL, DEPTH

    def nrm(i, shape, scale):
        return jax.random.normal(ks[i], shape, f32) * scale

    return {
        "x": nrm(0, (BATCH, SEQ, D), 1.0),
        "c": nrm(1, (BATCH, D), 1.0),
        "ctx": nrm(2, (BATCH, CTX_LEN, D), 1.0),
        "c_ctx": nrm(3, (D,), 1.0),
        "ada_w": nrm(4, (Lr, D, 6 * D), 0.5 * D ** -0.5),
        "ada_b": nrm(5, (Lr, 6 * D), 0.01),
        "norm1_g": 1.0 + nrm(6, (Lr, D), 0.02),
        "norm2_g": 1.0 + nrm(7, (Lr, D), 0.02),
        "w_in": nrm(8, (Lr, D, IN_W), D ** -0.5),
        "lam_q1": nrm(9, (Lr, HEAD_DIM), 0.1),
        "lam_k1": nrm(10, (Lr, HEAD_DIM), 0.1),
        "lam_q2": nrm(11, (Lr, HEAD_DIM), 0.1),
        "lam_k2": nrm(12, (Lr, HEAD_DIM), 0.1),
        "subln_g": 1.0 + nrm(13, (Lr, V_DIM), 0.02),
        "hy_conv_w": nrm(14, (Lr, 3, 3 * HYENA_W), 3 ** -0.5),
        "hy_conv_b": nrm(15, (Lr, 3 * HYENA_W), 0.01),
        "filt_w1": nrm(16, (Lr, FILTER_EMB, FILTER_HIDDEN), FILTER_EMB ** -0.5),
        "filt_b1": nrm(17, (Lr, FILTER_HIDDEN), 0.1),
        "filt_freq": 1.0 + nrm(18, (Lr, FILTER_HIDDEN), 0.02),
        "filt_w2": nrm(19, (Lr, FILTER_HIDDEN, FILTER_HIDDEN), FILTER_HIDDEN ** -0.5),
        "filt_b2": nrm(20, (Lr, FILTER_HIDDEN), 0.1),
        "filt_w3": nrm(21, (Lr, FILTER_HIDDEN, HYENA_ORDER * 2 * HYENA_W), FILTER_HIDDEN ** -0.5),
        "hy_bias": nrm(22, (Lr, HYENA_ORDER, HYENA_W), 1.0),
        "w_branch_attn": nrm(23, (Lr, ATTN_V_W, D), ATTN_V_W ** -0.5),
        "w_branch_hyena": nrm(24, (Lr, HYENA_W, D), HYENA_W ** -0.5),
        "w_out": nrm(25, (Lr, D, D), D ** -0.5),
        "router_w": nrm(26, (Lr, D, N_EXPERTS), D ** -0.5),
        "router_bias": nrm(27, (Lr, N_EXPERTS), 0.01),
        "exp_w_gate": nrm(28, (Lr, N_EXPERTS, D, EXPERT_HIDDEN), D ** -0.5),
        "exp_w_up": nrm(29, (Lr, N_EXPERTS, D, EXPERT_HIDDEN), D ** -0.5),
        "exp_w_down": nrm(30, (Lr, N_EXPERTS, EXPERT_HIDDEN, D), EXPERT_HIDDEN ** -0.5),
        "shared_w_gate": nrm(31, (Lr, D, SHARED_HIDDEN), D ** -0.5),
        "shared_w_up": nrm(32, (Lr, D, SHARED_HIDDEN), D ** -0.5),
        "shared_w_down": nrm(33, (Lr, SHARED_HIDDEN, D), SHARED_HIDDEN ** -0.5),
        "final_norm_g": 1.0 + nrm(34, (D,), 0.02),
    }


def reference(x, c, ctx, c_ctx, ada_w, ada_b, norm1_g, norm2_g, w_in, lam_q1, lam_k1, lam_q2, lam_k2,
              subln_g, hy_conv_w, hy_conv_b, filt_w1, filt_b1, filt_freq, filt_w2, filt_b2, filt_w3, hy_bias,
              w_branch_attn, w_branch_hyena, w_out, router_w, router_bias, exp_w_gate, exp_w_up, exp_w_down,
              shared_w_gate, shared_w_up, shared_w_down, final_norm_g):
    f32 = jnp.float32
    ROWS = x.shape[1] // GRID_W
    cos, sin = rope_2d(ROWS)
    for layer in range(DEPTH):
        last = layer == DEPTH - 1
        lam_init = 0.8 - 0.6 * math.exp(-0.3 * layer)
        lam = (jnp.exp(jnp.sum(lam_q1[layer].astype(f32) * lam_k1[layer].astype(f32)))
               - jnp.exp(jnp.sum(lam_q2[layer].astype(f32) * lam_k2[layer].astype(f32))) + lam_init)
        filt = (filt_w1[layer], filt_b1[layer], filt_freq[layer], filt_w2[layer], filt_b2[layer], filt_w3[layer])
        sh1, sc1, g1, sh2, sc2, g2 = adaln(c, ada_w[layer], ada_b[layer], 6)
        cmod = adaln(c_ctx, ada_w[layer], ada_b[layer], 2 if last else 6)
        w = w_in[layer]

        hx = modulate(rmsnorm(x, norm1_g[layer]), sh1, sc1)
        hc = modulate(rmsnorm(ctx, norm1_g[layer]), cmod[0], cmod[1])
        px = hx @ w
        pc_kv = hc @ w[:, :Q_OFF]
        kc = qk_heads(pc_kv[..., K_OFF:V_OFF])
        vc = v_heads(pc_kv[..., V_OFF:Q_OFF])
        kx = apply_rope_2d(qk_heads(px[..., K_OFF:V_OFF]), cos, sin)
        vx = v_heads(px[..., V_OFF:Q_OFF])
        qx = apply_rope_2d(qk_heads(px[..., Q_OFF:HY_OFF]), cos, sin)
        k_all = jnp.concatenate([kx, kc], axis=1)
        v_all = jnp.concatenate([vx, vc], axis=1)
        ax = diff_sub_norm(diff_attention_blocked(qx, k_all, v_all, lam), subln_g[layer], lam_init)
        yx = hyena(px[..., HY_OFF:GATE_OFF], hy_conv_w[layer], hy_conv_b[layer], filt, hy_bias[layer])
        mix_x = merge_branches(ax, yx, px[..., GATE_OFF:IN_W], w_branch_attn[layer], w_branch_hyena[layer],
                               w_out[layer])
        if not last:
            pc_rest = hc @ w[:, Q_OFF:]
            qc = qk_heads(pc_rest[..., :HY_OFF - Q_OFF])
            ac = diff_sub_norm(diff_attend(qc, kc, vc, lam), subln_g[layer], lam_init)
            yc = hyena(pc_rest[..., HY_OFF - Q_OFF:GATE_OFF - Q_OFF], hy_conv_w[layer], hy_conv_b[layer], filt,
                       hy_bias[layer])
            ctx = ctx + cmod[2] * merge_branches(ac, yc, pc_rest[..., GATE_OFF - Q_OFF:], w_branch_attn[layer],
                                                 w_branch_hyena[layer], w_out[layer])
            hc2 = modulate(rmsnorm(ctx, norm2_g[layer]), cmod[3], cmod[4])
            ctx = ctx + cmod[5] * moe(hc2, router_w[layer], router_bias[layer], exp_w_gate[layer],
                                      exp_w_up[layer], exp_w_down[layer], shared_w_gate[layer],
                                      shared_w_up[layer], shared_w_down[layer])
        x = x + g1 * mix_x

        hx2 = modulate(rmsnorm(x, norm2_g[layer]), sh2, sc2)
        x = x + g2 * moe(hx2, router_w[layer], router_bias[layer], exp_w_gate[layer], exp_w_up[layer],
                         exp_w_down[layer], shared_w_gate[layer], shared_w_up[layer], shared_w_down[layer])
    return rmsnorm(x, final_norm_g)
```

```cpp
#include <hip/hip_runtime.h>
#include <hip/hip_cooperative_groups.h>
#include <cstdio>
#include <cstdint>
#include <cmath>
namespace cg = cooperative_groups;

#define LAS __attribute__((address_space(3)))
typedef unsigned short bf16_t;
typedef short bf16x8 __attribute__((ext_vector_type(8)));
typedef short s16x4 __attribute__((ext_vector_type(4)));
typedef float f32x2 __attribute__((ext_vector_type(2)));
typedef float f32x4 __attribute__((ext_vector_type(4)));
typedef float f32x8 __attribute__((ext_vector_type(8)));
typedef float f32x16 __attribute__((ext_vector_type(16)));
typedef unsigned u32x2 __attribute__((ext_vector_type(2)));
typedef unsigned u32x4 __attribute__((ext_vector_type(4)));

constexpr int NB = 8, SEQ = 4096, DM = 1024, NTOK = NB * SEQ, CTXL = 256, NCTX = NB * CTXL, MROWS = NTOK + NCTX  , LKV = SEQ + CTXL  ;
constexpr int INW = 8192, NEXP = 64, EH = 256;
constexpr int PMAX_TILES = 1087 + 128;
constexpr float NORM_EPS = 1e-6f;

constexpr size_t MiB = 1u << 20;
constexpr size_t WS_MOD = 0;
constexpr size_t WS_CMOD = 256 * 1024;
constexpr size_t WS_LAM = 320 * 1024;
constexpr size_t WS_HDN = 1 * MiB;
constexpr size_t WS_ZERO = 2 * MiB, WS_ZERO_BYTES = 3 * MiB;
constexpr size_t WS_CNT = 2 * MiB;
constexpr size_t WS_TILEE = 2 * MiB + 65536;
constexpr size_t WS_ROWTOK = 3 * MiB;
constexpr size_t WS_POS = 5 * MiB;
constexpr size_t WS_WSEL = 6 * MiB;
constexpr size_t WS_EIDX = 7 * MiB;
constexpr size_t WS_WIN = 8 * MiB;
constexpr size_t WS_WPA = 24 * MiB, WS_WPH = 26 * MiB, WS_WOUT = 28 * MiB;
constexpr size_t WS_HX = 32 * MiB;
constexpr size_t WS_Q = 100 * MiB;
constexpr size_t WS_K = 164 * MiB;
constexpr size_t WS_V = 232 * MiB;
constexpr size_t WS_UT = 300 * MiB;
constexpr size_t WS_H = 100 * MiB;
constexpr size_t WS_Y = 252 * MiB;
constexpr size_t WS_WGU = 414 * MiB;
constexpr size_t WS_WD = 479 * MiB;
constexpr size_t WS_END = 512 * MiB;
static_assert(WS_WD + (size_t)65 * 1024 * 256 * 2 <= WS_END && WS_Y + (size_t)PMAX_TILES * 256 * 512 <= WS_WGU && WS_H + (size_t)PMAX_TILES * 256 * 512 <= WS_Y, "ws map");

struct Params { const float* in[35]; float* out; unsigned char* ws; };
enum { I_X = 0, I_C, I_CTX, I_CCTX, I_ADAW, I_ADAB, I_N1G, I_N2G, I_WIN, I_LQ1, I_LK1, I_LQ2, I_LK2, I_SUBG, I_HCW, I_HCB, I_FW1, I_FB1, I_FFR, I_FW2, I_FB2, I_FW3, I_HYB,
       I_WPA, I_WPH, I_WOUT, I_RW, I_RB, I_EG, I_EU, I_ED, I_SG, I_SU, I_SD, I_FNG };

__device__ __forceinline__ unsigned cvt_pk_bf16(float lo, float hi) { unsigned r; asm volatile("v_cvt_pk_bf16_f32 %0, %1, %2" : "=v"(r) : "v"(lo), "v"(hi)); return r; }
__device__ __forceinline__ float bf2f(unsigned short h) { return __uint_as_float(((unsigned)h) << 16); }
__device__ __forceinline__ float bflo(unsigned w) { return __uint_as_float(w << 16); }
__device__ __forceinline__ float bfhi(unsigned w) { return __uint_as_float(w & 0xffff0000u); }
__device__ __forceinline__ float wave_sum(float v) {
#pragma unroll
    for (int o = 1; o < 64; o <<= 1) v += __shfl_xor(v, o);
    return v;
}
__device__ __forceinline__ float sigmoidf_(float x) { return 1.f / (1.f + __expf(-x)); }
namespace pg8 {
constexpr int BM = 256, BK = 64, HALF = 128, HTB = HALF * BK * 2  , STAGE_BYTES = 8 * HTB, NXCD = 8, WGM = 8;

__host__ __device__ __forceinline__ int lds_byte(int r, int c) { const int st = (r >> 4) * 2 + (c >> 5), rr = r & 15, cc = c & 31, ob = rr * 64 + cc * 2; return st * 1024 + (ob ^ (((ob >> 9) & 1) << 5)); }
__host__ __device__ __forceinline__ void stage_rc(int b, int& R, int& C) { const int st = b / 1024, sb = b % 1024, swz = sb ^ (((sb >> 9) & 1) << 5); R = (st >> 1) * 16 + swz / 64; C = (st & 1) * 32 + (swz % 64) / 2; }
__host__ __device__ __forceinline__ int perm32(int rho) { const int n = rho >> 4, i = rho & 15; return 8 * (i >> 2) + 4 * n + (i & 3); }

struct Unit { int pm, pn; };
struct Gemm { const bf16_t* A; const bf16_t* Bt; int K; const int* rowidx; };

struct StaticOrder {
    int nM, nN, nwg, G, c;
    __device__ void init(int M, int N, int G_, int c_) { nM = M / BM; nN = N / BM; nwg = nM * nN; G = G_; c = c_; }
    __device__ bool next(int i, Unit& u) const {
        const long L = (long)i * G + c; if (L >= nwg) return false;
        int wgid = (int)L; { const int q = nwg / NXCD, r = nwg % NXCD, xcd = wgid % NXCD, off = wgid / NXCD; wgid = (xcd < r ? xcd * (q + 1) : r * (q + 1) + (xcd - r) * q) + off; }
        const int nig = WGM * nN, gid = wgid / nig, fm = gid * WGM, gsz = (nM - fm) < WGM ? (nM - fm) : WGM;
        u.pm = fm + ((wgid % nig) % gsz); u.pn = (wgid % nig) / gsz; return true;
    }
};

template <class Epi, class Sched, bool GATHER>
__device__ __forceinline__ void gemm_phase(LAS unsigned char* lds, const Gemm g, const Sched& S, const Epi& E) {
    const int tid = threadIdx.x, wid = __builtin_amdgcn_readfirstlane(tid >> 6), lane = tid & 63, wr = wid >> 2, wc = wid & 3, fr = lane & 15, fq = lane >> 4;
    const int K = g.K, nt = K / BK;
    int sR[2], sC[2];
    unsigned voffB[2];
#pragma unroll
    for (int i = 0; i < 2; ++i) { int R, C; stage_rc(tid * 16 + i * 8192, R, C); sR[i] = R; sC[i] = C; const int Rb = (R & ~31) + perm32(R & 31); voffB[i] = (unsigned)(Rb * K + C) * 2u; }
    const size_t kstep = (size_t)(BK * 2);
    const size_t hstep = (size_t)HALF * K * 2;
    const size_t tstep = 2 * hstep;
    const unsigned ldsw = (unsigned)wid * 1024u;
    const int aoff = lds_byte(wr * 64 + fr, fq * 8), boff = lds_byte(wc * 32 + fr, fq * 8);
#define PG8_SA(b, h) (((b) * 2 + (h)) * HTB)
#define PG8_SB(b, h) ((4 + (b) * 2 + (h)) * HTB)
#define PG8_STAGEB(bufoff, gbase) do { _Pragma("unroll") for (int _i = 0; _i < 2; ++_i) \
        __builtin_amdgcn_global_load_lds((const unsigned*)((const char*)(gbase) + voffB[_i]), (LAS unsigned*)(lds + (bufoff) + ldsw + _i * 8192), 16, 0, 0); } while (0)
#define PG8_STAGEA(bufoff, gbase, v0, v1) do { \
        __builtin_amdgcn_global_load_lds((const unsigned*)((const char*)(gbase) + (v0)), (LAS unsigned*)(lds + (bufoff) + ldsw), 16, 0, 0); \
        __builtin_amdgcn_global_load_lds((const unsigned*)((const char*)(gbase) + (v1)), (LAS unsigned*)(lds + (bufoff) + ldsw + 8192), 16, 0, 0); } while (0)
#define PG8_LDA(dst, b, h) do { _Pragma("unroll") for (int m = 0; m < 4; ++m) _Pragma("unroll") for (int k = 0; k < 2; ++k) dst[m][k] = *(const LAS bf16x8*)(lds + PG8_SA(b, h) + aoff + m * 2048 + k * 1024); } while (0)
#define PG8_LDB(dst, b, h) do { _Pragma("unroll") for (int n = 0; n < 2; ++n) _Pragma("unroll") for (int k = 0; k < 2; ++k) dst[n][k] = *(const LAS bf16x8*)(lds + PG8_SB(b, h) + boff + n * 2048 + k * 1024); } while (0)
#define PG8_MMA(ai, bj, At, Bt) do { __builtin_amdgcn_s_setprio(1); _Pragma("unroll") for (int m = 0; m < 4; ++m) _Pragma("unroll") for (int n = 0; n < 2; ++n) _Pragma("unroll") for (int k = 0; k < 2; ++k) \
        acc[ai][bj][m][n] = __builtin_amdgcn_mfma_f32_16x16x32_bf16(Bt[n][k], At[m][k], acc[ai][bj][m][n], 0, 0, 0); __builtin_amdgcn_s_setprio(0); } while (0)
#define PG8_WAIT_V(n) asm volatile("s_waitcnt vmcnt(" #n ")" ::: "memory")
#define PG8_WAIT_L(n) asm volatile("s_waitcnt lgkmcnt(" #n ")" ::: "memory")
#define PG8_BAR __builtin_amdgcn_s_barrier()
#define PG8_SCHED __builtin_amdgcn_sched_barrier(0)
    Unit cur, nxt; int ui = 0;
    if (!S.next(0, cur)) return;
    f32x4 acc[2][2][4][2];
#pragma unroll
    for (int a = 0; a < 2; ++a)
#pragma unroll
        for (int b = 0; b < 2; ++b)
#pragma unroll
            for (int m = 0; m < 4; ++m)
#pragma unroll
                for (int n = 0; n < 2; ++n) acc[a][b][m][n] = (f32x4){0.f, 0.f, 0.f, 0.f};
    bf16x8 At[4][2], B0[2][2], B1[2][2];
    unsigned vA[2][2], vN[2][2];
    const char* cA; const char* cB = (const char*)g.Bt + (size_t)cur.pn * tstep;
    if constexpr (GATHER) {
        cA = (const char*)g.A;
#pragma unroll
        for (int h = 0; h < 2; ++h)
#pragma unroll
            for (int i = 0; i < 2; ++i) vA[h][i] = ((unsigned)__hip_atomic_load(g.rowidx + cur.pm * BM + h * HALF + sR[i], __ATOMIC_RELAXED, __HIP_MEMORY_SCOPE_AGENT) * (unsigned)K + (unsigned)sC[i]) * 2u;
    } else {
        cA = (const char*)g.A + (size_t)cur.pm * tstep;
#pragma unroll
        for (int h = 0; h < 2; ++h)
#pragma unroll
            for (int i = 0; i < 2; ++i) vA[h][i] = (unsigned)(sR[i] * K + sC[i]) * 2u + (unsigned)(h * hstep);
    }
    PG8_STAGEB(PG8_SB(0, 0), cB); PG8_STAGEB(PG8_SB(0, 1), cB + hstep); PG8_STAGEA(PG8_SA(0, 0), cA, vA[0][0], vA[0][1]); PG8_STAGEA(PG8_SA(0, 1), cA, vA[1][0], vA[1][1]);
    if (wr == 1) PG8_BAR;
    PG8_WAIT_V(2); PG8_BAR;
    PG8_STAGEB(PG8_SB(1, 0), cB + kstep); PG8_STAGEA(PG8_SA(1, 0), cA + kstep, vA[0][0], vA[0][1]); PG8_STAGEB(PG8_SB(1, 1), cB + hstep + kstep);
    PG8_WAIT_V(6); PG8_BAR;
    for (;;) {
        const bool has_next = S.next(ui + 1, nxt);
        const char* nA; const char* nB = has_next ? (const char*)g.Bt + (size_t)nxt.pn * tstep : cB;
        if constexpr (GATHER) {
            nA = cA;
            if (has_next) {
#pragma unroll
                for (int h = 0; h < 2; ++h)
#pragma unroll
                    for (int i = 0; i < 2; ++i) vN[h][i] = ((unsigned)__hip_atomic_load(g.rowidx + nxt.pm * BM + h * HALF + sR[i], __ATOMIC_RELAXED, __HIP_MEMORY_SCOPE_AGENT) * (unsigned)K + (unsigned)sC[i]) * 2u;
            } else {
#pragma unroll
                for (int h = 0; h < 2; ++h)
#pragma unroll
                    for (int i = 0; i < 2; ++i) vN[h][i] = vA[h][i];
            }
        } else {
            nA = has_next ? (const char*)g.A + (size_t)nxt.pm * tstep : cA;
#pragma unroll
            for (int h = 0; h < 2; ++h)
#pragma unroll
                for (int i = 0; i < 2; ++i) vN[h][i] = vA[h][i];
        }
#pragma unroll 1
        for (int t = 0; t < nt; t += 2) {
            const bool last = (t == nt - 2);
            const char* a1 = cA + (size_t)(t + 1) * kstep;
            const char* a2 = last ? nA : cA + (size_t)(t + 2) * kstep; const char* b2 = last ? nB : cB + (size_t)(t + 2) * kstep;
            const char* a3 = a2 + kstep; const char* b3 = b2 + kstep;
            const unsigned w00 = last ? vN[0][0] : vA[0][0], w01 = last ? vN[0][1] : vA[0][1], w10 = last ? vN[1][0] : vA[1][0], w11 = last ? vN[1][1] : vA[1][1];
            PG8_LDB(B0, 0, 0); PG8_LDB(B1, 0, 1); PG8_SCHED; PG8_LDA(At, 0, 0); PG8_STAGEA(PG8_SA(1, 1), a1, vA[1][0], vA[1][1]);
            PG8_WAIT_V(8); PG8_WAIT_L(0); PG8_BAR; PG8_MMA(0, 0, At, B0); PG8_MMA(0, 1, At, B1); PG8_BAR; PG8_SCHED;
            PG8_LDA(At, 0, 1); PG8_STAGEB(PG8_SB(0, 0), b2); PG8_STAGEB(PG8_SB(0, 1), b2 + hstep); PG8_STAGEA(PG8_SA(0, 0), a2, w00, w01);
            PG8_WAIT_V(8); PG8_WAIT_L(0); PG8_BAR; PG8_MMA(1, 0, At, B0); PG8_MMA(1, 1, At, B1); PG8_BAR; PG8_SCHED;
            PG8_LDB(B0, 1, 0); PG8_LDB(B1, 1, 1); PG8_SCHED; PG8_LDA(At, 1, 0); PG8_STAGEA(PG8_SA(0, 1), a2, w10, w11);
            PG8_WAIT_V(8); PG8_WAIT_L(0); PG8_BAR; PG8_MMA(0, 0, At, B0); PG8_MMA(0, 1, At, B1); PG8_BAR; PG8_SCHED;
            PG8_LDA(At, 1, 1); PG8_STAGEB(PG8_SB(1, 0), b3); PG8_STAGEB(PG8_SB(1, 1), b3 + hstep); PG8_STAGEA(PG8_SA(1, 0), a3, w00, w01);
            PG8_WAIT_V(8); PG8_WAIT_L(0); PG8_BAR; PG8_MMA(1, 0, At, B0); PG8_MMA(1, 1, At, B1); PG8_BAR; PG8_SCHED;
        }
        if (wr == 0) PG8_BAR;
        E(acc, cur, wr, wc, fr, fq);
        if (!has_next) break;
#pragma unroll
        for (int a = 0; a < 2; ++a)
#pragma unroll
            for (int b = 0; b < 2; ++b)
#pragma unroll
                for (int m = 0; m < 4; ++m)
#pragma unroll
                    for (int n = 0; n < 2; ++n) acc[a][b][m][n] = (f32x4){0.f, 0.f, 0.f, 0.f};
        cur = nxt; cA = nA; cB = nB; ++ui;
#pragma unroll
        for (int h = 0; h < 2; ++h)
#pragma unroll
            for (int i = 0; i < 2; ++i) vA[h][i] = vN[h][i];
        if (wr == 1) PG8_BAR;
    }
    PG8_WAIT_V(0);
    PG8_BAR;
#undef PG8_SA
#undef PG8_SB
#undef PG8_STAGEA
#undef PG8_STAGEB
#undef PG8_LDA
#undef PG8_LDB
#undef PG8_MMA
#undef PG8_WAIT_V
#undef PG8_WAIT_L
#undef PG8_BAR
#undef PG8_SCHED
}
}
namespace epi {
using pg8::Unit;
__device__ __forceinline__ u32x4 pack8(const f32x4 v0, const f32x4 v1) { u32x4 w; w.x = cvt_pk_bf16(v0[0], v0[1]); w.y = cvt_pk_bf16(v0[2], v0[3]); w.z = cvt_pk_bf16(v1[0], v1[1]); w.w = cvt_pk_bf16(v1[2], v1[3]); return w; }

struct InProj {
    bf16_t* Q; bf16_t* Kall; bf16_t* Vall; bf16_t* UT; bf16_t* G;
    __device__ __forceinline__ void operator()(const f32x4 (&acc)[2][2][4][2], const Unit& u, int wr, int wc, int fr, int fq) const {
        const int pn = u.pn; const int row0 = u.pm * 256 + wr * 64 + fr; const int cw = wc * 32 + 8 * fq;
        if (pn < 12 && !(pn >= 4 && pn < 8)) {
            const bool isq = pn >= 8; const int colt = (isq ? pn - 8 : pn) * 256;
            float inv[4];
#pragma unroll
            for (int j = 0; j < 4; ++j) inv[j] = exp2f(-(float)(4 * fq + j) * 0.8304820237218406f);
            const int axis = wc & 1;
#pragma unroll
            for (int ai = 0; ai < 2; ++ai)
#pragma unroll
                for (int m = 0; m < 4; ++m) {
                    const int row = row0 + ai * 128 + m * 16;
                    bf16_t* dst; bool rope;
                    if (row < NTOK) { const int b = row >> 12, t = row & 4095; rope = true;
                        dst = isq ? Q + (size_t)row * DM : Kall + ((size_t)b * LKV + t) * DM; }
                    else { const int rc = row - NTOK, b = rc >> 8, j = rc & 255; rope = false; dst = Kall + ((size_t)b * LKV + SEQ + j) * DM; }
                    const int t = row & 4095; const float pos = (float)(axis ? (t & 63) : (t >> 6));
#pragma unroll
                    for (int bj = 0; bj < 2; ++bj) {
                        f32x4 x1 = acc[ai][bj][m][0], x2 = acc[ai][bj][m][1], o1, o2;
                        if (rope) {
#pragma unroll
                            for (int j = 0; j < 4; ++j) { const float a = pos * inv[j]; const float c = __cosf(a), s = __sinf(a); o1[j] = x1[j] * c - x2[j] * s; o2[j] = x2[j] * c + x1[j] * s; }
                        } else { o1 = x1; o2 = x2; }
                        *(u32x4*)(dst + colt + bj * 128 + cw) = pack8(o1, o2);
                    }
                }
        } else if (pn < 8) {
            const int colt = (pn - 4) * 256;
#pragma unroll
            for (int ai = 0; ai < 2; ++ai)
#pragma unroll
                for (int m = 0; m < 4; ++m) {
                    const int row = row0 + ai * 128 + m * 16; bf16_t* dst;
                    if (row < NTOK) { const int b = row >> 12, t = row & 4095; dst = Vall + ((size_t)b * LKV + t) * DM; }
                    else { const int rc = row - NTOK, b = rc >> 8, j = rc & 255; dst = Vall + ((size_t)b * LKV + SEQ + j) * DM; }
#pragma unroll
                    for (int bj = 0; bj < 2; ++bj) *(u32x4*)(dst + colt + bj * 128 + cw) = pack8(acc[ai][bj][m][0], acc[ai][bj][m][1]);
                }
        } else if (pn < 24) {
            const int ch0 = (pn - 12) * 256 + cw;
#pragma unroll
            for (int ai = 0; ai < 2; ++ai)
#pragma unroll
                for (int m = 0; m < 4; ++m) {
                    const int row = row0 + ai * 128 + m * 16; const int b = row >> 12, t = row & 4095;
                    bf16_t* dst = UT + ((size_t)b * 3072 + ch0) * SEQ + t;
#pragma unroll
                    for (int bj = 0; bj < 2; ++bj)
#pragma unroll
                        for (int n = 0; n < 2; ++n)
#pragma unroll
                            for (int j = 0; j < 4; ++j) dst[(size_t)(bj * 128 + n * 4 + j) * SEQ] = (bf16_t)(cvt_pk_bf16(acc[ai][bj][m][n][j], 0.f) & 0xffffu);
                }
        } else {
            const int colt = (pn - 24) * 256;
#pragma unroll
            for (int ai = 0; ai < 2; ++ai)
#pragma unroll
                for (int m = 0; m < 4; ++m) {
                    const int row = row0 + ai * 128 + m * 16; bf16_t* dst = G + (size_t)row * 2048 + colt + cw;
#pragma unroll
                    for (int bj = 0; bj < 2; ++bj) { f32x4 a = acc[ai][bj][m][0], c = acc[ai][bj][m][1];
#pragma unroll
                        for (int j = 0; j < 4; ++j) { a[j] = sigmoidf_(a[j]); c[j] = sigmoidf_(c[j]); }
                        *(u32x4*)(dst + bj * 128) = pack8(a, c); }
                }
        }
    }
};

template <int MODE> struct Merge {
    const bf16_t* G; bf16_t* T1;
    __device__ __forceinline__ void operator()(const f32x4 (&acc)[2][2][4][2], const Unit& u, int wr, int wc, int fr, int fq) const {
        const int row0 = u.pm * 256 + wr * 64 + fr; const int col0 = u.pn * 256 + wc * 32 + 8 * fq;
#pragma unroll
        for (int ai = 0; ai < 2; ++ai)
#pragma unroll
            for (int m = 0; m < 4; ++m) {
                const int row = row0 + ai * 128 + m * 16;
#pragma unroll
                for (int bj = 0; bj < 2; ++bj) {
                    const int col = col0 + bj * 128;
                    const u32x4 gw = *(const u32x4*)(G + (size_t)row * 2048 + MODE * 1024 + col);
                    f32x4 a = acc[ai][bj][m][0], c = acc[ai][bj][m][1];
                    a[0] *= bflo(gw.x); a[1] *= bfhi(gw.x); a[2] *= bflo(gw.y); a[3] *= bfhi(gw.y);
                    c[0] *= bflo(gw.z); c[1] *= bfhi(gw.z); c[2] *= bflo(gw.w); c[3] *= bfhi(gw.w);
                    bf16_t* tp = T1 + (size_t)row * DM + col;
                    if (MODE == 1) { const u32x4 tw = *(const u32x4*)tp;
                        a[0] += bflo(tw.x); a[1] += bfhi(tw.x); a[2] += bflo(tw.y); a[3] += bfhi(tw.y);
                        c[0] += bflo(tw.z); c[1] += bfhi(tw.z); c[2] += bflo(tw.w); c[3] += bfhi(tw.w); }
                    *(u32x4*)tp = pack8(a, c);
                }
            }
    }
};

struct OutProj {
    const float* x; const float* mod; float* xnew;
    __device__ __forceinline__ void operator()(const f32x4 (&acc)[2][2][4][2], const Unit& u, int wr, int wc, int fr, int fq) const {
        const int row0 = u.pm * 256 + wr * 64 + fr; const int col0 = u.pn * 256 + wc * 32 + 8 * fq;
#pragma unroll
        for (int ai = 0; ai < 2; ++ai)
#pragma unroll
            for (int m = 0; m < 4; ++m) {
                const int row = row0 + ai * 128 + m * 16; const int b = row >> 12;
#pragma unroll
                for (int bj = 0; bj < 2; ++bj) {
                    const int col = col0 + bj * 128; const size_t off = (size_t)row * DM + col;
                    const float* gp = mod + b * 6144 + 2048 + col;
#pragma unroll
                    for (int n = 0; n < 2; ++n) { const f32x4 xv = *(const f32x4*)(x + off + 4 * n), gv = *(const f32x4*)(gp + 4 * n);
                        *(f32x4*)(xnew + off + 4 * n) = xv + gv * acc[ai][bj][m][n]; }
                }
            }
    }
};

struct SwiGLU {
    bf16_t* H;
    __device__ __forceinline__ void operator()(const f32x4 (&acc)[2][2][4][2], const Unit& u, int wr, int wc, int fr, int fq) const {
        const int row0 = u.pm * 256 + wr * 64 + fr; const int j = u.pn & 1;
#pragma unroll
        for (int ai = 0; ai < 2; ++ai)
#pragma unroll
            for (int m = 0; m < 4; ++m) {
                const int row = row0 + ai * 128 + m * 16;
#pragma unroll
                for (int bj = 0; bj < 2; ++bj) {
                    const int gi = 16 * bj + 4 * wc + fq;
                    const f32x4 g = acc[ai][bj][m][0], up = acc[ai][bj][m][1]; f32x4 h;
#pragma unroll
                    for (int q = 0; q < 4; ++q) h[q] = g[q] * sigmoidf_(g[q]) * up[q];
                    u32x2 w; w.x = cvt_pk_bf16(h[0], h[1]); w.y = cvt_pk_bf16(h[2], h[3]);
                    *(u32x2*)(H + (size_t)row * EH + 128 * j + 4 * gi) = w;
                }
            }
    }
};

struct Down {
    bf16_t* Y;
    __device__ __forceinline__ void operator()(const f32x4 (&acc)[2][2][4][2], const Unit& u, int wr, int wc, int fr, int fq) const {
        const int row0 = u.pm * 256 + wr * 64 + fr; const int col0 = wc * 32 + 8 * fq;
#pragma unroll
        for (int ai = 0; ai < 2; ++ai)
#pragma unroll
            for (int m = 0; m < 4; ++m) {
                const int row = row0 + ai * 128 + m * 16;
#pragma unroll
                for (int bj = 0; bj < 2; ++bj) *(u32x4*)(Y + (size_t)row * 256 + col0 + bj * 128) = pack8(acc[ai][bj][m][0], acc[ai][bj][m][1]);
            }
    }
};
}
struct Ctx { int tid, lane, wave, G, bid; unsigned char* ws; };

__device__ __forceinline__ void adaln_phase(const Params& p, const Ctx& C, char* lds) {
    float* s = (float*)lds;
    float* red = (float*)(lds + 9 * 1024 * 4);
    const float* c = p.in[I_C]; const float* cc = p.in[I_CCTX]; const float* W = p.in[I_ADAW]; const float* bias = p.in[I_ADAB];
    float* mod = (float*)(C.ws + WS_MOD); float* cmod = (float*)(C.ws + WS_CMOD);
    if (C.bid < 192) {
        for (int i = C.tid; i < 9 * 1024; i += 512) { const int b = i >> 10, k = i & 1023; const float v = b < 8 ? c[b * 1024 + k] : cc[k]; s[i] = v / (1.f + expf(-v)); }
        __syncthreads();
    }
    for (int item = C.bid; item < 192; item += C.G) {
        const int cl = C.tid & 31, kg = C.tid >> 5, col = item * 32 + cl;
        float acc[9];
#pragma unroll
        for (int b = 0; b < 9; ++b) acc[b] = 0.f;
        for (int k = kg; k < 1024; k += 16) { const float w = W[(size_t)k * 6144 + col];
#pragma unroll
            for (int b = 0; b < 9; ++b) acc[b] += s[b * 1024 + k] * w; }
#pragma unroll
        for (int b = 0; b < 9; ++b) red[(kg * 9 + b) * 32 + cl] = acc[b];
        __syncthreads();
        if (C.tid < 9 * 32) { const int b = C.tid >> 5, c2 = C.tid & 31, col2 = item * 32 + c2; float v = 0.f;
            for (int q = 0; q < 16; ++q) v += red[(q * 9 + b) * 32 + c2];
            v += bias[col2];
            if (b < 8) mod[b * 6144 + col2] = v; else if (col2 < 2048) cmod[col2] = v; }
        __syncthreads();
    }
    if (C.bid == (C.G > 200 ? 200 : 0) && C.tid < 64) {
        const float a = wave_sum(p.in[I_LQ1][C.tid] * p.in[I_LK1][C.tid]), b = wave_sum(p.in[I_LQ2][C.tid] * p.in[I_LK2][C.tid]);
        if (C.tid == 0) *(float*)(C.ws + WS_LAM) = expf(a) - expf(b) + 0.2f;
    }
}

__device__ __forceinline__ void hdn_phase(const Params& p, const Ctx& C) {
    const float* w1 = p.in[I_FW1]; const float* b1 = p.in[I_FB1]; const float* fr = p.in[I_FFR]; const float* w2 = p.in[I_FW2]; const float* b2 = p.in[I_FB2];
    float* hdn = (float*)(C.ws + WS_HDN);
    const int gw = C.bid * 8 + C.wave, NGW = C.G * 8, l = C.lane;
    for (int t = gw; t < SEQ; t += NGW) {
        float z = 0.f;
        if (l == 0) z = (float)((double)t / 4095.0);
        else if (l < 33) { const int bi = (l - 1) & 15; const double band = 1e-4 + (double)bi * ((15.0 - 1e-4) / 15.0); const double w = 6.283185307179586476925 * (double)t / 4096.0; const double a = band * w;
            z = (l < 17) ? (float)cos(a) : (float)(-sin(a)); }
        float h = b1[l];
        for (int i = 0; i < 33; ++i) h += __shfl(z, i) * w1[i * 64 + l];
        h = sinf(fr[l] * h);
        float h2 = b2[l];
        for (int i = 0; i < 64; ++i) h2 += __shfl(h, i) * w2[i * 64 + l];
        h2 = sinf(fr[l] * h2);
        hdn[t * 64 + l] = h2;
    }
}

__device__ __forceinline__ void transpose_item(const float* srcl, int ldw, bf16_t* dst, int K, float* scr, int lane) {
#pragma unroll 8
    for (int i = 0; i < 32; ++i) { const int kk = 2 * i + (lane >> 5); scr[kk * 33 + (lane & 31)] = srcl[(size_t)kk * ldw]; }
    asm volatile("s_waitcnt lgkmcnt(0)" ::: "memory");
    const int c = lane & 7;
#pragma unroll
    for (int j = 0; j < 4; ++j) { const int n = (lane >> 3) + 8 * j; const float* s = scr + (8 * c) * 33 + n;
        u32x4 o; o.x = cvt_pk_bf16(s[0 * 33], s[1 * 33]); o.y = cvt_pk_bf16(s[2 * 33], s[3 * 33]); o.z = cvt_pk_bf16(s[4 * 33], s[5 * 33]); o.w = cvt_pk_bf16(s[6 * 33], s[7 * 33]);
        *(u32x4*)(dst + (size_t)n * K + 8 * c) = o; }
    asm volatile("s_waitcnt lgkmcnt(0)" ::: "memory");
}
__device__ __forceinline__ int qk_src_col(int n) {
    const int blk = n & ~63, pp = n & 63, axis = pp >> 5, f = ((pp & 31) >> 3) * 4 + (pp & 3), half = (pp >> 2) & 1;
    return blk + axis * 32 + half * 16 + f;
}
__device__ __forceinline__ void wconv_mixer_phase(const Params& p, const Ctx& C, char* lds) {
    float* scr = (float*)(lds + C.wave * 16384);
    const int gw = C.bid * 8 + C.wave, NGW = C.G * 8, l31 = C.lane & 31;
    constexpr int I_IN = 16 * 256, I_SQ = 16 * 32, NIT = I_IN + 3 * I_SQ;
    for (int it = gw; it < NIT; it += NGW) {
        int r = it;
        if (r < I_IN) { const int kb = r / 256, nb = r % 256, k0 = 64 * kb, n0 = 32 * nb; const int n = n0 + l31;
            const int src = (n < 1024 || (n >= 2048 && n < 3072)) ? qk_src_col(n) : n;
            transpose_item(p.in[I_WIN] + (size_t)k0 * INW + src, INW, (bf16_t*)(C.ws + WS_WIN) + (size_t)n0 * 1024 + k0, 1024, scr, C.lane); continue; }
        r -= I_IN; const int which = r / I_SQ; r %= I_SQ;
        const float* W = which == 0 ? p.in[I_WPA] : which == 1 ? p.in[I_WPH] : p.in[I_WOUT];
        bf16_t* WT = (bf16_t*)(C.ws + (which == 0 ? WS_WPA : which == 1 ? WS_WPH : WS_WOUT));
        const int kb = r / 32, nb = r % 32, k0 = 64 * kb, n0 = 32 * nb;
        transpose_item(W + (size_t)k0 * 1024 + n0 + l31, 1024, WT + (size_t)n0 * 1024 + k0, 1024, scr, C.lane);
    }
}
__device__ __forceinline__ void wconv_moe_phase(const Params& p, const Ctx& C, char* lds) {
    float* scr = (float*)(lds + C.wave * 16384);
    const int gw = C.bid * 8 + C.wave, NGW = C.G * 8, l31 = C.lane & 31;
    constexpr int I_GU = 16 * 16, I_D = 4 * 32, NIT = 65 * (I_GU + I_D);
    for (int it = gw; it < NIT; it += NGW) {
        const int e = it / (I_GU + I_D); int r = it % (I_GU + I_D);
        if (r < I_GU) { const int kb = r / 16, nb = r % 16, k0 = 64 * kb, n0 = 32 * nb; const int n = n0 + l31;
            const int j = n >> 8, gi = (n & 255) >> 3, e8 = n & 7, i = 128 * j + 4 * gi + (e8 & 3);
            const float* mat = (e8 >> 2) ? (e < 64 ? p.in[I_EU] + (size_t)e * 1024 * 256 : p.in[I_SU]) : (e < 64 ? p.in[I_EG] + (size_t)e * 1024 * 256 : p.in[I_SG]);
            transpose_item(mat + (size_t)k0 * 256 + i, 256, (bf16_t*)(C.ws + WS_WGU) + ((size_t)e * 512 + n0) * 1024 + k0, 1024, scr, C.lane); continue; }
        r -= I_GU; const int kb = r / 32, nb = r % 32, k0 = 64 * kb, n0 = 32 * nb;
        const float* mat = e < 64 ? p.in[I_ED] + (size_t)e * 256 * 1024 : p.in[I_SD];
        transpose_item(mat + (size_t)k0 * 1024 + n0 + l31, 1024, (bf16_t*)(C.ws + WS_WD) + ((size_t)e * 1024 + n0) * 256 + k0, 256, scr, C.lane);
    }
}

__device__ __forceinline__ void hx_phase(const Params& p, const Ctx& C) {
    const float* mod = (const float*)(C.ws + WS_MOD); const float* cmod = (const float*)(C.ws + WS_CMOD); const float* g = p.in[I_N1G];
    bf16_t* HX = (bf16_t*)(C.ws + WS_HX);
    const int gw = C.bid * 8 + C.wave, NGW = C.G * 8;
    for (int r = gw; r < MROWS; r += NGW) {
        const float* xr; const float* sh; const float* sc;
        if (r < NTOK) { xr = p.in[I_X] + (size_t)r * DM; const int b = r >> 12; sh = mod + b * 6144; sc = sh + 1024; }
        else { xr = p.in[I_CTX] + (size_t)(r - NTOK) * DM; sh = cmod; sc = cmod + 1024; }
        f32x4 v[4]; float ss = 0.f;
#pragma unroll
        for (int j = 0; j < 4; ++j) { v[j] = *(const f32x4*)(xr + 256 * j + 4 * C.lane); ss += (v[j].x * v[j].x + v[j].y * v[j].y) + (v[j].z * v[j].z + v[j].w * v[j].w); }
        const float rn = 1.0f / sqrtf(wave_sum(ss) * (1.f / DM) + NORM_EPS);
#pragma unroll
        for (int j = 0; j < 4; ++j) { const int k = 256 * j + 4 * C.lane;
            const f32x4 gv = *(const f32x4*)(g + k), scv = *(const f32x4*)(sc + k), shv = *(const f32x4*)(sh + k);
            const f32x4 o = v[j] * rn * gv * (1.f + scv) + shv;
            u32x2 w; w.x = cvt_pk_bf16(o.x, o.y); w.y = cvt_pk_bf16(o.z, o.w);
            *(u32x2*)(HX + (size_t)r * DM + k) = w; }
    }
}
namespace att {
constexpr int KVBLK = 64, NT = LKV / KVBLK;
constexpr float SCALE = 0.125f, THR = 8.f;
constexpr int SHM_V = KVBLK * 128 * 2, SHM_K = KVBLK * 128 * 2;
#define KSWZ(row, colB) ((row) * 256 + ((colB) ^ (((row) & 7) << 4)))
#define SBAR() __builtin_amdgcn_sched_barrier(0)
__device__ __forceinline__ int crow(int r, int hi) { return (r & 3) + 8 * (r >> 2) + 4 * hi; }
__device__ __forceinline__ void partialSM(f32x16& p0, f32x16& p1, float& m_reg, float& mn, float& alpha) {
  constexpr float C = SCALE * 1.4426950408889634f;
  float pmax = p0[0];
#pragma unroll
  for (int r = 1; r < 16; ++r) pmax = fmaxf(pmax, p0[r]);
#pragma unroll
  for (int r = 0; r < 16; ++r) pmax = fmaxf(pmax, p1[r]);
  { auto rr = __builtin_amdgcn_permlane32_swap(__float_as_uint(pmax), __float_as_uint(pmax), false, false);
    pmax = fmaxf(__uint_as_float(rr[0]), __uint_as_float(rr[1])); }
  if (__builtin_expect(__all(pmax - m_reg <= THR / SCALE), 1)) { mn = m_reg; alpha = 1.f; }
  else { mn = fmaxf(m_reg, pmax); alpha = __builtin_amdgcn_exp2f((m_reg - mn) * C); m_reg = mn; }
  float mnC = -mn * C;
#pragma unroll
  for (int r = 0; r < 16; ++r) p0[r] = fmaf(p0[r], C, mnC);
#pragma unroll
  for (int r = 0; r < 16; ++r) p1[r] = fmaf(p1[r], C, mnC);
#pragma unroll
  for (int r = 0; r < 16; ++r) p0[r] = __builtin_amdgcn_exp2f(p0[r]);
}
__device__ __forceinline__ void finishSM(f32x16& p0, f32x16& p1, float alpha, float& l_reg, bf16x8& pa0, bf16x8& pa1, bf16x8& pa2, bf16x8& pa3) {
#pragma unroll
  for (int r = 0; r < 16; ++r) p1[r] = __builtin_amdgcn_exp2f(p1[r]);
  float ps = 0;
#pragma unroll
  for (int r = 0; r < 16; ++r) ps += p0[r];
#pragma unroll
  for (int r = 0; r < 16; ++r) ps += p1[r];
  { auto rr = __builtin_amdgcn_permlane32_swap(__float_as_uint(ps), __float_as_uint(ps), false, false);
    ps = __uint_as_float(rr[0]) + __uint_as_float(rr[1]); }
  l_reg = l_reg * alpha + ps;
#define PK4(P, BASE, OUT) do { unsigned a0 = cvt_pk_bf16(P[BASE + 0], P[BASE + 1]), a1 = cvt_pk_bf16(P[BASE + 2], P[BASE + 3]);   \
    unsigned b0 = cvt_pk_bf16(P[BASE + 4], P[BASE + 5]), b1 = cvt_pk_bf16(P[BASE + 6], P[BASE + 7]);                              \
    auto r0 = __builtin_amdgcn_permlane32_swap(a0, b0, false, false); auto r1 = __builtin_amdgcn_permlane32_swap(a1, b1, false, false); \
    u32x4 w = {r0[0], r1[0], r0[1], r1[1]}; OUT = *reinterpret_cast<bf16x8*>(&w); } while (0)
  PK4(p0, 0, pa0); PK4(p0, 8, pa1); PK4(p1, 0, pa2); PK4(p1, 8, pa3);
#undef PK4
}
__device__ __forceinline__ void qkt(f32x16& p0, f32x16& p1, const char* Ks, const bf16x8* qr, int r32, int hi, int mp) {
  p0 = f32x16{}; p1 = f32x16{};
#pragma unroll
  for (int d0 = 0; d0 < 4; ++d0) { const int cb = ((mp * 4 + d0) * 16 + hi * 8) * 2;
    const bf16x8 b0 = *reinterpret_cast<const bf16x8*>(Ks + KSWZ(r32, cb));
    const bf16x8 b1 = *reinterpret_cast<const bf16x8*>(Ks + KSWZ(32 + r32, cb));
    p0 = __builtin_amdgcn_mfma_f32_32x32x16_bf16(b0, qr[d0], p0, 0, 0, 0);
    p1 = __builtin_amdgcn_mfma_f32_32x32x16_bf16(b1, qr[d0], p1, 0, 0, 0); }
}
__device__ __forceinline__ int v_st(int k, int c) { const int kk = (k & ~0xC) | ((k & 4) << 1) | ((k & 8) >> 1); return ((kk >> 3) * 4 + (c >> 5)) * 512 + ((kk & 7) * 32 + (c & 31)) * 2; }
__device__ __forceinline__ int v_rd_base(int lane) { return ((lane & 3) << 3) | (((lane >> 2) & 3) << 6) | (((lane >> 4) & 1) << 5) | (((lane >> 5) & 1) << 8); }
constexpr int v_rd_off(int d0, int ks, int half) { return d0 * 512 + ks * 4096 + half * 2048; }
template <int OFF> __device__ __forceinline__ s16x4 tr_read(int vb) {
  s16x4 r; asm volatile("ds_read_b64_tr_b16 %0, %1 offset:%2" : "=&v"(r) : "v"(vb), "i"(OFF) : "memory"); return r;
}
template <int D0> __device__ __forceinline__ void pv_one(f32x16& od, int vb, bf16x8 pa0, bf16x8 pa1, bf16x8 pa2, bf16x8 pa3) {
  const s16x4 l0 = tr_read<v_rd_off(D0, 0, 0)>(vb), h0 = tr_read<v_rd_off(D0, 0, 1)>(vb), l1 = tr_read<v_rd_off(D0, 1, 0)>(vb), h1 = tr_read<v_rd_off(D0, 1, 1)>(vb);
  const s16x4 l2 = tr_read<v_rd_off(D0, 2, 0)>(vb), h2 = tr_read<v_rd_off(D0, 2, 1)>(vb), l3 = tr_read<v_rd_off(D0, 3, 0)>(vb), h3 = tr_read<v_rd_off(D0, 3, 1)>(vb);
  asm volatile("s_waitcnt lgkmcnt(0)" ::: "memory"); SBAR();
#define PK(L, H) (bf16x8){L[0], L[1], L[2], L[3], H[0], H[1], H[2], H[3]}
  od = __builtin_amdgcn_mfma_f32_32x32x16_bf16(pa0, PK(l0, h0), od, 0, 0, 0);
  od = __builtin_amdgcn_mfma_f32_32x32x16_bf16(pa1, PK(l1, h1), od, 0, 0, 0);
  od = __builtin_amdgcn_mfma_f32_32x32x16_bf16(pa2, PK(l2, h2), od, 0, 0, 0);
  od = __builtin_amdgcn_mfma_f32_32x32x16_bf16(pa3, PK(l3, h3), od, 0, 0, 0);
#undef PK
}
__device__ __forceinline__ void pv_d0(f32x16* o, int vb, bf16x8 pa0, bf16x8 pa1, bf16x8 pa2, bf16x8 pa3) {
  pv_one<0>(o[0], vb, pa0, pa1, pa2, pa3); pv_one<1>(o[1], vb, pa0, pa1, pa2, pa3); pv_one<2>(o[2], vb, pa0, pa1, pa2, pa3); pv_one<3>(o[3], vb, pa0, pa1, pa2, pa3);
}

__device__ __forceinline__ void attn_unit(const bf16_t* Qg, const bf16_t* Kall, const bf16_t* Vall, bf16_t* AX, float lam, const float* subg, int b, int h, int qb, char* lds) {
  constexpr int LDK = DM;
  const int tid = threadIdx.x, wid = tid >> 6, lane = tid & 63, r32 = lane & 31, hi = lane >> 5, rg = wid & 3, mp = wid >> 2;
  char* V_lds = lds; char* K_lds = lds + 2 * SHM_V;
  float* wsf = (float*)(lds + 2 * SHM_V + 2 * SHM_K) + wid * 64; float* li_l = wsf; float* al_l = wsf + 32;
  const bf16_t* Kh = Kall + (size_t)b * LKV * DM + h * 128; const bf16_t* Vh = Vall + (size_t)b * LKV * DM + h * 128;
  float m_reg = -1e30f, l_reg = 0; f32x16 o[4] = {}; bf16x8 qr[4];
  const bf16_t* Qw = Qg + ((size_t)(b * SEQ + qb * 128 + rg * 32 + r32)) * DM + h * 128 + mp * 64 + hi * 8;
#pragma unroll
  for (int d0 = 0; d0 < 4; ++d0) qr[d0] = *reinterpret_cast<const bf16x8*>(Qw + d0 * 16);
  const int sr = tid >> 4, sc = (tid & 15) * 8, vst0 = v_st(sr, sc), vst1 = v_st(32 + sr, sc);
  const int vb0 = (int)(uintptr_t)V_lds + v_rd_base(lane);
  struct { bf16x8 vs0, vs1, ks0, ks1; } sr_[2];
#define SLOAD(i, k0) do { sr_[i].vs0 = *(const bf16x8*)(&Vh[(size_t)((k0) + sr) * LDK + sc]); sr_[i].vs1 = *(const bf16x8*)(&Vh[(size_t)((k0) + 32 + sr) * LDK + sc]); \
    sr_[i].ks0 = *(const bf16x8*)(&Kh[(size_t)((k0) + sr) * LDK + sc]); sr_[i].ks1 = *(const bf16x8*)(&Kh[(size_t)((k0) + 32 + sr) * LDK + sc]); } while (0)
#define SWRITE(bb, i) do { *(bf16x8*)(V_lds + (bb) * SHM_V + vst0) = sr_[i].vs0;          \
    *(bf16x8*)(V_lds + (bb) * SHM_V + vst1) = sr_[i].vs1; int kc = sc * 2;               \
    *(bf16x8*)(K_lds + (bb) * SHM_K + KSWZ(sr, kc)) = sr_[i].ks0;                       \
    *(bf16x8*)(K_lds + (bb) * SHM_K + KSWZ(32 + sr, kc)) = sr_[i].ks1; } while (0)
#define SWAIT() asm volatile("s_waitcnt vmcnt(4)" ::: "memory")
#define RESC(a) do { if (__any((a) < 1.f)) { if (hi == 0) al_l[r32] = (a); asm volatile("s_waitcnt lgkmcnt(0)" ::: "memory"); \
    _Pragma("unroll") for (int d = 0; d < 4; ++d) _Pragma("unroll") for (int r = 0; r < 16; ++r) o[d][r] *= al_l[crow(r, hi)]; } } while (0)
  f32x16 pA0, pA1, pB0, pB1; float mnA, mnB, alA, alB; bf16x8 pa0, pa1, pa2, pa3;
  constexpr int SE = 0, SO = 1;
  SLOAD(SE, 0); asm volatile("s_waitcnt vmcnt(0)" ::: "memory"); SWRITE(0, SE); __syncthreads();
  qkt(pA0, pA1, K_lds, qr, r32, hi, mp); partialSM(pA0, pA1, m_reg, mnA, alA);
  SLOAD(SO, KVBLK); SLOAD(SE, 2 * KVBLK);
  SWAIT(); SWRITE(1, SO); __syncthreads();
  for (int j = 1; j + 1 < NT; j += 2) {
    SBAR(); qkt(pB0, pB1, K_lds + SHM_K, qr, r32, hi, mp);
    finishSM(pA0, pA1, alA, l_reg, pa0, pa1, pa2, pa3); SBAR();
    SLOAD(SO, (j + 2) * KVBLK); SBAR();
    pv_d0(o, vb0, pa0, pa1, pa2, pa3); partialSM(pB0, pB1, m_reg, mnB, alB);
    __syncthreads(); SWAIT(); SWRITE(0, SE);
    RESC(alB); __syncthreads();
    SBAR(); qkt(pA0, pA1, K_lds, qr, r32, hi, mp);
    finishSM(pB0, pB1, alB, l_reg, pa0, pa1, pa2, pa3); SBAR();
    if (j + 3 < NT) SLOAD(SE, (j + 3) * KVBLK); SBAR();
    pv_d0(o, vb0 + SHM_V, pa0, pa1, pa2, pa3); partialSM(pA0, pA1, m_reg, mnA, alA);
    __syncthreads(); SWAIT(); SWRITE(1, SO);
    RESC(alA); __syncthreads();
  }
  SBAR(); qkt(pB0, pB1, K_lds + SHM_K, qr, r32, hi, mp);
  finishSM(pA0, pA1, alA, l_reg, pa0, pa1, pa2, pa3); SBAR();
  pv_d0(o, vb0, pa0, pa1, pa2, pa3); partialSM(pB0, pB1, m_reg, mnB, alB);
  __syncthreads(); RESC(alB);
  finishSM(pB0, pB1, alB, l_reg, pa0, pa1, pa2, pa3); SBAR();
  pv_d0(o, vb0 + SHM_V, pa0, pa1, pa2, pa3);
  if (hi == 0) li_l[r32] = l_reg; asm volatile("s_waitcnt lgkmcnt(0)" ::: "memory");
  float rli[16];
#pragma unroll
  for (int r = 0; r < 16; ++r) rli[r] = __builtin_amdgcn_rcpf(li_l[crow(r, hi)]);
  __syncthreads();
  { float* Ob = (float*)lds + (size_t)(mp * 128 + rg * 32) * 132;
#pragma unroll
    for (int r = 0; r < 16; ++r) { const int orow = crow(r, hi);
#pragma unroll
      for (int d0 = 0; d0 < 4; ++d0) Ob[orow * 132 + d0 * 32 + r32] = o[d0][r] * rli[r]; } }
  __syncthreads();
  { const int row = tid >> 2, q4 = tid & 3;
    const float* o0 = (const float*)lds + (size_t)row * 132 + q4 * 32; const float* o1 = o0 + 128 * 132;
    float d[32]; float ss = 0.f;
#pragma unroll
    for (int i = 0; i < 32; i += 4) { const f32x4 a = *(const f32x4*)(o0 + i), c = *(const f32x4*)(o1 + i);
#pragma unroll
      for (int q = 0; q < 4; ++q) { d[i + q] = a[q] - lam * c[q]; ss += d[i + q] * d[i + q]; } }
    ss += __shfl_xor(ss, 1); ss += __shfl_xor(ss, 2);
    const float rn = 0.8f / sqrtf(ss * (1.f / 128.f) + NORM_EPS);
    bf16_t* op = AX + ((size_t)(b * SEQ + qb * 128 + row)) * DM + h * 128 + q4 * 32; const float* gp = subg + q4 * 32;
#pragma unroll
    for (int i = 0; i < 32; i += 8) { u32x4 w;
      w.x = cvt_pk_bf16(d[i] * rn * gp[i], d[i + 1] * rn * gp[i + 1]); w.y = cvt_pk_bf16(d[i + 2] * rn * gp[i + 2], d[i + 3] * rn * gp[i + 3]);
      w.z = cvt_pk_bf16(d[i + 4] * rn * gp[i + 4], d[i + 5] * rn * gp[i + 5]); w.w = cvt_pk_bf16(d[i + 6] * rn * gp[i + 6], d[i + 7] * rn * gp[i + 7]);
      *(u32x4*)(op + i) = w; } }
  __syncthreads();
#undef SLOAD
#undef SWRITE
#undef SWAIT
#undef RESC
}
__device__ __forceinline__ void attn_phase(const Ctx& C, const float* subg, char* lds) {
  const bf16_t* Qg = (const bf16_t*)(C.ws + WS_Q); const bf16_t* Kall = (const bf16_t*)(C.ws + WS_K); const bf16_t* Vall = (const bf16_t*)(C.ws + WS_V);
  const float lam = *(const float*)(C.ws + WS_LAM);
  if (C.G == 256) { const int vcu = (C.bid & 7) * 32 + (C.bid >> 3);
    for (int i = 0; i < 8; ++i) { const int bh = (vcu >> 5) * 8 + i, qb = vcu & 31; attn_unit(Qg, Kall, Vall, (bf16_t*)(C.ws + WS_Q), lam, subg, bh >> 3, bh & 7, qb, lds); }
  } else {
    for (int L = C.bid; L < 2048; L += C.G) attn_unit(Qg, Kall, Vall, (bf16_t*)(C.ws + WS_Q), lam, subg, L >> 8, (L >> 5) & 7, L & 31, lds);
  }
}
#undef KSWZ
#undef SBAR
}
namespace hyn {
__device__ __forceinline__ float block_sum(float v, float* red, int tid) {
    v = wave_sum(v);
    __syncthreads();
    if ((tid & 63) == 0) red[tid >> 6] = v;
    __syncthreads();
    float s = 0.f;
#pragma unroll
    for (int i = 0; i < 8; ++i) s += red[i];
    return s;
}
__device__ __forceinline__ void build_kernel(const Params& p, const Ctx& C, int o, int c, float* kern, float* w3s, float* red) {
    const float* hdn = (const float*)(C.ws + WS_HDN); const float* w3 = p.in[I_FW3];
    __syncthreads();
    if (C.tid < 128) { const int dir = C.tid >> 6, k = C.tid & 63; w3s[C.tid] = w3[(size_t)k * 4096 + o * 2048 + dir * 1024 + c]; }
    __syncthreads();
    const float a = -3.0701134573253944f, bq = -15.350567286626972f;
    const float delta = fabsf(a + (float)c * ((bq - a) / 1023.f));
    float hf[8], hb[8]; float asum = 0.f;
#pragma unroll
    for (int j = 0; j < 8; ++j) { const int t = C.tid + 512 * j; const float* hr = hdn + t * 64; float sf = 0.f, sb = 0.f;
#pragma unroll 8
        for (int k = 0; k < 64; ++k) { const float hv = hr[k]; sf += hv * w3s[k]; sb += hv * w3s[64 + k]; }
        const float dec = expf(-((float)t * (1.f / 4095.f)) * delta);
        hf[j] = sf * dec; hb[j] = sb * dec; asum += fabsf(hf[j]) + (t > 0 ? fabsf(hb[j]) : 0.f); }
    const float tot = block_sum(asum, red, C.tid); const float inv = 1.f / tot;
#pragma unroll
    for (int j = 0; j < 8; ++j) { const int t = C.tid + 512 * j; kern[4096 + t] = hf[j] * inv; if (t > 0) kern[4096 - t] = hb[j] * inv; }
    if (C.tid == 0) kern[0] = 0.f;
    __syncthreads();
}
__device__ __forceinline__ void hyena_naive_phase(const Params& p, const Ctx& C, char* lds) {
    float* kern = (float*)lds;
    float* zb = (float*)(lds + 32768);
    float* w3s = (float*)(lds + 32768 + 65536);
    float* red = w3s + 128;
    const bf16_t* UT = (const bf16_t*)(C.ws + WS_UT); bf16_t* YX = (bf16_t*)(C.ws + WS_HX);
    const float* cw = p.in[I_HCW]; const float* cb = p.in[I_HCB]; const float* hyb = p.in[I_HYB];
    for (int unit = C.bid; unit < 2048; unit += C.G) {
        const int c = unit >> 1, bh = unit & 1;
        float vreg[8][4];
#pragma unroll
        for (int j = 0; j < 8; ++j) { const int t = C.tid + 512 * j;
#pragma unroll
            for (int bb = 0; bb < 4; ++bb) { const bf16_t* u = UT + ((size_t)(bh * 4 + bb) * 3072 + c) * SEQ;
                const float um = t > 0 ? bf2f(u[t - 1]) : 0.f, u0 = bf2f(u[t]), up = t < SEQ - 1 ? bf2f(u[t + 1]) : 0.f;
                vreg[j][bb] = um * cw[c] + u0 * cw[3072 + c] + up * cw[6144 + c] + cb[c]; } }
        for (int o = 0; o < 2; ++o) {
            build_kernel(p, C, o, c, kern, w3s, red);
#pragma unroll
            for (int j = 0; j < 8; ++j) { const int t = C.tid + 512 * j; *(f32x4*)(zb + t * 4) = (f32x4){vreg[j][0], vreg[j][1], vreg[j][2], vreg[j][3]}; }
            __syncthreads();
            float acc[8][4];
#pragma unroll
            for (int j = 0; j < 8; ++j)
#pragma unroll
                for (int bb = 0; bb < 4; ++bb) acc[j][bb] = 0.f;
            for (int s = 0; s < SEQ; ++s) { const f32x4 z4 = *(const f32x4*)(zb + s * 4);
#pragma unroll
                for (int j = 0; j < 8; ++j) { const float kv = kern[4096 + C.tid + 512 * j - s];
#pragma unroll
                    for (int bb = 0; bb < 4; ++bb) acc[j][bb] += kv * z4[bb]; } }
            const float bias = hyb[o * 1024 + c]; const int xc = (o + 1) * 1024 + c;
#pragma unroll
            for (int j = 0; j < 8; ++j) { const int t = C.tid + 512 * j;
#pragma unroll
                for (int bb = 0; bb < 4; ++bb) { const bf16_t* u = UT + ((size_t)(bh * 4 + bb) * 3072 + xc) * SEQ;
                    const float um = t > 0 ? bf2f(u[t - 1]) : 0.f, u0 = bf2f(u[t]), up = t < SEQ - 1 ? bf2f(u[t + 1]) : 0.f;
                    const float xg = um * cw[xc] + u0 * cw[3072 + xc] + up * cw[6144 + xc] + cb[xc];
                    vreg[j][bb] = xg * (acc[j][bb] + vreg[j][bb] * bias); } }
            __syncthreads();
        }
#pragma unroll
        for (int j = 0; j < 8; ++j) { const int t = C.tid + 512 * j;
#pragma unroll
            for (int bb = 0; bb < 4; ++bb) YX[((size_t)(bh * 4 + bb) * SEQ + t) * DM + c] = (bf16_t)(cvt_pk_bf16(vreg[j][bb], 0.f) & 0xffffu); }
    }
}
}
namespace moe {
__device__ __forceinline__ void route_phase(const Params& p, const Ctx& C, const float* xnew, char* lds) {
    const float* mod = (const float*)(C.ws + WS_MOD); const float* g = p.in[I_N2G]; const float* rw = p.in[I_RW]; const float* rb = p.in[I_RB];
    bf16_t* HX2 = (bf16_t*)(C.ws + WS_HX); int* eidx = (int*)(C.ws + WS_EIDX); float* wsel = (float*)(C.ws + WS_WSEL); int* counts = (int*)(C.ws + WS_CNT);
    float* hb = (float*)(lds + C.wave * 16384);
    int* hist = (int*)(lds + 8 * 16384);
    if (C.tid < 64) hist[C.tid] = 0;
    __syncthreads();
    const int gw = C.bid * 8 + C.wave, NGW = C.G * 8, lane = C.lane;
    const float bias = rb[lane];
    for (int grp = gw; grp < NTOK / 4; grp += NGW) {
        const int tok0 = grp * 4; const int b = tok0 >> 12;
        const float* sh = mod + b * 6144 + 3072; const float* sc = sh + 1024;
        f32x4 v[4][4];
#pragma unroll
        for (int i = 0; i < 4; ++i) { const float* xr = xnew + (size_t)(tok0 + i) * DM; float ss = 0.f;
#pragma unroll
            for (int j = 0; j < 4; ++j) { v[i][j] = *(const f32x4*)(xr + 256 * j + 4 * lane); ss += (v[i][j].x * v[i][j].x + v[i][j].y * v[i][j].y) + (v[i][j].z * v[i][j].z + v[i][j].w * v[i][j].w); }
            const float rn = 1.0f / sqrtf(wave_sum(ss) * (1.f / DM) + NORM_EPS);
#pragma unroll
            for (int j = 0; j < 4; ++j) { const int k = 256 * j + 4 * lane;
                const f32x4 gv = *(const f32x4*)(g + k), scv = *(const f32x4*)(sc + k), shv = *(const f32x4*)(sh + k);
                v[i][j] = v[i][j] * rn * gv * (1.f + scv) + shv;
                u32x2 w; w.x = cvt_pk_bf16(v[i][j].x, v[i][j].y); w.y = cvt_pk_bf16(v[i][j].z, v[i][j].w);
                *(u32x2*)(HX2 + (size_t)(tok0 + i) * DM + k) = w; } }
#pragma unroll
        for (int j = 0; j < 4; ++j)
#pragma unroll
            for (int e = 0; e < 4; ++e) { const int k = 256 * j + 4 * lane + e; *(f32x4*)(hb + k * 4) = (f32x4){v[0][j][e], v[1][j][e], v[2][j][e], v[3][j][e]}; }
        asm volatile("s_waitcnt lgkmcnt(0)" ::: "memory");
        float acc[4] = {0.f, 0.f, 0.f, 0.f};
#pragma unroll 8
        for (int k = 0; k < DM; ++k) { const float w = rw[k * 64 + lane]; const f32x4 h4 = *(const f32x4*)(hb + k * 4);
            acc[0] += h4[0] * w; acc[1] += h4[1] * w; acc[2] += h4[2] * w; acc[3] += h4[3] * w; }
#pragma unroll
        for (int i = 0; i < 4; ++i) {
            const float s = 1.f / (1.f + expf(-acc[i])); const float ch = s + bias;
            float m1 = ch; m1 = fmaxf(m1, __shfl_xor(m1, 1)); m1 = fmaxf(m1, __shfl_xor(m1, 2)); m1 = fmaxf(m1, __shfl_xor(m1, 4));
            const unsigned long long eq = __ballot(ch == m1); const int gidx = lane >> 3; const unsigned gm = (unsigned)(eq >> (8 * gidx)) & 0xffu; const int first = __builtin_ctz(gm);
            float c2 = ((lane & 7) == first) ? -INFINITY : ch;
            float m2 = c2; m2 = fmaxf(m2, __shfl_xor(m2, 1)); m2 = fmaxf(m2, __shfl_xor(m2, 2)); m2 = fmaxf(m2, __shfl_xor(m2, 4));
            const float gs = m1 + m2; int grank = 0;
#pragma unroll
            for (int g2 = 0; g2 < 8; ++g2) { const float ov = __shfl(gs, 8 * g2); grank += (ov > gs || (ov == gs && g2 < gidx)) ? 1 : 0; }
            const bool gsel = grank < 4; const float mc = gsel ? ch : -INFINITY; int rank = 0;
#pragma unroll 16
            for (int e2 = 0; e2 < 64; ++e2) { const float ov = __shfl(mc, e2); rank += (ov > mc || (ov == mc && e2 < lane)) ? 1 : 0; }
            const bool sel = gsel && rank < 8;
            const float tot = wave_sum(sel ? s : 0.f);
            if (sel) { eidx[(tok0 + i) * 8 + rank] = lane; wsel[(tok0 + i) * 8 + rank] = s / tot * 2.5f; atomicAdd(&hist[lane], 1); }
        }
    }
    __syncthreads();
    if (C.tid < 64 && hist[C.tid] > 0) atomicAdd(&counts[C.tid], hist[C.tid]);
}

__device__ __forceinline__ void place_phase(const Ctx& C, char* lds) {
    int* counts = (int*)(C.ws + WS_CNT); int* cursor = counts + 64; int* ntp = counts + 128; int* tile_e = (int*)(C.ws + WS_TILEE);
    int* row_tok = (int*)(C.ws + WS_ROWTOK); int* pos = (int*)(C.ws + WS_POS); const int* eidx = (const int*)(C.ws + WS_EIDX);
    int* pst = (int*)lds;
    int* lh = pst + 80;
    int* lbase = lh + 64;
    if (C.tid == 0) { int a = 0; for (int e = 0; e < 64; ++e) { pst[e] = a; const int cnt = __hip_atomic_load(counts + e, __ATOMIC_RELAXED, __HIP_MEMORY_SCOPE_AGENT); a += (cnt + 255) / 256 * 256; } pst[64] = a; }
    __syncthreads();
    const int P = pst[64];
    if (C.bid == 0) {
        if (C.tid == 0) *ntp = P / 256 + 128;
        for (int t = C.tid; t < P / 256 + 128; t += 512) { int e = 64; const int r = t * 256; if (r < P) { e = 0; while (pst[e + 1] <= r) ++e; } tile_e[t] = e; }
    }
    for (int chunk = C.bid; chunk < NTOK / 128; chunk += C.G) {
        if (C.tid < 64) lh[C.tid] = 0;
        __syncthreads();
        int e_[2], lr_[2];
#pragma unroll
        for (int q = 0; q < 2; ++q) { const int a = C.tid + 512 * q; const int tok = chunk * 128 + (a >> 3); e_[q] = eidx[tok * 8 + (a & 7)]; lr_[q] = atomicAdd(&lh[e_[q]], 1); }
        __syncthreads();
        if (C.tid < 64) lbase[C.tid] = lh[C.tid] > 0 ? atomicAdd(&cursor[C.tid], lh[C.tid]) : 0;
        __syncthreads();
#pragma unroll
        for (int q = 0; q < 2; ++q) { const int a = C.tid + 512 * q; const int tok = chunk * 128 + (a >> 3); const int dest = pst[e_[q]] + lbase[e_[q]] + lr_[q]; row_tok[dest] = tok; pos[tok * 8 + (a & 7)] = dest; }
        __syncthreads();
    }
    for (int tok = C.bid * 512 + C.tid; tok < NTOK; tok += C.G * 512) row_tok[P + tok] = tok;
}

struct MoeOrder {
    const int* tile_e; int NT, G, c, NJ, PNE, colq;
    __device__ bool next(int i, pg8::Unit& u) const {
        const long L = (long)i * G + c; if (L >= (long)NT * NJ) return false;
        const int t = (int)(L / NJ), j = (int)(L % NJ);
        u.pm = t; u.pn = __hip_atomic_load(tile_e + t, __ATOMIC_RELAXED, __HIP_MEMORY_SCOPE_AGENT) * PNE + (NJ == 2 ? j : colq); return true;
    }
};

template <bool LAST>
__device__ __forceinline__ void combine_phase(const Params& p, const Ctx& C, int q) {
    const float* mod = (const float*)(C.ws + WS_MOD); const bf16_t* Y = (const bf16_t*)(C.ws + WS_Y);
    const int* pos = (const int*)(C.ws + WS_POS); const float* wsel = (const float*)(C.ws + WS_WSEL);
    const int NT = __hip_atomic_load((const int*)(C.ws + WS_CNT) + 128, __ATOMIC_RELAXED, __HIP_MEMORY_SCOPE_AGENT); const int P = (NT - 128) * 256;
    float* out = p.out; const float* fg = p.in[I_FNG];
    const int gw = C.bid * 8 + C.wave, NGW = C.G * 8, lane = C.lane;
    for (int tok = gw; tok < NTOK; tok += NGW) {
        const int b = tok >> 12; const float* g2 = mod + b * 6144 + 5120 + 256 * q + 4 * lane;
        f32x4 a = {0.f, 0.f, 0.f, 0.f};
#pragma unroll
        for (int k = 0; k < 8; ++k) { const int r = pos[tok * 8 + k]; const float w = wsel[tok * 8 + k]; const u32x2 y = *(const u32x2*)(Y + (size_t)r * 256 + 4 * lane);
            a[0] += w * bflo(y.x); a[1] += w * bfhi(y.x); a[2] += w * bflo(y.y); a[3] += w * bfhi(y.y); }
        { const u32x2 y = *(const u32x2*)(Y + (size_t)(P + tok) * 256 + 4 * lane); a[0] += bflo(y.x); a[1] += bfhi(y.x); a[2] += bflo(y.y); a[3] += bfhi(y.y); }
        float* op = out + (size_t)tok * DM;
        const f32x4 xo = *(const f32x4*)(op + 256 * q + 4 * lane); const f32x4 gv = *(const f32x4*)g2;
        const f32x4 xn = xo + gv * a;
        if (!LAST) { *(f32x4*)(op + 256 * q + 4 * lane) = xn; }
        else {
            f32x4 v[4]; float ss = 0.f;
#pragma unroll
            for (int j = 0; j < 4; ++j) { v[j] = (j == 3) ? xn : *(const f32x4*)(op + 256 * j + 4 * lane); ss += (v[j].x * v[j].x + v[j].y * v[j].y) + (v[j].z * v[j].z + v[j].w * v[j].w); }
            const float rn = 1.0f / sqrtf(wave_sum(ss) * (1.f / DM) + NORM_EPS);
#pragma unroll
            for (int j = 0; j < 4; ++j) { const f32x4 gq = *(const f32x4*)(fg + 256 * j + 4 * lane); *(f32x4*)(op + 256 * j + 4 * lane) = v[j] * rn * gq; }
        }
    }
}
}
constexpr int LDS_BYTES = 147456;
struct InProjOrder {
    pg8::StaticOrder so; int G, c;
    __device__ bool next(int i, pg8::Unit& u) const {
        const long L = (long)i * G + c;
        if (L < 4096) return so.next(i, u);
        const int r = (int)(L - 4096); if (r >= 64) return false;
        u.pm = 128 + r / 8; u.pn = r % 8; return true;
    }
};

template <int PH> __device__ __forceinline__ void run_phase(const Params& p, const Ctx& C, unsigned char* lds_) {
    char* lds = (char*)lds_; LAS unsigned char* ldsl = (LAS unsigned char*)lds_;
    unsigned char* ws = C.ws;
    if constexpr (PH == 0) { adaln_phase(p, C, lds); __syncthreads(); wconv_mixer_phase(p, C, lds); hdn_phase(p, C); }
    else if constexpr (PH == 1) { hx_phase(p, C); }
    else if constexpr (PH == 2) {
        pg8::Gemm g{(const bf16_t*)(ws + WS_HX), (const bf16_t*)(ws + WS_WIN), 1024, nullptr};
        InProjOrder S; S.so.init(NTOK, INW, C.G, C.bid); S.G = C.G; S.c = C.bid;
        epi::InProj E{(bf16_t*)(ws + WS_Q), (bf16_t*)(ws + WS_K), (bf16_t*)(ws + WS_V), (bf16_t*)(ws + WS_UT), (bf16_t*)p.out};
        pg8::gemm_phase<epi::InProj, InProjOrder, false>(ldsl, g, S, E);
    }
    else if constexpr (PH == 3) { att::attn_phase(C, p.in[I_SUBG], lds); }
    else if constexpr (PH == 4) { hyn::hyena_naive_phase(p, C, lds); }
    else if constexpr (PH == 5) { wconv_moe_phase(p, C, lds); }
    else if constexpr (PH == 6) {
        pg8::Gemm g{(const bf16_t*)(ws + WS_Q), (const bf16_t*)(ws + WS_WPA), 1024, nullptr};
        pg8::StaticOrder S; S.init(NTOK, DM, C.G, C.bid);
        epi::Merge<0> E{(const bf16_t*)p.out, (bf16_t*)(ws + WS_K)};
        pg8::gemm_phase<epi::Merge<0>, pg8::StaticOrder, false>(ldsl, g, S, E);
    }
    else if constexpr (PH == 7) {
        pg8::Gemm g{(const bf16_t*)(ws + WS_HX), (const bf16_t*)(ws + WS_WPH), 1024, nullptr};
        pg8::StaticOrder S; S.init(NTOK, DM, C.G, C.bid);
        epi::Merge<1> E{(const bf16_t*)p.out, (bf16_t*)(ws + WS_K)};
        pg8::gemm_phase<epi::Merge<1>, pg8::StaticOrder, false>(ldsl, g, S, E);
    }
    else if constexpr (PH == 8) {
        pg8::Gemm g{(const bf16_t*)(ws + WS_K), (const bf16_t*)(ws + WS_WOUT), 1024, nullptr};
        pg8::StaticOrder S; S.init(NTOK, DM, C.G, C.bid);
        epi::OutProj E{p.in[I_X], (const float*)(ws + WS_MOD), p.out};
        pg8::gemm_phase<epi::OutProj, pg8::StaticOrder, false>(ldsl, g, S, E);
    }
    else if constexpr (PH == 9) { moe::route_phase(p, C, p.out, lds); }
    else if constexpr (PH == 10) { moe::place_phase(C, lds); }
    else if constexpr (PH == 11) {
        const int NT = __hip_atomic_load((const int*)(ws + WS_CNT) + 128, __ATOMIC_RELAXED, __HIP_MEMORY_SCOPE_AGENT);
        pg8::Gemm g{(const bf16_t*)(ws + WS_HX), (const bf16_t*)(ws + WS_WGU), 1024, (const int*)(ws + WS_ROWTOK)};
        moe::MoeOrder S{(const int*)(ws + WS_TILEE), NT, C.G, C.bid, 2, 2, 0};
        epi::SwiGLU E{(bf16_t*)(ws + WS_H)};
        pg8::gemm_phase<epi::SwiGLU, moe::MoeOrder, true>(ldsl, g, S, E);
    }
    else if constexpr (PH >= 12 && PH < 20 && (PH & 1) == 0) {
        constexpr int q = (PH - 12) / 2;
        const int NT = __hip_atomic_load((const int*)(ws + WS_CNT) + 128, __ATOMIC_RELAXED, __HIP_MEMORY_SCOPE_AGENT);
        pg8::Gemm g{(const bf16_t*)(ws + WS_H), (const bf16_t*)(ws + WS_WD), 256, nullptr};
        moe::MoeOrder S{(const int*)(ws + WS_TILEE), NT, C.G, C.bid, 1, 4, q};
        epi::Down E{(bf16_t*)(ws + WS_Y)};
        pg8::gemm_phase<epi::Down, moe::MoeOrder, false>(ldsl, g, S, E);
    }
    else if constexpr (PH >= 12 && PH < 20 && (PH & 1) == 1) {
        constexpr int q = (PH - 13) / 2;
        moe::combine_phase<q == 3>(p, C, q);
    }
}

template <int PH> __global__ void __launch_bounds__(512, 2) k_phase(Params p) {
    extern __shared__ __attribute__((aligned(16))) unsigned char lds[];
    Ctx C; C.tid = threadIdx.x; C.lane = C.tid & 63; C.wave = __builtin_amdgcn_readfirstlane(C.tid >> 6); C.G = gridDim.x; C.bid = blockIdx.x; C.ws = p.ws;
    run_phase<PH>(p, C, lds);
}

template <int PH> static void launch_phase(const Params& p, int grid, hipStream_t stream, bool first) {
    if (first) (void)hipFuncSetAttribute((const void*)k_phase<PH>, hipFuncAttributeMaxDynamicSharedMemorySize, LDS_BYTES);
    hipLaunchKernelGGL(k_phase<PH>, dim3(grid), dim3(512), LDS_BYTES, stream, p);
}
template <int PH, int END> struct LaunchAll { static void run(const Params& p, int grid, hipStream_t s, bool first) { launch_phase<PH>(p, grid, s, first); LaunchAll<PH + 1, END>::run(p, grid, s, first); } };
template <int END> struct LaunchAll<END, END> { static void run(const Params&, int, hipStream_t, bool) {} };

extern "C" void kernel_launch(void* const* d_in, const int* in_sizes, int n_in, void* d_out, int out_size, void* d_ws, size_t ws_size, hipStream_t stream) {
    static int grid = 0; static bool first = true;
    if (grid == 0) {
        if (n_in != 35 || out_size != NTOK * DM || ws_size < WS_END) { fprintf(stderr, "kernel_launch: unexpected shapes: n_in %d out %d ws %zu\n", n_in, out_size, ws_size); grid = -1; return; }
        int dev = 0, cus = 0; (void)hipGetDevice(&dev); (void)hipDeviceGetAttribute(&cus, hipDeviceAttributeMultiprocessorCount, dev);
        grid = cus > 0 ? cus : 256;
    }
    if (grid < 0) return;
    Params p{};
    for (int i = 0; i < 35; ++i) p.in[i] = (const float*)d_in[i];
    p.out = (float*)d_out; p.ws = (unsigned char*)d_ws;
    (void)hipMemsetAsync((char*)d_ws + WS_ZERO, 0, WS_ZERO_BYTES, stream);
    LaunchAll<0, 20>::run(p, grid, stream, first);
    first = false;
}
```

```cpp
#include <hip/hip_runtime.h>
#include <hip/hip_cooperative_groups.h>
#include <cstdio>
#include <cstdint>
#include <cmath>
namespace cg = cooperative_groups;

#define LAS __attribute__((address_space(3)))
typedef unsigned short bf16_t;
typedef short bf16x8 __attribute__((ext_vector_type(8)));
typedef short s16x4 __attribute__((ext_vector_type(4)));
typedef float f32x2 __attribute__((ext_vector_type(2)));
typedef float f32x4 __attribute__((ext_vector_type(4)));
typedef float f32x8 __attribute__((ext_vector_type(8)));
typedef float f32x16 __attribute__((ext_vector_type(16)));
typedef unsigned u32x2 __attribute__((ext_vector_type(2)));
typedef unsigned u32x4 __attribute__((ext_vector_type(4)));

constexpr int NB = 8, SEQ = 4096, DM = 1024, NTOK = NB * SEQ, CTXL = 256, NCTX = NB * CTXL, MROWS = NTOK + NCTX  , LKV = SEQ + CTXL  ;
constexpr int INW = 8192, NEXP = 64, EH = 256;
constexpr int PMAX_TILES = 1087 + 128;
constexpr float NORM_EPS = 1e-6f;

constexpr size_t MiB = 1u << 20;
constexpr size_t WS_MOD = 0;
constexpr size_t WS_CMOD = 256 * 1024;
constexpr size_t WS_LAM = 320 * 1024;
constexpr size_t WS_HDN = 1 * MiB;
constexpr size_t WS_ZERO = 2 * MiB, WS_ZERO_BYTES = 3 * MiB;
constexpr size_t WS_CNT = 2 * MiB;
constexpr size_t WS_TILEE = 2 * MiB + 65536;
constexpr size_t WS_ROWTOK = 3 * MiB;
constexpr size_t WS_POS = 5 * MiB;
constexpr size_t WS_WSEL = 6 * MiB;
constexpr size_t WS_EIDX = 7 * MiB;
constexpr size_t WS_WIN = 8 * MiB;
constexpr size_t WS_WPA = 24 * MiB, WS_WPH = 26 * MiB, WS_WOUT = 28 * MiB;
constexpr size_t WS_HX = 32 * MiB;
constexpr size_t WS_Q = 100 * MiB;
constexpr size_t WS_K = 164 * MiB;
constexpr size_t WS_V = 232 * MiB;
constexpr size_t WS_UT = 300 * MiB;
constexpr size_t WS_H = 100 * MiB;
constexpr size_t WS_Y = 252 * MiB;
constexpr size_t WS_WGU = 414 * MiB;
constexpr size_t WS_WD = 479 * MiB;
constexpr size_t WS_END = 512 * MiB;
static_assert(WS_WD + (size_t)65 * 1024 * 256 * 2 <= WS_END && WS_Y + (size_t)PMAX_TILES * 256 * 512 <= WS_WGU && WS_H + (size_t)PMAX_TILES * 256 * 512 <= WS_Y, "ws map");

struct Params { const float* in[35]; float* out; unsigned char* ws; };
enum { I_X = 0, I_C, I_CTX, I_CCTX, I_ADAW, I_ADAB, I_N1G, I_N2G, I_WIN, I_LQ1, I_LK1, I_LQ2, I_LK2, I_SUBG, I_HCW, I_HCB, I_FW1, I_FB1, I_FFR, I_FW2, I_FB2, I_FW3, I_HYB,
       I_WPA, I_WPH, I_WOUT, I_RW, I_RB, I_EG, I_EU, I_ED, I_SG, I_SU, I_SD, I_FNG };

__device__ __forceinline__ unsigned cvt_pk_bf16(float lo, float hi) { unsigned r; asm volatile("v_cvt_pk_bf16_f32 %0, %1, %2" : "=v"(r) : "v"(lo), "v"(hi)); return r; }
__device__ __forceinline__ float bf2f(unsigned short h) { return __uint_as_float(((unsigned)h) << 16); }
__device__ __forceinline__ float bflo(unsigned w) { return __uint_as_float(w << 16); }
__device__ __forceinline__ float bfhi(unsigned w) { return __uint_as_float(w & 0xffff0000u); }
__device__ __forceinline__ float wave_sum(float v) {
#pragma unroll
    for (int o = 1; o < 64; o <<= 1) v += __shfl_xor(v, o);
    return v;
}
__device__ __forceinline__ float sigmoidf_(float x) { return 1.f / (1.f + __expf(-x)); }
namespace pg8 {
constexpr int BM = 256, BK = 64, HALF = 128, HTB = HALF * BK * 2  , STAGE_BYTES = 8 * HTB, NXCD = 8, WGM = 8;

__host__ __device__ __forceinline__ int lds_byte(int r, int c) { const int st = (r >> 4) * 2 + (c >> 5), rr = r & 15, cc = c & 31, ob = rr * 64 + cc * 2; return st * 1024 + (ob ^ (((ob >> 9) & 1) << 5)); }
__host__ __device__ __forceinline__ void stage_rc(int b, int& R, int& C) { const int st = b / 1024, sb = b % 1024, swz = sb ^ (((sb >> 9) & 1) << 5); R = (st >> 1) * 16 + swz / 64; C = (st & 1) * 32 + (swz % 64) / 2; }
__host__ __device__ __forceinline__ int perm32(int rho) { const int n = rho >> 4, i = rho & 15; return 8 * (i >> 2) + 4 * n + (i & 3); }

struct Unit { int pm, pn; };
struct Gemm { const bf16_t* A; const bf16_t* Bt; int K; const int* rowidx; };

struct StaticOrder {
    int nM, nN, nwg, G, c;
    __device__ void init(int M, int N, int G_, int c_) { nM = M / BM; nN = N / BM; nwg = nM * nN; G = G_; c = c_; }
    __device__ bool next(int i, Unit& u) const {
        const long L = (long)i * G + c; if (L >= nwg) return false;
        int wgid = (int)L; { const int q = nwg / NXCD, r = nwg % NXCD, xcd = wgid % NXCD, off = wgid / NXCD; wgid = (xcd < r ? xcd * (q + 1) : r * (q + 1) + (xcd - r) * q) + off; }
        const int nig = WGM * nN, gid = wgid / nig, fm = gid * WGM, gsz = (nM - fm) < WGM ? (nM - fm) : WGM;
        u.pm = fm + ((wgid % nig) % gsz); u.pn = (wgid % nig) / gsz; return true;
    }
};

template <class Epi, class Sched, bool GATHER>
__device__ __forceinline__ void gemm_phase(LAS unsigned char* lds, const Gemm g, const Sched& S, const Epi& E) {
    int tid_ = threadIdx.x; asm volatile("" : "+v"(tid_));
    const int tid = tid_, wid = __builtin_amdgcn_readfirstlane(tid >> 6), lane = tid & 63, wr = wid >> 2, wc = wid & 3, fr = lane & 15, fq = lane >> 4;
    const int K = g.K, nt = K / BK;
    int sR[2], sC[2];
    unsigned voffB[2];
#pragma unroll
    for (int i = 0; i < 2; ++i) { int R, C; stage_rc(tid * 16 + i * 8192, R, C); sR[i] = R; sC[i] = C; const int Rb = (R & ~31) + perm32(R & 31); voffB[i] = (unsigned)(Rb * K + C) * 2u; }
    const size_t kstep = (size_t)(BK * 2);
    const size_t hstep = (size_t)HALF * K * 2;
    const size_t tstep = 2 * hstep;
    const unsigned ldsw = (unsigned)wid * 1024u;
    const int aoff = lds_byte(wr * 64 + fr, fq * 8), boff = lds_byte(wc * 32 + fr, fq * 8);
#define PG8_SA(b, h) (((b) * 2 + (h)) * HTB)
#define PG8_SB(b, h) ((4 + (b) * 2 + (h)) * HTB)
#define PG8_STAGEB(bufoff, gbase) do { _Pragma("unroll") for (int _i = 0; _i < 2; ++_i) \
        __builtin_amdgcn_global_load_lds((const unsigned*)((const char*)(gbase) + voffB[_i]), (LAS unsigned*)(lds + (bufoff) + ldsw + _i * 8192), 16, 0, 0); } while (0)
#define PG8_STAGEA(bufoff, gbase, v0, v1) do { \
        __builtin_amdgcn_global_load_lds((const unsigned*)((const char*)(gbase) + (v0)), (LAS unsigned*)(lds + (bufoff) + ldsw), 16, 0, 0); \
        __builtin_amdgcn_global_load_lds((const unsigned*)((const char*)(gbase) + (v1)), (LAS unsigned*)(lds + (bufoff) + ldsw + 8192), 16, 0, 0); } while (0)
#define PG8_LDA(dst, b, h) do { _Pragma("unroll") for (int m = 0; m < 4; ++m) _Pragma("unroll") for (int k = 0; k < 2; ++k) dst[m][k] = *(const LAS bf16x8*)(lds + PG8_SA(b, h) + aoff + m * 2048 + k * 1024); } while (0)
#define PG8_LDB(dst, b, h) do { _Pragma("unroll") for (int n = 0; n < 2; ++n) _Pragma("unroll") for (int k = 0; k < 2; ++k) dst[n][k] = *(const LAS bf16x8*)(lds + PG8_SB(b, h) + boff + n * 2048 + k * 1024); } while (0)
#define PG8_MMA(ai, bj, At, Bt) do { __builtin_amdgcn_s_setprio(1); _Pragma("unroll") for (int m = 0; m < 4; ++m) _Pragma("unroll") for (int n = 0; n < 2; ++n) _Pragma("unroll") for (int k = 0; k < 2; ++k) \
        acc[ai][bj][m][n] = __builtin_amdgcn_mfma_f32_16x16x32_bf16(Bt[n][k], At[m][k], acc[ai][bj][m][n], 0, 0, 0); __builtin_amdgcn_s_setprio(0); } while (0)
#define PG8_WAIT_V(n) asm volatile("s_waitcnt vmcnt(" #n ")" ::: "memory")
#define PG8_WAIT_L(n) asm volatile("s_waitcnt lgkmcnt(" #n ")" ::: "memory")
#define PG8_BAR __builtin_amdgcn_s_barrier()
#define PG8_SCHED __builtin_amdgcn_sched_barrier(0)
    Unit cur, nxt; int ui = 0;
    if (!S.next(0, cur)) return;
    f32x4 acc[2][2][4][2];
#pragma unroll
    for (int a = 0; a < 2; ++a)
#pragma unroll
        for (int b = 0; b < 2; ++b)
#pragma unroll
            for (int m = 0; m < 4; ++m)
#pragma unroll
                for (int n = 0; n < 2; ++n) acc[a][b][m][n] = (f32x4){0.f, 0.f, 0.f, 0.f};
    bf16x8 At[4][2], B0[2][2], B1[2][2];
    unsigned vA[2][2], vN[2][2];
    const char* cA; const char* cB = (const char*)g.Bt + (size_t)cur.pn * tstep;
    if constexpr (GATHER) {
        cA = (const char*)g.A;
#pragma unroll
        for (int h = 0; h < 2; ++h)
#pragma unroll
            for (int i = 0; i < 2; ++i) vA[h][i] = ((unsigned)__hip_atomic_load(g.rowidx + cur.pm * BM + h * HALF + sR[i], __ATOMIC_RELAXED, __HIP_MEMORY_SCOPE_AGENT) * (unsigned)K + (unsigned)sC[i]) * 2u;
    } else {
        cA = (const char*)g.A + (size_t)cur.pm * tstep;
#pragma unroll
        for (int h = 0; h < 2; ++h)
#pragma unroll
            for (int i = 0; i < 2; ++i) vA[h][i] = (unsigned)(sR[i] * K + sC[i]) * 2u + (unsigned)(h * hstep);
    }
    PG8_STAGEB(PG8_SB(0, 0), cB); PG8_STAGEB(PG8_SB(0, 1), cB + hstep); PG8_STAGEA(PG8_SA(0, 0), cA, vA[0][0], vA[0][1]); PG8_STAGEA(PG8_SA(0, 1), cA, vA[1][0], vA[1][1]);
    if (wr == 1) PG8_BAR;
    PG8_WAIT_V(2); PG8_BAR;
    PG8_STAGEB(PG8_SB(1, 0), cB + kstep); PG8_STAGEA(PG8_SA(1, 0), cA + kstep, vA[0][0], vA[0][1]); PG8_STAGEB(PG8_SB(1, 1), cB + hstep + kstep);
    PG8_WAIT_V(6); PG8_BAR;
    for (;;) {
        const bool has_next = S.next(ui + 1, nxt);
        const char* nA; const char* nB = has_next ? (const char*)g.Bt + (size_t)nxt.pn * tstep : cB;
        if constexpr (GATHER) {
            nA = cA;
            if (has_next) {
#pragma unroll
                for (int h = 0; h < 2; ++h)
#pragma unroll
                    for (int i = 0; i < 2; ++i) vN[h][i] = ((unsigned)__hip_atomic_load(g.rowidx + nxt.pm * BM + h * HALF + sR[i], __ATOMIC_RELAXED, __HIP_MEMORY_SCOPE_AGENT) * (unsigned)K + (unsigned)sC[i]) * 2u;
            } else {
#pragma unroll
                for (int h = 0; h < 2; ++h)
#pragma unroll
                    for (int i = 0; i < 2; ++i) vN[h][i] = vA[h][i];
            }
        } else {
            nA = has_next ? (const char*)g.A + (size_t)nxt.pm * tstep : cA;
#pragma unroll
            for (int h = 0; h < 2; ++h)
#pragma unroll
                for (int i = 0; i < 2; ++i) vN[h][i] = vA[h][i];
        }
#pragma unroll 1
        for (int t = 0; t < nt; t += 2) {
            const bool last = (t == nt - 2);
            const char* a1 = cA + (size_t)(t + 1) * kstep;
            const char* a2 = last ? nA : cA + (size_t)(t + 2) * kstep; const char* b2 = last ? nB : cB + (size_t)(t + 2) * kstep;
            const char* a3 = a2 + kstep; const char* b3 = b2 + kstep;
            const unsigned w00 = last ? vN[0][0] : vA[0][0], w01 = last ? vN[0][1] : vA[0][1], w10 = last ? vN[1][0] : vA[1][0], w11 = last ? vN[1][1] : vA[1][1];
            PG8_LDB(B0, 0, 0); PG8_LDB(B1, 0, 1); PG8_SCHED; PG8_LDA(At, 0, 0); PG8_STAGEA(PG8_SA(1, 1), a1, vA[1][0], vA[1][1]);
            PG8_WAIT_V(8); PG8_WAIT_L(0); PG8_BAR; PG8_MMA(0, 0, At, B0); PG8_MMA(0, 1, At, B1); PG8_BAR; PG8_SCHED;
            PG8_LDA(At, 0, 1); PG8_STAGEB(PG8_SB(0, 0), b2); PG8_STAGEB(PG8_SB(0, 1), b2 + hstep); PG8_STAGEA(PG8_SA(0, 0), a2, w00, w01);
            PG8_WAIT_V(8); PG8_WAIT_L(0); PG8_BAR; PG8_MMA(1, 0, At, B0); PG8_MMA(1, 1, At, B1); PG8_BAR; PG8_SCHED;
            PG8_LDB(B0, 1, 0); PG8_LDB(B1, 1, 1); PG8_SCHED; PG8_LDA(At, 1, 0); PG8_STAGEA(PG8_SA(0, 1), a2, w10, w11);
            PG8_WAIT_V(8); PG8_WAIT_L(0); PG8_BAR; PG8_MMA(0, 0, At, B0); PG8_MMA(0, 1, At, B1); PG8_BAR; PG8_SCHED;
            PG8_LDA(At, 1, 1); PG8_STAGEB(PG8_SB(1, 0), b3); PG8_STAGEB(PG8_SB(1, 1), b3 + hstep); PG8_STAGEA(PG8_SA(1, 0), a3, w00, w01);
            PG8_WAIT_V(8); PG8_WAIT_L(0); PG8_BAR; PG8_MMA(1, 0, At, B0); PG8_MMA(1, 1, At, B1); PG8_BAR; PG8_SCHED;
        }
        if (wr == 0) PG8_BAR;
        E(acc, cur, wr, wc, fr, fq);
        if (!has_next) break;
#pragma unroll
        for (int a = 0; a < 2; ++a)
#pragma unroll
            for (int b = 0; b < 2; ++b)
#pragma unroll
                for (int m = 0; m < 4; ++m)
#pragma unroll
                    for (int n = 0; n < 2; ++n) acc[a][b][m][n] = (f32x4){0.f, 0.f, 0.f, 0.f};
        cur = nxt; cA = nA; cB = nB; ++ui;
#pragma unroll
        for (int h = 0; h < 2; ++h)
#pragma unroll
            for (int i = 0; i < 2; ++i) vA[h][i] = vN[h][i];
        if (wr == 1) PG8_BAR;
    }
    PG8_WAIT_V(0);
    PG8_BAR;
#undef PG8_SA
#undef PG8_SB
#undef PG8_STAGEA
#undef PG8_STAGEB
#undef PG8_LDA
#undef PG8_LDB
#undef PG8_MMA
#undef PG8_WAIT_V
#undef PG8_WAIT_L
#undef PG8_BAR
#undef PG8_SCHED
}
}
namespace epi {
using pg8::Unit;
__device__ __forceinline__ u32x4 pack8(const f32x4 v0, const f32x4 v1) { u32x4 w; w.x = cvt_pk_bf16(v0[0], v0[1]); w.y = cvt_pk_bf16(v0[2], v0[3]); w.z = cvt_pk_bf16(v1[0], v1[1]); w.w = cvt_pk_bf16(v1[2], v1[3]); return w; }

struct InProj {
    bf16_t* Q; bf16_t* Kall; bf16_t* Vall; bf16_t* UT; bf16_t* G;
    __device__ __forceinline__ void operator()(const f32x4 (&acc)[2][2][4][2], const Unit& u, int wr, int wc, int fr, int fq) const {
        const int pn = u.pn; const int row0 = u.pm * 256 + wr * 64 + fr; const int cw = wc * 32 + 8 * fq;
        if (pn < 12 && !(pn >= 4 && pn < 8)) {
            const bool isq = pn >= 8; const int colt = (isq ? pn - 8 : pn) * 256;
            float inv[4];
#pragma unroll
            for (int j = 0; j < 4; ++j) inv[j] = exp2f(-(float)(4 * fq + j) * 0.8304820237218406f);
            const int axis = wc & 1;
#pragma unroll
            for (int ai = 0; ai < 2; ++ai)
#pragma unroll
                for (int m = 0; m < 4; ++m) {
                    const int row = row0 + ai * 128 + m * 16;
                    bf16_t* dst; bool rope;
                    if (row < NTOK) { const int b = row >> 12, t = row & 4095; rope = true;
                        dst = isq ? Q + (size_t)row * DM : Kall + ((size_t)b * LKV + t) * DM; }
                    else { const int rc = row - NTOK, b = rc >> 8, j = rc & 255; rope = false; dst = Kall + ((size_t)b * LKV + SEQ + j) * DM; }
                    const int t = row & 4095; const float pos = (float)(axis ? (t & 63) : (t >> 6));
#pragma unroll
                    for (int bj = 0; bj < 2; ++bj) {
                        f32x4 x1 = acc[ai][bj][m][0], x2 = acc[ai][bj][m][1], o1, o2;
                        if (rope) {
#pragma unroll
                            for (int j = 0; j < 4; ++j) { const float a = pos * inv[j]; const float c = __cosf(a), s = __sinf(a); o1[j] = x1[j] * c - x2[j] * s; o2[j] = x2[j] * c + x1[j] * s; }
                        } else { o1 = x1; o2 = x2; }
                        *(u32x4*)(dst + colt + bj * 128 + cw) = pack8(o1, o2);
                    }
                }
        } else if (pn < 8) {
            const int colt = (pn - 4) * 256;
#pragma unroll
            for (int ai = 0; ai < 2; ++ai)
#pragma unroll
                for (int m = 0; m < 4; ++m) {
                    const int row = row0 + ai * 128 + m * 16; bf16_t* dst;
                    if (row < NTOK) { const int b = row >> 12, t = row & 4095; dst = Vall + ((size_t)b * LKV + t) * DM; }
                    else { const int rc = row - NTOK, b = rc >> 8, j = rc & 255; dst = Vall + ((size_t)b * LKV + SEQ + j) * DM; }
#pragma unroll
                    for (int bj = 0; bj < 2; ++bj) *(u32x4*)(dst + colt + bj * 128 + cw) = pack8(acc[ai][bj][m][0], acc[ai][bj][m][1]);
                }
        } else if (pn < 24) {
            const int ch0 = (pn - 12) * 256 + cw;
#pragma unroll
            for (int ai = 0; ai < 2; ++ai)
#pragma unroll
                for (int m = 0; m < 4; ++m) {
                    const int row = row0 + ai * 128 + m * 16; const int b = row >> 12, t = row & 4095;
                    bf16_t* dst = UT + ((size_t)b * 3072 + ch0) * SEQ + t;
#pragma unroll
                    for (int bj = 0; bj < 2; ++bj)
#pragma unroll
                        for (int n = 0; n < 2; ++n)
#pragma unroll
                            for (int j = 0; j < 4; ++j) dst[(size_t)(bj * 128 + n * 4 + j) * SEQ] = (bf16_t)(cvt_pk_bf16(acc[ai][bj][m][n][j], 0.f) & 0xffffu);
                }
        } else {
            const int colt = (pn - 24) * 256;
#pragma unroll
            for (int ai = 0; ai < 2; ++ai)
#pragma unroll
                for (int m = 0; m < 4; ++m) {
                    const int row = row0 + ai * 128 + m * 16; bf16_t* dst = G + (size_t)row * 2048 + colt + cw;
#pragma unroll
                    for (int bj = 0; bj < 2; ++bj) { f32x4 a = acc[ai][bj][m][0], c = acc[ai][bj][m][1];
#pragma unroll
                        for (int j = 0; j < 4; ++j) { a[j] = sigmoidf_(a[j]); c[j] = sigmoidf_(c[j]); }
                        *(u32x4*)(dst + bj * 128) = pack8(a, c); }
                }
        }
    }
};

template <int MODE> struct Merge {
    const bf16_t* G; bf16_t* T1;
    __device__ __forceinline__ void operator()(const f32x4 (&acc)[2][2][4][2], const Unit& u, int wr, int wc, int fr, int fq) const {
        const int row0 = u.pm * 256 + wr * 64 + fr; const int col0 = u.pn * 256 + wc * 32 + 8 * fq;
#pragma unroll
        for (int ai = 0; ai < 2; ++ai)
#pragma unroll
            for (int m = 0; m < 4; ++m) {
                const int row = row0 + ai * 128 + m * 16;
#pragma unroll
                for (int bj = 0; bj < 2; ++bj) {
                    const int col = col0 + bj * 128;
                    const u32x4 gw = *(const u32x4*)(G + (size_t)row * 2048 + MODE * 1024 + col);
                    f32x4 a = acc[ai][bj][m][0], c = acc[ai][bj][m][1];
                    a[0] *= bflo(gw.x); a[1] *= bfhi(gw.x); a[2] *= bflo(gw.y); a[3] *= bfhi(gw.y);
                    c[0] *= bflo(gw.z); c[1] *= bfhi(gw.z); c[2] *= bflo(gw.w); c[3] *= bfhi(gw.w);
                    bf16_t* tp = T1 + (size_t)row * DM + col;
                    if (MODE == 1) { const u32x4 tw = *(const u32x4*)tp;
                        a[0] += bflo(tw.x); a[1] += bfhi(tw.x); a[2] += bflo(tw.y); a[3] += bfhi(tw.y);
                        c[0] += bflo(tw.z); c[1] += bfhi(tw.z); c[2] += bflo(tw.w); c[3] += bfhi(tw.w); }
                    *(u32x4*)tp = pack8(a, c);
                }
            }
    }
};

struct OutProj {
    const float* x; const float* mod; float* xnew;
    __device__ __forceinline__ void operator()(const f32x4 (&acc)[2][2][4][2], const Unit& u, int wr, int wc, int fr, int fq) const {
        const int row0 = u.pm * 256 + wr * 64 + fr; const int col0 = u.pn * 256 + wc * 32 + 8 * fq;
#pragma unroll
        for (int ai = 0; ai < 2; ++ai)
#pragma unroll
            for (int m = 0; m < 4; ++m) {
                const int row = row0 + ai * 128 + m * 16; const int b = row >> 12;
#pragma unroll
                for (int bj = 0; bj < 2; ++bj) {
                    const int col = col0 + bj * 128; const size_t off = (size_t)row * DM + col;
                    const float* gp = mod + b * 6144 + 2048 + col;
#pragma unroll
                    for (int n = 0; n < 2; ++n) { const f32x4 xv = *(const f32x4*)(x + off + 4 * n), gv = *(const f32x4*)(gp + 4 * n);
                        *(f32x4*)(xnew + off + 4 * n) = xv + gv * acc[ai][bj][m][n]; }
                }
            }
    }
};

struct SwiGLU {
    bf16_t* H;
    __device__ __forceinline__ void operator()(const f32x4 (&acc)[2][2][4][2], const Unit& u, int wr, int wc, int fr, int fq) const {
        const int row0 = u.pm * 256 + wr * 64 + fr; const int j = u.pn & 1;
#pragma unroll
        for (int ai = 0; ai < 2; ++ai)
#pragma unroll
            for (int m = 0; m < 4; ++m) {
                const int row = row0 + ai * 128 + m * 16;
#pragma unroll
                for (int bj = 0; bj < 2; ++bj) {
                    const int gi = 16 * bj + 4 * wc + fq;
                    const f32x4 g = acc[ai][bj][m][0], up = acc[ai][bj][m][1]; f32x4 h;
#pragma unroll
                    for (int q = 0; q < 4; ++q) h[q] = g[q] * sigmoidf_(g[q]) * up[q];
                    u32x2 w; w.x = cvt_pk_bf16(h[0], h[1]); w.y = cvt_pk_bf16(h[2], h[3]);
                    *(u32x2*)(H + (size_t)row * EH + 128 * j + 4 * gi) = w;
                }
            }
    }
};

struct Down {
    bf16_t* Y;
    __device__ __forceinline__ void operator()(const f32x4 (&acc)[2][2][4][2], const Unit& u, int wr, int wc, int fr, int fq) const {
        const int row0 = u.pm * 256 + wr * 64 + fr; const int col0 = wc * 32 + 8 * fq;
#pragma unroll
        for (int ai = 0; ai < 2; ++ai)
#pragma unroll
            for (int m = 0; m < 4; ++m) {
                const int row = row0 + ai * 128 + m * 16;
#pragma unroll
                for (int bj = 0; bj < 2; ++bj) *(u32x4*)(Y + (size_t)row * 256 + col0 + bj * 128) = pack8(acc[ai][bj][m][0], acc[ai][bj][m][1]);
            }
    }
};
}
struct Ctx { int tid, lane, wave, G, bid; unsigned char* ws; };

__device__ __forceinline__ void adaln_phase(const Params& p, const Ctx& C, char* lds) {
    float* s = (float*)lds;
    float* red = (float*)(lds + 9 * 1024 * 4);
    const float* c = p.in[I_C]; const float* cc = p.in[I_CCTX]; const float* W = p.in[I_ADAW]; const float* bias = p.in[I_ADAB];
    float* mod = (float*)(C.ws + WS_MOD); float* cmod = (float*)(C.ws + WS_CMOD);
    if (C.bid < 192) {
        for (int i = C.tid; i < 9 * 1024; i += 512) { const int b = i >> 10, k = i & 1023; const float v = b < 8 ? c[b * 1024 + k] : cc[k]; s[i] = v / (1.f + expf(-v)); }
        __syncthreads();
    }
    for (int item = C.bid; item < 192; item += C.G) {
        const int cl = C.tid & 31, kg = C.tid >> 5, col = item * 32 + cl;
        float acc[9];
#pragma unroll
        for (int b = 0; b < 9; ++b) acc[b] = 0.f;
        for (int k = kg; k < 1024; k += 16) { const float w = W[(size_t)k * 6144 + col];
#pragma unroll
            for (int b = 0; b < 9; ++b) acc[b] += s[b * 1024 + k] * w; }
#pragma unroll
        for (int b = 0; b < 9; ++b) red[(kg * 9 + b) * 32 + cl] = acc[b];
        __syncthreads();
        if (C.tid < 9 * 32) { const int b = C.tid >> 5, c2 = C.tid & 31, col2 = item * 32 + c2; float v = 0.f;
            for (int q = 0; q < 16; ++q) v += red[(q * 9 + b) * 32 + c2];
            v += bias[col2];
            if (b < 8) mod[b * 6144 + col2] = v; else if (col2 < 2048) cmod[col2] = v; }
        __syncthreads();
    }
    if (C.bid == (C.G > 200 ? 200 : 0) && C.tid < 64) {
        const float a = wave_sum(p.in[I_LQ1][C.tid] * p.in[I_LK1][C.tid]), b = wave_sum(p.in[I_LQ2][C.tid] * p.in[I_LK2][C.tid]);
        if (C.tid == 0) *(float*)(C.ws + WS_LAM) = expf(a) - expf(b) + 0.2f;
    }
}

__device__ __forceinline__ void hdn_phase(const Params& p, const Ctx& C) {
    const float* w1 = p.in[I_FW1]; const float* b1 = p.in[I_FB1]; const float* fr = p.in[I_FFR]; const float* w2 = p.in[I_FW2]; const float* b2 = p.in[I_FB2];
    float* hdn = (float*)(C.ws + WS_HDN);
    const int gw = C.bid * 8 + C.wave, NGW = C.G * 8, l = C.lane;
    for (int t = gw; t < SEQ; t += NGW) {
        float z = 0.f;
        if (l == 0) z = (float)((double)t / 4095.0);
        else if (l < 33) { const int bi = (l - 1) & 15; const double band = 1e-4 + (double)bi * ((15.0 - 1e-4) / 15.0); const double w = 6.283185307179586476925 * (double)t / 4096.0; const double a = band * w;
            z = (l < 17) ? (float)cos(a) : (float)(-sin(a)); }
        float h = b1[l];
        for (int i = 0; i < 33; ++i) h += __shfl(z, i) * w1[i * 64 + l];
        h = sinf(fr[l] * h);
        float h2 = b2[l];
        for (int i = 0; i < 64; ++i) h2 += __shfl(h, i) * w2[i * 64 + l];
        h2 = sinf(fr[l] * h2);
        hdn[t * 64 + l] = h2;
    }
}

__device__ __forceinline__ void transpose_item(const float* srcl, int ldw, bf16_t* dst, int K, float* scr, int lane) {
#pragma unroll 8
    for (int i = 0; i < 32; ++i) { const int kk = 2 * i + (lane >> 5); scr[kk * 33 + (lane & 31)] = srcl[(size_t)kk * ldw]; }
    asm volatile("s_waitcnt lgkmcnt(0)" ::: "memory");
    const int c = lane & 7;
#pragma unroll
    for (int j = 0; j < 4; ++j) { const int n = (lane >> 3) + 8 * j; const float* s = scr + (8 * c) * 33 + n;
        u32x4 o; o.x = cvt_pk_bf16(s[0 * 33], s[1 * 33]); o.y = cvt_pk_bf16(s[2 * 33], s[3 * 33]); o.z = cvt_pk_bf16(s[4 * 33], s[5 * 33]); o.w = cvt_pk_bf16(s[6 * 33], s[7 * 33]);
        *(u32x4*)(dst + (size_t)n * K + 8 * c) = o; }
    asm volatile("s_waitcnt lgkmcnt(0)" ::: "memory");
}
__device__ __forceinline__ int qk_src_col(int n) {
    const int blk = n & ~63, pp = n & 63, axis = pp >> 5, f = ((pp & 31) >> 3) * 4 + (pp & 3), half = (pp >> 2) & 1;
    return blk + axis * 32 + half * 16 + f;
}
__device__ __forceinline__ void wconv_mixer_phase(const Params& p, const Ctx& C, char* lds) {
    float* scr = (float*)(lds + C.wave * 16384);
    const int gw = C.bid * 8 + C.wave, NGW = C.G * 8, l31 = C.lane & 31;
    constexpr int I_IN = 16 * 256, I_SQ = 16 * 32, NIT = I_IN + 3 * I_SQ;
    for (int it = gw; it < NIT; it += NGW) {
        int r = it;
        if (r < I_IN) { const int kb = r / 256, nb = r % 256, k0 = 64 * kb, n0 = 32 * nb; const int n = n0 + l31;
            const int src = (n < 1024 || (n >= 2048 && n < 3072)) ? qk_src_col(n) : n;
            transpose_item(p.in[I_WIN] + (size_t)k0 * INW + src, INW, (bf16_t*)(C.ws + WS_WIN) + (size_t)n0 * 1024 + k0, 1024, scr, C.lane); continue; }
        r -= I_IN; const int which = r / I_SQ; r %= I_SQ;
        const float* W = which == 0 ? p.in[I_WPA] : which == 1 ? p.in[I_WPH] : p.in[I_WOUT];
        bf16_t* WT = (bf16_t*)(C.ws + (which == 0 ? WS_WPA : which == 1 ? WS_WPH : WS_WOUT));
        const int kb = r / 32, nb = r % 32, k0 = 64 * kb, n0 = 32 * nb;
        transpose_item(W + (size_t)k0 * 1024 + n0 + l31, 1024, WT + (size_t)n0 * 1024 + k0, 1024, scr, C.lane);
    }
}
__device__ __forceinline__ void wconv_moe_phase(const Params& p, const Ctx& C, char* lds) {
    float* scr = (float*)(lds + C.wave * 16384);
    const int gw = C.bid * 8 + C.wave, NGW = C.G * 8, l31 = C.lane & 31;
    constexpr int I_GU = 16 * 16, I_D = 4 * 32, NIT = 65 * (I_GU + I_D);
    for (int it = gw; it < NIT; it += NGW) {
        const int e = it / (I_GU + I_D); int r = it % (I_GU + I_D);
        if (r < I_GU) { const int kb = r / 16, nb = r % 16, k0 = 64 * kb, n0 = 32 * nb; const int n = n0 + l31;
            const int j = n >> 8, gi = (n & 255) >> 3, e8 = n & 7, i = 128 * j + 4 * gi + (e8 & 3);
            const float* mat = (e8 >> 2) ? (e < 64 ? p.in[I_EU] + (size_t)e * 1024 * 256 : p.in[I_SU]) : (e < 64 ? p.in[I_EG] + (size_t)e * 1024 * 256 : p.in[I_SG]);
            transpose_item(mat + (size_t)k0 * 256 + i, 256, (bf16_t*)(C.ws + WS_WGU) + ((size_t)e * 512 + n0) * 1024 + k0, 1024, scr, C.lane); continue; }
        r -= I_GU; const int kb = r / 32, nb = r % 32, k0 = 64 * kb, n0 = 32 * nb;
        const float* mat = e < 64 ? p.in[I_ED] + (size_t)e * 256 * 1024 : p.in[I_SD];
        transpose_item(mat + (size_t)k0 * 1024 + n0 + l31, 1024, (bf16_t*)(C.ws + WS_WD) + ((size_t)e * 1024 + n0) * 256 + k0, 256, scr, C.lane);
    }
}

__device__ __forceinline__ void hx_phase(const Params& p, const Ctx& C) {
    const float* mod = (const float*)(C.ws + WS_MOD); const float* cmod = (const float*)(C.ws + WS_CMOD); const float* g = p.in[I_N1G];
    bf16_t* HX = (bf16_t*)(C.ws + WS_HX);
    const int gw = C.bid * 8 + C.wave, NGW = C.G * 8;
    for (int r = gw; r < MROWS; r += NGW) {
        const float* xr; const float* sh; const float* sc;
        if (r < NTOK) { xr = p.in[I_X] + (size_t)r * DM; const int b = r >> 12; sh = mod + b * 6144; sc = sh + 1024; }
        else { xr = p.in[I_CTX] + (size_t)(r - NTOK) * DM; sh = cmod; sc = cmod + 1024; }
        f32x4 v[4]; float ss = 0.f;
#pragma unroll
        for (int j = 0; j < 4; ++j) { v[j] = *(const f32x4*)(xr + 256 * j + 4 * C.lane); ss += (v[j].x * v[j].x + v[j].y * v[j].y) + (v[j].z * v[j].z + v[j].w * v[j].w); }
        const float rn = 1.0f / sqrtf(wave_sum(ss) * (1.f / DM) + NORM_EPS);
#pragma unroll
        for (int j = 0; j < 4; ++j) { const int k = 256 * j + 4 * C.lane;
            const f32x4 gv = *(const f32x4*)(g + k), scv = *(const f32x4*)(sc + k), shv = *(const f32x4*)(sh + k);
            const f32x4 o = v[j] * rn * gv * (1.f + scv) + shv;
            u32x2 w; w.x = cvt_pk_bf16(o.x, o.y); w.y = cvt_pk_bf16(o.z, o.w);
            *(u32x2*)(HX + (size_t)r * DM + k) = w; }
    }
}
namespace att {
constexpr int KVBLK = 64, NT = LKV / KVBLK;
constexpr float SCALE = 0.125f, THR = 8.f;
constexpr int SHM_V = KVBLK * 128 * 2, SHM_K = KVBLK * 128 * 2;
#define KSWZ(row, colB) ((row) * 256 + ((colB) ^ (((row) & 7) << 4)))
#define SBAR() __builtin_amdgcn_sched_barrier(0)
__device__ __forceinline__ int crow(int r, int hi) { return (r & 3) + 8 * (r >> 2) + 4 * hi; }
__device__ __forceinline__ void partialSM(f32x16& p0, f32x16& p1, float& m_reg, float& mn, float& alpha) {
  constexpr float C = SCALE * 1.4426950408889634f;
  float pmax = p0[0];
#pragma unroll
  for (int r = 1; r < 16; ++r) pmax = fmaxf(pmax, p0[r]);
#pragma unroll
  for (int r = 0; r < 16; ++r) pmax = fmaxf(pmax, p1[r]);
  { auto rr = __builtin_amdgcn_permlane32_swap(__float_as_uint(pmax), __float_as_uint(pmax), false, false);
    pmax = fmaxf(__uint_as_float(rr[0]), __uint_as_float(rr[1])); }
  if (__builtin_expect(__all(pmax - m_reg <= THR / SCALE), 1)) { mn = m_reg; alpha = 1.f; }
  else { mn = fmaxf(m_reg, pmax); alpha = __builtin_amdgcn_exp2f((m_reg - mn) * C); m_reg = mn; }
  float mnC = -mn * C;
#pragma unroll
  for (int r = 0; r < 16; ++r) p0[r] = fmaf(p0[r], C, mnC);
#pragma unroll
  for (int r = 0; r < 16; ++r) p1[r] = fmaf(p1[r], C, mnC);
#pragma unroll
  for (int r = 0; r < 16; ++r) p0[r] = __builtin_amdgcn_exp2f(p0[r]);
}
__device__ __forceinline__ void finishSM(f32x16& p0, f32x16& p1, float alpha, float& l_reg, bf16x8& pa0, bf16x8& pa1, bf16x8& pa2, bf16x8& pa3) {
#pragma unroll
  for (int r = 0; r < 16; ++r) p1[r] = __builtin_amdgcn_exp2f(p1[r]);
  float ps = 0;
#pragma unroll
  for (int r = 0; r < 16; ++r) ps += p0[r];
#pragma unroll
  for (int r = 0; r < 16; ++r) ps += p1[r];
  { auto rr = __builtin_amdgcn_permlane32_swap(__float_as_uint(ps), __float_as_uint(ps), false, false);
    ps = __uint_as_float(rr[0]) + __uint_as_float(rr[1]); }
  l_reg = l_reg * alpha + ps;
#define PK4(P, BASE, OUT) do { unsigned a0 = cvt_pk_bf16(P[BASE + 0], P[BASE + 1]), a1 = cvt_pk_bf16(P[BASE + 2], P[BASE + 3]);   \
    unsigned b0 = cvt_pk_bf16(P[BASE + 4], P[BASE + 5]), b1 = cvt_pk_bf16(P[BASE + 6], P[BASE + 7]);                              \
    auto r0 = __builtin_amdgcn_permlane32_swap(a0, b0, false, false); auto r1 = __builtin_amdgcn_permlane32_swap(a1, b1, false, false); \
    u32x4 w = {r0[0], r1[0], r0[1], r1[1]}; OUT = *reinterpret_cast<bf16x8*>(&w); } while (0)
  PK4(p0, 0, pa0); PK4(p0, 8, pa1); PK4(p1, 0, pa2); PK4(p1, 8, pa3);
#undef PK4
}
__device__ __forceinline__ void qkt(f32x16& p0, f32x16& p1, const char* Ks, const bf16x8* qr, int r32, int hi, int mp) {
  p0 = f32x16{}; p1 = f32x16{};
#pragma unroll
  for (int d0 = 0; d0 < 4; ++d0) { const int cb = ((mp * 4 + d0) * 16 + hi * 8) * 2;
    const bf16x8 b0 = *reinterpret_cast<const bf16x8*>(Ks + KSWZ(r32, cb));
    const bf16x8 b1 = *reinterpret_cast<const bf16x8*>(Ks + KSWZ(32 + r32, cb));
    p0 = __builtin_amdgcn_mfma_f32_32x32x16_bf16(b0, qr[d0], p0, 0, 0, 0);
    p1 = __builtin_amdgcn_mfma_f32_32x32x16_bf16(b1, qr[d0], p1, 0, 0, 0); }
}
__device__ __forceinline__ int v_st(int k, int c) { const int kk = (k & ~0xC) | ((k & 4) << 1) | ((k & 8) >> 1); return ((kk >> 3) * 4 + (c >> 5)) * 512 + ((kk & 7) * 32 + (c & 31)) * 2; }
__device__ __forceinline__ int v_rd_base(int lane) { return ((lane & 3) << 3) | (((lane >> 2) & 3) << 6) | (((lane >> 4) & 1) << 5) | (((lane >> 5) & 1) << 8); }
constexpr int v_rd_off(int d0, int ks, int half) { return d0 * 512 + ks * 4096 + half * 2048; }
template <int OFF> __device__ __forceinline__ s16x4 tr_read(int vb) {
  s16x4 r; asm volatile("ds_read_b64_tr_b16 %0, %1 offset:%2" : "=&v"(r) : "v"(vb), "i"(OFF) : "memory"); return r;
}
template <int D0> __device__ __forceinline__ void pv_one(f32x16& od, int vb, bf16x8 pa0, bf16x8 pa1, bf16x8 pa2, bf16x8 pa3) {
  const s16x4 l0 = tr_read<v_rd_off(D0, 0, 0)>(vb), h0 = tr_read<v_rd_off(D0, 0, 1)>(vb), l1 = tr_read<v_rd_off(D0, 1, 0)>(vb), h1 = tr_read<v_rd_off(D0, 1, 1)>(vb);
  const s16x4 l2 = tr_read<v_rd_off(D0, 2, 0)>(vb), h2 = tr_read<v_rd_off(D0, 2, 1)>(vb), l3 = tr_read<v_rd_off(D0, 3, 0)>(vb), h3 = tr_read<v_rd_off(D0, 3, 1)>(vb);
  asm volatile("s_waitcnt lgkmcnt(0)" ::: "memory"); SBAR();
#define PK(L, H) (bf16x8){L[0], L[1], L[2], L[3], H[0], H[1], H[2], H[3]}
  od = __builtin_amdgcn_mfma_f32_32x32x16_bf16(pa0, PK(l0, h0), od, 0, 0, 0);
  od = __builtin_amdgcn_mfma_f32_32x32x16_bf16(pa1, PK(l1, h1), od, 0, 0, 0);
  od = __builtin_amdgcn_mfma_f32_32x32x16_bf16(pa2, PK(l2, h2), od, 0, 0, 0);
  od = __builtin_amdgcn_mfma_f32_32x32x16_bf16(pa3, PK(l3, h3), od, 0, 0, 0);
#undef PK
}
__device__ __forceinline__ void pv_d0(f32x16* o, int vb, bf16x8 pa0, bf16x8 pa1, bf16x8 pa2, bf16x8 pa3) {
  pv_one<0>(o[0], vb, pa0, pa1, pa2, pa3); pv_one<1>(o[1], vb, pa0, pa1, pa2, pa3); pv_one<2>(o[2], vb, pa0, pa1, pa2, pa3); pv_one<3>(o[3], vb, pa0, pa1, pa2, pa3);
}

__device__ __forceinline__ void attn_unit(const bf16_t* Qg, const bf16_t* Kall, const bf16_t* Vall, bf16_t* AX, float lam, const float* subg, int b, int h, int qb, char* lds) {
  constexpr int LDK = DM;
  int tid_ = threadIdx.x; asm volatile("" : "+v"(tid_));
  const int tid = tid_, wid = tid >> 6, lane = tid & 63, r32 = lane & 31, hi = lane >> 5, rg = wid & 3, mp = wid >> 2;
  char* V_lds = lds; char* K_lds = lds + 2 * SHM_V;
  float* wsf = (float*)(lds + 2 * SHM_V + 2 * SHM_K) + wid * 64; float* li_l = wsf; float* al_l = wsf + 32;
  const bf16_t* Kh = Kall + (size_t)b * LKV * DM + h * 128; const bf16_t* Vh = Vall + (size_t)b * LKV * DM + h * 128;
  float m_reg = -1e30f, l_reg = 0; f32x16 o[4] = {}; bf16x8 qr[4];
  const bf16_t* Qw = Qg + ((size_t)(b * SEQ + qb * 128 + rg * 32 + r32)) * DM + h * 128 + mp * 64 + hi * 8;
#pragma unroll
  for (int d0 = 0; d0 < 4; ++d0) qr[d0] = *reinterpret_cast<const bf16x8*>(Qw + d0 * 16);
  const int sr = tid >> 4, sc = (tid & 15) * 8, vst0 = v_st(sr, sc), vst1 = v_st(32 + sr, sc);
  const int vb0 = (int)(uintptr_t)V_lds + v_rd_base(lane);
  struct { bf16x8 vs0, vs1, ks0, ks1; } sr_[2];
#define SLOAD(i, k0) do { sr_[i].vs0 = *(const bf16x8*)(&Vh[(size_t)((k0) + sr) * LDK + sc]); sr_[i].vs1 = *(const bf16x8*)(&Vh[(size_t)((k0) + 32 + sr) * LDK + sc]); \
    sr_[i].ks0 = *(const bf16x8*)(&Kh[(size_t)((k0) + sr) * LDK + sc]); sr_[i].ks1 = *(const bf16x8*)(&Kh[(size_t)((k0) + 32 + sr) * LDK + sc]); } while (0)
#define SWRITE(bb, i) do { *(bf16x8*)(V_lds + (bb) * SHM_V + vst0) = sr_[i].vs0;          \
    *(bf16x8*)(V_lds + (bb) * SHM_V + vst1) = sr_[i].vs1; int kc = sc * 2;               \
    *(bf16x8*)(K_lds + (bb) * SHM_K + KSWZ(sr, kc)) = sr_[i].ks0;                       \
    *(bf16x8*)(K_lds + (bb) * SHM_K + KSWZ(32 + sr, kc)) = sr_[i].ks1; } while (0)
#define SWAIT() asm volatile("s_waitcnt vmcnt(4)" ::: "memory")
#define RESC(a) do { if (__any((a) < 1.f)) { if (hi == 0) al_l[r32] = (a); asm volatile("s_waitcnt lgkmcnt(0)" ::: "memory"); \
    _Pragma("unroll") for (int d = 0; d < 4; ++d) _Pragma("unroll") for (int r = 0; r < 16; ++r) o[d][r] *= al_l[crow(r, hi)]; } } while (0)
  f32x16 pA0, pA1, pB0, pB1; float mnA, mnB, alA, alB; bf16x8 pa0, pa1, pa2, pa3;
  constexpr int SE = 0, SO = 1;
  SLOAD(SE, 0); asm volatile("s_waitcnt vmcnt(0)" ::: "memory"); SWRITE(0, SE); __syncthreads();
  qkt(pA0, pA1, K_lds, qr, r32, hi, mp); partialSM(pA0, pA1, m_reg, mnA, alA);
  SLOAD(SO, KVBLK); SLOAD(SE, 2 * KVBLK);
  SWAIT(); SWRITE(1, SO); __syncthreads();
  for (int j = 1; j + 1 < NT; j += 2) {
    SBAR(); qkt(pB0, pB1, K_lds + SHM_K, qr, r32, hi, mp);
    finishSM(pA0, pA1, alA, l_reg, pa0, pa1, pa2, pa3); SBAR();
    SLOAD(SO, (j + 2) * KVBLK); SBAR();
    pv_d0(o, vb0, pa0, pa1, pa2, pa3); partialSM(pB0, pB1, m_reg, mnB, alB);
    __syncthreads(); SWAIT(); SWRITE(0, SE);
    RESC(alB); __syncthreads();
    SBAR(); qkt(pA0, pA1, K_lds, qr, r32, hi, mp);
    finishSM(pB0, pB1, alB, l_reg, pa0, pa1, pa2, pa3); SBAR();
    if (j + 3 < NT) SLOAD(SE, (j + 3) * KVBLK); SBAR();
    pv_d0(o, vb0 + SHM_V, pa0, pa1, pa2, pa3); partialSM(pA0, pA1, m_reg, mnA, alA);
    __syncthreads(); SWAIT(); SWRITE(1, SO);
    RESC(alA); __syncthreads();
  }
  SBAR(); qkt(pB0, pB1, K_lds + SHM_K, qr, r32, hi, mp);
  finishSM(pA0, pA1, alA, l_reg, pa0, pa1, pa2, pa3); SBAR();
  pv_d0(o, vb0, pa0, pa1, pa2, pa3); partialSM(pB0, pB1, m_reg, mnB, alB);
  __syncthreads(); RESC(alB);
  finishSM(pB0, pB1, alB, l_reg, pa0, pa1, pa2, pa3); SBAR();
  pv_d0(o, vb0 + SHM_V, pa0, pa1, pa2, pa3);
  if (hi == 0) li_l[r32] = l_reg; asm volatile("s_waitcnt lgkmcnt(0)" ::: "memory");
  float rli[16];
#pragma unroll
  for (int r = 0; r < 16; ++r) rli[r] = __builtin_amdgcn_rcpf(li_l[crow(r, hi)]);
  __syncthreads();
  { float* Ob = (float*)lds + (size_t)(mp * 128 + rg * 32) * 132;
#pragma unroll
    for (int r = 0; r < 16; ++r) { const int orow = crow(r, hi);
#pragma unroll
      for (int d0 = 0; d0 < 4; ++d0) Ob[orow * 132 + d0 * 32 + r32] = o[d0][r] * rli[r]; } }
  __syncthreads();
  { const int row = tid >> 2, q4 = tid & 3;
    const float* o0 = (const float*)lds + (size_t)row * 132 + q4 * 32; const float* o1 = o0 + 128 * 132;
    float d[32]; float ss = 0.f;
#pragma unroll
    for (int i = 0; i < 32; i += 4) { const f32x4 a = *(const f32x4*)(o0 + i), c = *(const f32x4*)(o1 + i);
#pragma unroll
      for (int q = 0; q < 4; ++q) { d[i + q] = a[q] - lam * c[q]; ss += d[i + q] * d[i + q]; } }
    ss += __shfl_xor(ss, 1); ss += __shfl_xor(ss, 2);
    const float rn = 0.8f / sqrtf(ss * (1.f / 128.f) + NORM_EPS);
    bf16_t* op = AX + ((size_t)(b * SEQ + qb * 128 + row)) * DM + h * 128 + q4 * 32; const float* gp = subg + q4 * 32;
#pragma unroll
    for (int i = 0; i < 32; i += 8) { u32x4 w;
      w.x = cvt_pk_bf16(d[i] * rn * gp[i], d[i + 1] * rn * gp[i + 1]); w.y = cvt_pk_bf16(d[i + 2] * rn * gp[i + 2], d[i + 3] * rn * gp[i + 3]);
      w.z = cvt_pk_bf16(d[i + 4] * rn * gp[i + 4], d[i + 5] * rn * gp[i + 5]); w.w = cvt_pk_bf16(d[i + 6] * rn * gp[i + 6], d[i + 7] * rn * gp[i + 7]);
      *(u32x4*)(op + i) = w; } }
  __syncthreads();
#undef SLOAD
#undef SWRITE
#undef SWAIT
#undef RESC
}
__device__ __forceinline__ void attn_phase(const Ctx& C, const float* subg, char* lds) {
  const bf16_t* Qg = (const bf16_t*)(C.ws + WS_Q); const bf16_t* Kall = (const bf16_t*)(C.ws + WS_K); const bf16_t* Vall = (const bf16_t*)(C.ws + WS_V);
  const float lam = *(const float*)(C.ws + WS_LAM);
  if (C.G == 256) { const int vcu = (C.bid & 7) * 32 + (C.bid >> 3);
    for (int i = 0; i < 8; ++i) { const int bh = (vcu >> 5) * 8 + i, qb = vcu & 31; attn_unit(Qg, Kall, Vall, (bf16_t*)(C.ws + WS_Q), lam, subg, bh >> 3, bh & 7, qb, lds); }
  } else {
    for (int L = C.bid; L < 2048; L += C.G) attn_unit(Qg, Kall, Vall, (bf16_t*)(C.ws + WS_Q), lam, subg, L >> 8, (L >> 5) & 7, L & 31, lds);
  }
}
#undef KSWZ
#undef SBAR
}
namespace hyn {
__device__ __forceinline__ float block_sum(float v, float* red, int tid) {
    v = wave_sum(v);
    __syncthreads();
    if ((tid & 63) == 0) red[tid >> 6] = v;
    __syncthreads();
    float s = 0.f;
#pragma unroll
    for (int i = 0; i < 8; ++i) s += red[i];
    return s;
}
__device__ __forceinline__ void build_kernel(const Params& p, const Ctx& C, int o, int c, float* kern, float* w3s, float* red) {
    const float* hdn = (const float*)(C.ws + WS_HDN); const float* w3 = p.in[I_FW3];
    __syncthreads();
    if (C.tid < 128) { const int dir = C.tid >> 6, k = C.tid & 63; w3s[C.tid] = w3[(size_t)k * 4096 + o * 2048 + dir * 1024 + c]; }
    __syncthreads();
    const float a = -3.0701134573253944f, bq = -15.350567286626972f;
    const float delta = fabsf(a + (float)c * ((bq - a) / 1023.f));
    float hf[8], hb[8]; float asum = 0.f;
#pragma unroll
    for (int j = 0; j < 8; ++j) { const int t = C.tid + 512 * j; const float* hr = hdn + t * 64; float sf = 0.f, sb = 0.f;
#pragma unroll 8
        for (int k = 0; k < 64; ++k) { const float hv = hr[k]; sf += hv * w3s[k]; sb += hv * w3s[64 + k]; }
        const float dec = expf(-((float)t * (1.f / 4095.f)) * delta);
        hf[j] = sf * dec; hb[j] = sb * dec; asum += fabsf(hf[j]) + (t > 0 ? fabsf(hb[j]) : 0.f); }
    const float tot = block_sum(asum, red, C.tid); const float inv = 1.f / tot;
#pragma unroll
    for (int j = 0; j < 8; ++j) { const int t = C.tid + 512 * j; kern[4096 + t] = hf[j] * inv; if (t > 0) kern[4096 - t] = hb[j] * inv; }
    if (C.tid == 0) kern[0] = 0.f;
    __syncthreads();
}
__device__ __forceinline__ void hyena_naive_phase(const Params& p, const Ctx& C, char* lds) {
    float* kern = (float*)lds;
    float* zb = (float*)(lds + 32768);
    float* w3s = (float*)(lds + 32768 + 65536);
    float* red = w3s + 128;
    const bf16_t* UT = (const bf16_t*)(C.ws + WS_UT); bf16_t* YX = (bf16_t*)(C.ws + WS_HX);
    const float* cw = p.in[I_HCW]; const float* cb = p.in[I_HCB]; const float* hyb = p.in[I_HYB];
    for (int unit = C.bid; unit < 2048; unit += C.G) {
        const int c = unit >> 1, bh = unit & 1;
        float vreg[8][4];
#pragma unroll
        for (int j = 0; j < 8; ++j) { const int t = C.tid + 512 * j;
#pragma unroll
            for (int bb = 0; bb < 4; ++bb) { const bf16_t* u = UT + ((size_t)(bh * 4 + bb) * 3072 + c) * SEQ;
                const float um = t > 0 ? bf2f(u[t - 1]) : 0.f, u0 = bf2f(u[t]), up = t < SEQ - 1 ? bf2f(u[t + 1]) : 0.f;
                vreg[j][bb] = um * cw[c] + u0 * cw[3072 + c] + up * cw[6144 + c] + cb[c]; } }
        for (int o = 0; o < 2; ++o) {
            build_kernel(p, C, o, c, kern, w3s, red);
#pragma unroll
            for (int j = 0; j < 8; ++j) { const int t = C.tid + 512 * j; *(f32x4*)(zb + t * 4) = (f32x4){vreg[j][0], vreg[j][1], vreg[j][2], vreg[j][3]}; }
            __syncthreads();
            float acc[8][4];
#pragma unroll
            for (int j = 0; j < 8; ++j)
#pragma unroll
                for (int bb = 0; bb < 4; ++bb) acc[j][bb] = 0.f;
            for (int s = 0; s < SEQ; ++s) { const f32x4 z4 = *(const f32x4*)(zb + s * 4);
#pragma unroll
                for (int j = 0; j < 8; ++j) { const float kv = kern[4096 + C.tid + 512 * j - s];
#pragma unroll
                    for (int bb = 0; bb < 4; ++bb) acc[j][bb] += kv * z4[bb]; } }
            const float bias = hyb[o * 1024 + c]; const int xc = (o + 1) * 1024 + c;
#pragma unroll
            for (int j = 0; j < 8; ++j) { const int t = C.tid + 512 * j;
#pragma unroll
                for (int bb = 0; bb < 4; ++bb) { const bf16_t* u = UT + ((size_t)(bh * 4 + bb) * 3072 + xc) * SEQ;
                    const float um = t > 0 ? bf2f(u[t - 1]) : 0.f, u0 = bf2f(u[t]), up = t < SEQ - 1 ? bf2f(u[t + 1]) : 0.f;
                    const float xg = um * cw[xc] + u0 * cw[3072 + xc] + up * cw[6144 + xc] + cb[xc];
                    vreg[j][bb] = xg * (acc[j][bb] + vreg[j][bb] * bias); } }
            __syncthreads();
        }
#pragma unroll
        for (int j = 0; j < 8; ++j) { const int t = C.tid + 512 * j;
#pragma unroll
            for (int bb = 0; bb < 4; ++bb) YX[((size_t)(bh * 4 + bb) * SEQ + t) * DM + c] = (bf16_t)(cvt_pk_bf16(vreg[j][bb], 0.f) & 0xffffu); }
    }
}
}
namespace hym {
constexpr size_t WS_TAB0 = WS_WIN;
constexpr size_t WS_TAB1 = 492 * MiB;
constexpr int ZBLK = 134, ZHS = ZBLK * 256, Z_BYTES = 2 * ZHS;
constexpr int KCS = 16448, KC_OFF = Z_BYTES, KC_BYTES = 4 * KCS, SCR_OFF = KC_OFF + KC_BYTES;
static_assert(SCR_OFF + 256 <= 147456, "hyena LDS");

__device__ __forceinline__ void table_phase(const Params& p, const Ctx& C, char* lds) {
    const float* hdn = (const float*)(C.ws + WS_HDN); const float* w3 = p.in[I_FW3];
    float* w3s = (float*)lds;
    float* red = w3s + 512;
    for (int unit = C.bid; unit < 512; unit += C.G) {
        const int o = unit >> 8, c0 = (unit & 255) * 4;
        __syncthreads();
        int tq = C.tid; asm volatile("" : "+v"(tq));
        { const int col = C.tid >> 6, k = C.tid & 63; const int dir = col >> 2, cc = col & 3; w3s[col * 64 + k] = w3[(size_t)k * 4096 + o * 2048 + dir * 1024 + c0 + cc]; }
        __syncthreads();
        float dl[4];
#pragma unroll
        for (int cc = 0; cc < 4; ++cc) { const float a = -3.0701134573253944f, bq = -15.350567286626972f; dl[cc] = fabsf(a + (float)(c0 + cc) * ((bq - a) / 1023.f)); }
        float h[8][8]; float asum[4] = {0.f, 0.f, 0.f, 0.f};
#pragma unroll
        for (int j = 0; j < 8; ++j) { const int t = tq + 512 * j; const float* hr = hdn + t * 64;
            float s[8];
#pragma unroll
            for (int q = 0; q < 8; ++q) s[q] = 0.f;
#pragma unroll 4
            for (int k4 = 0; k4 < 16; ++k4) { const f32x4 hv = *(const f32x4*)(hr + 4 * k4);
#pragma unroll
                for (int q = 0; q < 8; ++q) { const f32x4 wv = *(const f32x4*)(w3s + q * 64 + 4 * k4); s[q] += hv[0] * wv[0] + hv[1] * wv[1] + hv[2] * wv[2] + hv[3] * wv[3]; } }
            const float tn = (float)t * (1.f / 4095.f);
#pragma unroll
            for (int cc = 0; cc < 4; ++cc) { const float dec = expf(-tn * dl[cc]); h[j][cc] = s[cc] * dec; h[j][4 + cc] = s[4 + cc] * dec; asum[cc] += fabsf(h[j][cc]) + (t > 0 ? fabsf(h[j][4 + cc]) : 0.f); } }
#pragma unroll
        for (int cc = 0; cc < 4; ++cc) asum[cc] = wave_sum(asum[cc]);
        if (C.lane == 0) { red[C.wave * 4 + 0] = asum[0]; red[C.wave * 4 + 1] = asum[1]; red[C.wave * 4 + 2] = asum[2]; red[C.wave * 4 + 3] = asum[3]; }
        __syncthreads();
        float inv[4];
#pragma unroll
        for (int cc = 0; cc < 4; ++cc) { float s = 0.f;
#pragma unroll
            for (int w = 0; w < 8; ++w) s += red[w * 4 + cc];
            inv[cc] = 1.f / s; }
        bf16_t* tab = (bf16_t*)(C.ws + (o ? WS_TAB1 : WS_TAB0));
#pragma unroll
        for (int cc = 0; cc < 4; ++cc) { bf16_t* row = tab + (size_t)(c0 + cc) * 8192;
#pragma unroll
            for (int j = 0; j < 8; ++j) { const int t = tq + 512 * j;
                row[4096 - t] = (bf16_t)(cvt_pk_bf16(h[j][cc] * inv[cc], 0.f) & 0xffffu);
                if (t > 0) row[4096 + t] = (bf16_t)(cvt_pk_bf16(h[j][4 + cc] * inv[cc], 0.f) & 0xffffu); }
            if (C.tid == 0) row[0] = 0; }
    }
}

__device__ __forceinline__ int zaddr(int b, int t) {
    const int tp = t + 96, Jp = tp >> 5, g = (tp >> 3) & 3;
    return (b >> 2) * ZHS + Jp * 256 + ((((g ^ (Jp & 3)) << 2) | (b & 3)) << 4) + (tp & 7) * 2;
}
__device__ __forceinline__ void conv3_8(const bf16_t* urow, int t0, float w0, float w1, float w2, float bias, float (&out)[8]) {
    const u32x4 raw = *(const u32x4*)(urow + t0);
    float u[10];
    u[0] = t0 > 0 ? bf2f(urow[t0 - 1]) : 0.f; u[9] = (t0 + 8 < SEQ) ? bf2f(urow[t0 + 8]) : 0.f;
    u[1] = bflo(raw.x); u[2] = bfhi(raw.x); u[3] = bflo(raw.y); u[4] = bfhi(raw.y); u[5] = bflo(raw.z); u[6] = bfhi(raw.z); u[7] = bflo(raw.w); u[8] = bfhi(raw.w);
#pragma unroll
    for (int e = 0; e < 8; ++e) out[e] = u[e] * w0 + u[e + 1] * w1 + u[e + 2] * w2 + bias;
}
__device__ __forceinline__ u32x4 pack8f(const float (&v)[8]) { u32x4 w; w.x = cvt_pk_bf16(v[0], v[1]); w.y = cvt_pk_bf16(v[2], v[3]); w.z = cvt_pk_bf16(v[4], v[5]); w.w = cvt_pk_bf16(v[6], v[7]); return w; }

__device__ __forceinline__ void build_kc(const bf16_t* trow, char* lds, int tid) {
#pragma unroll
    for (int q = 0; q < 2; ++q) { const int m = tid + 512 * q;
        const u32x4 cur = *(const u32x4*)(trow + 8 * m); u32x4 prv = {0u, 0u, 0u, 0u}; if (m > 0) prv = *(const u32x4*)(trow + 8 * m - 8);
        const unsigned s2 = prv.z, s3 = prv.w, s4 = cur.x, s5 = cur.y, s6 = cur.z, s7 = cur.w;
        const u32x4 c0 = cur;
        const u32x4 c1 = {__builtin_amdgcn_alignbit(s4, s3, 16), __builtin_amdgcn_alignbit(s5, s4, 16), __builtin_amdgcn_alignbit(s6, s5, 16), __builtin_amdgcn_alignbit(s7, s6, 16)};
        const u32x4 c2 = {s3, s4, s5, s6};
        const u32x4 c3 = {__builtin_amdgcn_alignbit(s3, s2, 16), __builtin_amdgcn_alignbit(s4, s3, 16), __builtin_amdgcn_alignbit(s5, s4, 16), __builtin_amdgcn_alignbit(s6, s5, 16)};
        *(u32x4*)(lds + KC_OFF + 0 * KCS + 16 * m) = c0; *(u32x4*)(lds + KC_OFF + 1 * KCS + 16 * m) = c1;
        *(u32x4*)(lds + KC_OFF + 2 * KCS + 16 * m) = c2; *(u32x4*)(lds + KC_OFF + 3 * KCS + 16 * m) = c3; }
}

__device__ __forceinline__ void conv_loop(f32x16 (&acc)[4], const char* lds, int wave, int lane) {
    const int i = lane & 31, hh = lane >> 5, jj = (lane >> 3) & 3, bq = lane & 3, bhh = (lane >> 2) & 1;
    const int Xb = 16 * wave;
    for (int dm = 0; dm < 4; ++dm) {
        const int dlo = Xb - 127 + ((dm - (Xb - 127)) & 3);
        const int sw = (jj + 3 - dm) & 3;
        const char* pB0 = lds + bhh * ZHS + bq * 16 + (((hh) ^ sw) << 6) + (jj + 3) * 256 + (Xb - dlo) * 256;
        const char* pB1 = lds + bhh * ZHS + bq * 16 + (((2 + hh) ^ sw) << 6) + (jj + 3) * 256 + (Xb - dlo) * 256;
        const char* pA = lds + KC_OFF + (i & 3) * KCS + 2 * (4096 - (i & ~3) + 8 * hh) - 64 * dlo;
#pragma unroll 1
        for (int d = dlo; d <= Xb + 15; d += 4) {
            const s16x4 a00 = *(const s16x4*)(pA), a01 = *(const s16x4*)(pA + 8), a10 = *(const s16x4*)(pA + 32), a11 = *(const s16x4*)(pA + 40);
            const bf16x8 a0 = {a00[0], a00[1], a00[2], a00[3], a01[0], a01[1], a01[2], a01[3]}, a1 = {a10[0], a10[1], a10[2], a10[3], a11[0], a11[1], a11[2], a11[3]};
#pragma unroll
            for (int k = 0; k < 4; ++k) { const int J0 = Xb + 4 * k - d;
                if (J0 >= -3 && J0 <= 127) {
                    const bf16x8 b0 = *(const bf16x8*)(pB0 + k * 1024), b1 = *(const bf16x8*)(pB1 + k * 1024);
                    acc[k] = __builtin_amdgcn_mfma_f32_32x32x16_bf16(a0, b0, acc[k], 0, 0, 0);
                    acc[k] = __builtin_amdgcn_mfma_f32_32x32x16_bf16(a1, b1, acc[k], 0, 0, 0); } }
            pA -= 256; pB0 -= 1024; pB1 -= 1024;
        }
    }
}

__device__ __forceinline__ void hyena_phase(const Params& p, const Ctx& C, char* lds) {
    const bf16_t* UT = (const bf16_t*)(C.ws + WS_UT); bf16_t* YX = (bf16_t*)(C.ws + WS_HX);
    const float* cw = p.in[I_HCW]; const float* cb = p.in[I_HCB]; const float* hyb = p.in[I_HYB];
    const int lane = C.lane, wave = C.wave, tid = C.tid;
    __syncthreads();
    if (tid < 384) { const int bh = tid / 192, r = tid % 192, blk = r / 32, off = (r % 32) * 8; const int Jp = blk < 3 ? blk : 128 + blk;
        *(unsigned long long*)(lds + bh * ZHS + Jp * 256 + off) = 0ull; }
    for (int c = C.bid; c < 1024; c += C.G) {
        __syncthreads();
        { const bf16_t* urow = UT + ((size_t)wave * 3072 + c) * SEQ; const float w0 = cw[c], w1 = cw[3072 + c], w2 = cw[6144 + c], bs = cb[c];
#pragma unroll 2
            for (int ch = 0; ch < 8; ++ch) { const int t0 = ch * 512 + lane * 8; float v[8]; conv3_8(urow, t0, w0, w1, w2, bs, v); *(u32x4*)(lds + zaddr(wave, t0)) = pack8f(v); } }
#pragma unroll 1
        for (int o = 0; o < 2; ++o) {
            build_kc((const bf16_t*)(C.ws + (o ? WS_TAB1 : WS_TAB0)) + (size_t)c * 8192, lds, tid);
            __syncthreads();
            f32x16 acc[4];
#pragma unroll
            for (int k = 0; k < 4; ++k) acc[k] = f32x16{};
            conv_loop(acc, lds, wave, lane);
            __syncthreads();
            { const int xc = (o + 1) * 1024 + c; const bf16_t* urow = UT + ((size_t)wave * 3072 + xc) * SEQ; const float w0 = cw[xc], w1 = cw[3072 + xc], w2 = cw[6144 + xc], bs = cb[xc];
#pragma unroll 2
                for (int ch = 0; ch < 8; ++ch) { const int t0 = ch * 512 + lane * 8; float v[8]; conv3_8(urow, t0, w0, w1, w2, bs, v); *(u32x4*)(lds + KC_OFF + wave * 8192 + t0 * 2) = pack8f(v); } }
            __syncthreads();
            const float bias = hyb[o * 1024 + c];
            int lb = lane; asm volatile("" : "+v"(lb));
            const int b = lb & 7, jj = (lb >> 3) & 3, hi = lb >> 5, sw = (jj + 3) & 3;
            const int zb = (b >> 2) * ZHS + (16 * wave + jj + 3) * 256 + ((b & 3) << 4) + 8 * hi;
            const int xb = KC_OFF + b * 8192 + 64 * (16 * wave + jj) + 8 * hi;
            bf16_t* yb = YX + ((size_t)b * SEQ + 32 * (16 * wave + jj) + 4 * hi) * DM + c;
#pragma unroll
            for (int g = 0; g < 4; ++g) { const int zg = zb + ((g ^ sw) << 6);
#pragma unroll
                for (int k = 0; k < 4; ++k)
#pragma unroll
                    for (int q = 0; q < 4; ++q) { const int r = 4 * g + q;
                        bf16_t* zp = (bf16_t*)(lds + zg + k * 1024 + 2 * q);
                        const float zin = bf2f(*zp), xg = bf2f(*(const bf16_t*)(lds + xb + k * 256 + 2 * q + 16 * g));
                        const float val = xg * (acc[k][r] + zin * bias);
                        const bf16_t ob = (bf16_t)(cvt_pk_bf16(val, 0.f) & 0xffffu);
                        if (o == 0) *zp = ob; else yb[(size_t)(128 * k + q + 8 * g) * DM] = ob; } }
            __syncthreads();
        }
    }
}
}
namespace moe {
__device__ __forceinline__ void route_phase(const Params& p, const Ctx& C, const float* xnew, char* lds) {
    const float* mod = (const float*)(C.ws + WS_MOD); const float* g = p.in[I_N2G]; const float* rw = p.in[I_RW]; const float* rb = p.in[I_RB];
    bf16_t* HX2 = (bf16_t*)(C.ws + WS_HX); int* eidx = (int*)(C.ws + WS_EIDX); float* wsel = (float*)(C.ws + WS_WSEL); int* counts = (int*)(C.ws + WS_CNT);
    float* hb = (float*)(lds + C.wave * 16384);
    int* hist = (int*)(lds + 8 * 16384);
    if (C.tid < 64) hist[C.tid] = 0;
    __syncthreads();
    const int gw = C.bid * 8 + C.wave, NGW = C.G * 8, lane = C.lane;
    const float bias = rb[lane];
    for (int grp = gw; grp < NTOK / 4; grp += NGW) {
        const int tok0 = grp * 4; const int b = tok0 >> 12;
        const float* sh = mod + b * 6144 + 3072; const float* sc = sh + 1024;
        f32x4 v[4][4];
#pragma unroll
        for (int i = 0; i < 4; ++i) { const float* xr = xnew + (size_t)(tok0 + i) * DM; float ss = 0.f;
#pragma unroll
            for (int j = 0; j < 4; ++j) { v[i][j] = *(const f32x4*)(xr + 256 * j + 4 * lane); ss += (v[i][j].x * v[i][j].x + v[i][j].y * v[i][j].y) + (v[i][j].z * v[i][j].z + v[i][j].w * v[i][j].w); }
            const float rn = 1.0f / sqrtf(wave_sum(ss) * (1.f / DM) + NORM_EPS);
#pragma unroll
            for (int j = 0; j < 4; ++j) { const int k = 256 * j + 4 * lane;
                const f32x4 gv = *(const f32x4*)(g + k), scv = *(const f32x4*)(sc + k), shv = *(const f32x4*)(sh + k);
                v[i][j] = v[i][j] * rn * gv * (1.f + scv) + shv;
                u32x2 w; w.x = cvt_pk_bf16(v[i][j].x, v[i][j].y); w.y = cvt_pk_bf16(v[i][j].z, v[i][j].w);
                *(u32x2*)(HX2 + (size_t)(tok0 + i) * DM + k) = w; } }
#pragma unroll
        for (int j = 0; j < 4; ++j)
#pragma unroll
            for (int e = 0; e < 4; ++e) { const int k = 256 * j + 4 * lane + e; *(f32x4*)(hb + k * 4) = (f32x4){v[0][j][e], v[1][j][e], v[2][j][e], v[3][j][e]}; }
        asm volatile("s_waitcnt lgkmcnt(0)" ::: "memory");
        float acc[4] = {0.f, 0.f, 0.f, 0.f};
#pragma unroll 8
        for (int k = 0; k < DM; ++k) { const float w = rw[k * 64 + lane]; const f32x4 h4 = *(const f32x4*)(hb + k * 4);
            acc[0] += h4[0] * w; acc[1] += h4[1] * w; acc[2] += h4[2] * w; acc[3] += h4[3] * w; }
#pragma unroll
        for (int i = 0; i < 4; ++i) {
            const float s = 1.f / (1.f + expf(-acc[i])); const float ch = s + bias;
            float m1 = ch; m1 = fmaxf(m1, __shfl_xor(m1, 1)); m1 = fmaxf(m1, __shfl_xor(m1, 2)); m1 = fmaxf(m1, __shfl_xor(m1, 4));
            const unsigned long long eq = __ballot(ch == m1); const int gidx = lane >> 3; const unsigned gm = (unsigned)(eq >> (8 * gidx)) & 0xffu; const int first = __builtin_ctz(gm);
            float c2 = ((lane & 7) == first) ? -INFINITY : ch;
            float m2 = c2; m2 = fmaxf(m2, __shfl_xor(m2, 1)); m2 = fmaxf(m2, __shfl_xor(m2, 2)); m2 = fmaxf(m2, __shfl_xor(m2, 4));
            const float gs = m1 + m2; int grank = 0;
#pragma unroll
            for (int g2 = 0; g2 < 8; ++g2) { const float ov = __shfl(gs, 8 * g2); grank += (ov > gs || (ov == gs && g2 < gidx)) ? 1 : 0; }
            const bool gsel = grank < 4; const float mc = gsel ? ch : -INFINITY; int rank = 0;
#pragma unroll 16
            for (int e2 = 0; e2 < 64; ++e2) { const float ov = __shfl(mc, e2); rank += (ov > mc || (ov == mc && e2 < lane)) ? 1 : 0; }
            const bool sel = gsel && rank < 8;
            const float tot = wave_sum(sel ? s : 0.f);
            if (sel) { eidx[(tok0 + i) * 8 + rank] = lane; wsel[(tok0 + i) * 8 + rank] = s / tot * 2.5f; atomicAdd(&hist[lane], 1); }
        }
    }
    __syncthreads();
    if (C.tid < 64 && hist[C.tid] > 0) atomicAdd(&counts[C.tid], hist[C.tid]);
}

__device__ __forceinline__ void place_phase(const Ctx& C, char* lds) {
    int* counts = (int*)(C.ws + WS_CNT); int* cursor = counts + 64; int* ntp = counts + 128; int* tile_e = (int*)(C.ws + WS_TILEE);
    int* row_tok = (int*)(C.ws + WS_ROWTOK); int* pos = (int*)(C.ws + WS_POS); const int* eidx = (const int*)(C.ws + WS_EIDX);
    int* pst = (int*)lds;
    int* lh = pst + 80;
    int* lbase = lh + 64;
    if (C.tid == 0) { int a = 0; for (int e = 0; e < 64; ++e) { pst[e] = a; const int cnt = __hip_atomic_load(counts + e, __ATOMIC_RELAXED, __HIP_MEMORY_SCOPE_AGENT); a += (cnt + 255) / 256 * 256; } pst[64] = a; }
    __syncthreads();
    const int P = pst[64];
    if (C.bid == 0) {
        if (C.tid == 0) *ntp = P / 256 + 128;
        for (int t = C.tid; t < P / 256 + 128; t += 512) { int e = 64; const int r = t * 256; if (r < P) { e = 0; while (pst[e + 1] <= r) ++e; } tile_e[t] = e; }
    }
    for (int chunk = C.bid; chunk < NTOK / 128; chunk += C.G) {
        if (C.tid < 64) lh[C.tid] = 0;
        __syncthreads();
        int e_[2], lr_[2];
#pragma unroll
        for (int q = 0; q < 2; ++q) { const int a = C.tid + 512 * q; const int tok = chunk * 128 + (a >> 3); e_[q] = eidx[tok * 8 + (a & 7)]; lr_[q] = atomicAdd(&lh[e_[q]], 1); }
        __syncthreads();
        if (C.tid < 64) lbase[C.tid] = lh[C.tid] > 0 ? atomicAdd(&cursor[C.tid], lh[C.tid]) : 0;
        __syncthreads();
#pragma unroll
        for (int q = 0; q < 2; ++q) { const int a = C.tid + 512 * q; const int tok = chunk * 128 + (a >> 3); const int dest = pst[e_[q]] + lbase[e_[q]] + lr_[q]; row_tok[dest] = tok; pos[tok * 8 + (a & 7)] = dest; }
        __syncthreads();
    }
    for (int tok = C.bid * 512 + C.tid; tok < NTOK; tok += C.G * 512) row_tok[P + tok] = tok;
}

struct MoeOrder {
    const int* tile_e; int NT, G, c, NJ, PNE, colq;
    __device__ bool next(int i, pg8::Unit& u) const {
        const long L = (long)i * G + c; if (L >= (long)NT * NJ) return false;
        const int t = (int)(L / NJ), j = (int)(L % NJ);
        u.pm = t; u.pn = __hip_atomic_load(tile_e + t, __ATOMIC_RELAXED, __HIP_MEMORY_SCOPE_AGENT) * PNE + (NJ == 2 ? j : colq); return true;
    }
};

template <bool LAST>
__device__ __forceinline__ void combine_phase(const Params& p, const Ctx& C, int q) {
    const float* mod = (const float*)(C.ws + WS_MOD); const bf16_t* Y = (const bf16_t*)(C.ws + WS_Y);
    const int* pos = (const int*)(C.ws + WS_POS); const float* wsel = (const float*)(C.ws + WS_WSEL);
    const int NT = __hip_atomic_load((const int*)(C.ws + WS_CNT) + 128, __ATOMIC_RELAXED, __HIP_MEMORY_SCOPE_AGENT); const int P = (NT - 128) * 256;
    float* out = p.out; const float* fg = p.in[I_FNG];
    const int gw = C.bid * 8 + C.wave, NGW = C.G * 8, lane = C.lane;
    for (int tok = gw; tok < NTOK; tok += NGW) {
        const int b = tok >> 12; const float* g2 = mod + b * 6144 + 5120 + 256 * q + 4 * lane;
        f32x4 a = {0.f, 0.f, 0.f, 0.f};
#pragma unroll
        for (int k = 0; k < 8; ++k) { const int r = pos[tok * 8 + k]; const float w = wsel[tok * 8 + k]; const u32x2 y = *(const u32x2*)(Y + (size_t)r * 256 + 4 * lane);
            a[0] += w * bflo(y.x); a[1] += w * bfhi(y.x); a[2] += w * bflo(y.y); a[3] += w * bfhi(y.y); }
        { const u32x2 y = *(const u32x2*)(Y + (size_t)(P + tok) * 256 + 4 * lane); a[0] += bflo(y.x); a[1] += bfhi(y.x); a[2] += bflo(y.y); a[3] += bfhi(y.y); }
        float* op = out + (size_t)tok * DM;
        const f32x4 xo = *(const f32x4*)(op + 256 * q + 4 * lane); const f32x4 gv = *(const f32x4*)g2;
        const f32x4 xn = xo + gv * a;
        if (!LAST) { *(f32x4*)(op + 256 * q + 4 * lane) = xn; }
        else {
            f32x4 v[4]; float ss = 0.f;
#pragma unroll
            for (int j = 0; j < 4; ++j) { v[j] = (j == 3) ? xn : *(const f32x4*)(op + 256 * j + 4 * lane); ss += (v[j].x * v[j].x + v[j].y * v[j].y) + (v[j].z * v[j].z + v[j].w * v[j].w); }
            const float rn = 1.0f / sqrtf(wave_sum(ss) * (1.f / DM) + NORM_EPS);
#pragma unroll
            for (int j = 0; j < 4; ++j) { const f32x4 gq = *(const f32x4*)(fg + 256 * j + 4 * lane); *(f32x4*)(op + 256 * j + 4 * lane) = v[j] * rn * gq; }
        }
    }
}
}
constexpr int LDS_BYTES = 147456;
struct InProjOrder {
    pg8::StaticOrder so; int G, c;
    __device__ bool next(int i, pg8::Unit& u) const {
        const long L = (long)i * G + c;
        if (L < 4096) return so.next(i, u);
        const int r = (int)(L - 4096); if (r >= 64) return false;
        u.pm = 128 + r / 8; u.pn = r % 8; return true;
    }
};

template <int PH> __device__ __forceinline__ void run_phase(const Params& p, unsigned char* lds_) {
    int tid_ = threadIdx.x; asm volatile("" : "+v"(tid_));
    Ctx C; C.tid = tid_; C.lane = C.tid & 63; C.wave = __builtin_amdgcn_readfirstlane(C.tid >> 6); C.G = gridDim.x; C.bid = blockIdx.x; C.ws = p.ws;
    char* lds = (char*)lds_; LAS unsigned char* ldsl = (LAS unsigned char*)lds_;
    unsigned char* ws = C.ws;
    if constexpr (PH == 0) { adaln_phase(p, C, lds); __syncthreads(); wconv_mixer_phase(p, C, lds); hdn_phase(p, C); }
    else if constexpr (PH == 1) { hx_phase(p, C); }
    else if constexpr (PH == 2) {
        pg8::Gemm g{(const bf16_t*)(ws + WS_HX), (const bf16_t*)(ws + WS_WIN), 1024, nullptr};
        InProjOrder S; S.so.init(NTOK, INW, C.G, C.bid); S.G = C.G; S.c = C.bid;
        epi::InProj E{(bf16_t*)(ws + WS_Q), (bf16_t*)(ws + WS_K), (bf16_t*)(ws + WS_V), (bf16_t*)(ws + WS_UT), (bf16_t*)p.out};
        pg8::gemm_phase<epi::InProj, InProjOrder, false>(ldsl, g, S, E);
    }
    else if constexpr (PH == 3) { att::attn_phase(C, p.in[I_SUBG], lds); }
    else if constexpr (PH == 4) { hym::hyena_phase(p, C, lds); }
    else if constexpr (PH == 20) { hym::table_phase(p, C, lds); }
    else if constexpr (PH == 21) { hyn::hyena_naive_phase(p, C, lds); }
    else if constexpr (PH == 5) { wconv_moe_phase(p, C, lds); }
    else if constexpr (PH == 6) {
        pg8::Gemm g{(const bf16_t*)(ws + WS_Q), (const bf16_t*)(ws + WS_WPA), 1024, nullptr};
        pg8::StaticOrder S; S.init(NTOK, DM, C.G, C.bid);
        epi::Merge<0> E{(const bf16_t*)p.out, (bf16_t*)(ws + WS_K)};
        pg8::gemm_phase<epi::Merge<0>, pg8::StaticOrder, false>(ldsl, g, S, E);
    }
    else if constexpr (PH == 7) {
        pg8::Gemm g{(const bf16_t*)(ws + WS_HX), (const bf16_t*)(ws + WS_WPH), 1024, nullptr};
        pg8::StaticOrder S; S.init(NTOK, DM, C.G, C.bid);
        epi::Merge<1> E{(const bf16_t*)p.out, (bf16_t*)(ws + WS_K)};
        pg8::gemm_phase<epi::Merge<1>, pg8::StaticOrder, false>(ldsl, g, S, E);
    }
    else if constexpr (PH == 8) {
        pg8::Gemm g{(const bf16_t*)(ws + WS_K), (const bf16_t*)(ws + WS_WOUT), 1024, nullptr};
        pg8::StaticOrder S; S.init(NTOK, DM, C.G, C.bid);
        epi::OutProj E{p.in[I_X], (const float*)(ws + WS_MOD), p.out};
        pg8::gemm_phase<epi::OutProj, pg8::StaticOrder, false>(ldsl, g, S, E);
    }
    else if constexpr (PH == 9) { moe::route_phase(p, C, p.out, lds); }
    else if constexpr (PH == 10) { moe::place_phase(C, lds); }
    else if constexpr (PH == 11) {
        const int NT = __hip_atomic_load((const int*)(ws + WS_CNT) + 128, __ATOMIC_RELAXED, __HIP_MEMORY_SCOPE_AGENT);
        pg8::Gemm g{(const bf16_t*)(ws + WS_HX), (const bf16_t*)(ws + WS_WGU), 1024, (const int*)(ws + WS_ROWTOK)};
        moe::MoeOrder S{(const int*)(ws + WS_TILEE), NT, C.G, C.bid, 2, 2, 0};
        epi::SwiGLU E{(bf16_t*)(ws + WS_H)};
        pg8::gemm_phase<epi::SwiGLU, moe::MoeOrder, true>(ldsl, g, S, E);
    }
    else if constexpr (PH >= 12 && PH < 20 && (PH & 1) == 0) {
        constexpr int q = (PH - 12) / 2;
        const int NT = __hip_atomic_load((const int*)(ws + WS_CNT) + 128, __ATOMIC_RELAXED, __HIP_MEMORY_SCOPE_AGENT);
        pg8::Gemm g{(const bf16_t*)(ws + WS_H), (const bf16_t*)(ws + WS_WD), 256, nullptr};
        moe::MoeOrder S{(const int*)(ws + WS_TILEE), NT, C.G, C.bid, 1, 4, q};
        epi::Down E{(bf16_t*)(ws + WS_Y)};
        pg8::gemm_phase<epi::Down, moe::MoeOrder, false>(ldsl, g, S, E);
    }
    else if constexpr (PH >= 12 && PH < 20 && (PH & 1) == 1) {
        constexpr int q = (PH - 13) / 2;
        moe::combine_phase<q == 3>(p, C, q);
    }
}


__global__ void __launch_bounds__(512, 2) mega_fwd(Params p) {
    extern __shared__ __attribute__((aligned(16))) unsigned char lds[];
    cg::grid_group grid = cg::this_grid();
    run_phase<0>(p, lds); grid.sync();
    run_phase<1>(p, lds); grid.sync();
    run_phase<2>(p, lds); grid.sync();
    run_phase<20>(p, lds); grid.sync();
    run_phase<3>(p, lds); __syncthreads();
    run_phase<4>(p, lds); grid.sync();
    run_phase<5>(p, lds); __syncthreads();
    run_phase<6>(p, lds); grid.sync();
    run_phase<7>(p, lds); grid.sync();
    run_phase<8>(p, lds); grid.sync();
    run_phase<9>(p, lds); grid.sync();
    run_phase<10>(p, lds); grid.sync();
    run_phase<11>(p, lds); grid.sync();
    run_phase<12>(p, lds); grid.sync();
    run_phase<13>(p, lds); grid.sync();
    run_phase<14>(p, lds); grid.sync();
    run_phase<15>(p, lds); grid.sync();
    run_phase<16>(p, lds); grid.sync();
    run_phase<17>(p, lds); grid.sync();
    run_phase<18>(p, lds); grid.sync();
    run_phase<19>(p, lds);
}

extern "C" void kernel_launch(void* const* d_in, const int* in_sizes, int n_in, void* d_out, int out_size, void* d_ws, size_t ws_size, hipStream_t stream) {
    static int grid = 0;
    if (grid == 0) {
        if (n_in != 35 || out_size != NTOK * DM || ws_size < WS_END) { fprintf(stderr, "kernel_launch: unexpected shapes: n_in %d out %d ws %zu\n", n_in, out_size, ws_size); grid = -1; return; }
        int dev = 0, cus = 0, per_cu = 0; (void)hipGetDevice(&dev); (void)hipDeviceGetAttribute(&cus, hipDeviceAttributeMultiprocessorCount, dev);
        if (hipFuncSetAttribute((const void*)mega_fwd, hipFuncAttributeMaxDynamicSharedMemorySize, LDS_BYTES) != hipSuccess) { fprintf(stderr, "kernel_launch: hipFuncSetAttribute failed\n"); grid = -1; return; }
        if (hipOccupancyMaxActiveBlocksPerMultiprocessor(&per_cu, (const void*)mega_fwd, 512, LDS_BYTES) != hipSuccess || per_cu < 1) { fprintf(stderr, "kernel_launch: occupancy query failed (%d)\n", per_cu); grid = -1; return; }
        grid = cus * 1;
    }
    if (grid < 0) return;
    Params p{};
    for (int i = 0; i < 35; ++i) p.in[i] = (const float*)d_in[i];
    p.out = (float*)d_out; p.ws = (unsigned char*)d_ws;
    (void)hipMemsetAsync((char*)d_ws + WS_ZERO, 0, WS_ZERO_BYTES, stream);
    void* args[] = {&p};
    hipError_t e = hipLaunchCooperativeKernel((const void*)mega_fwd, dim3(grid), dim3(512), args, LDS_BYTES, stream);
    if (e != hipSuccess) fprintf(stderr, "cooperative launch failed: %s (grid %d)\n", hipGetErrorString(e), grid);
}
```

```cpp
#include <hip/hip_runtime.h>
#include <hip/hip_cooperative_groups.h>
#include <cstdio>
#include <cstdint>
#include <cmath>
namespace cg = cooperative_groups;

#define LAS __attribute__((address_space(3)))
typedef unsigned short bf16_t;
typedef short bf16x8 __attribute__((ext_vector_type(8)));
typedef short s16x4 __attribute__((ext_vector_type(4)));
typedef float f32x2 __attribute__((ext_vector_type(2)));
typedef float f32x4 __attribute__((ext_vector_type(4)));
typedef float f32x8 __attribute__((ext_vector_type(8)));
typedef float f32x16 __attribute__((ext_vector_type(16)));
typedef unsigned u32x2 __attribute__((ext_vector_type(2)));
typedef unsigned u32x4 __attribute__((ext_vector_type(4)));

constexpr int NB = 8, SEQ = 4096, DM = 1024, NTOK = NB * SEQ, CTXL = 256, NCTX = NB * CTXL, MROWS = NTOK + NCTX  , LKV = SEQ + CTXL  ;
constexpr int INW = 8192, NEXP = 64, EH = 256;
constexpr int PMAX_TILES = 1087 + 128;
constexpr float NORM_EPS = 1e-6f;

constexpr size_t MiB = 1u << 20;
constexpr size_t WS_MOD = 0;
constexpr size_t WS_CMOD = 256 * 1024;
constexpr size_t WS_LAM = 320 * 1024;
constexpr size_t WS_HDN = 1 * MiB;
constexpr size_t WS_ZERO = 2 * MiB, WS_ZERO_BYTES = 3 * MiB;
constexpr size_t WS_CNT = 2 * MiB;
constexpr size_t WS_TILEE = 2 * MiB + 65536;
constexpr size_t WS_BAR = 2 * MiB + 131072;
constexpr size_t WS_ROWTOK = 3 * MiB;
constexpr size_t WS_POS = 5 * MiB;
constexpr size_t WS_WSEL = 6 * MiB;
constexpr size_t WS_EIDX = 7 * MiB;
constexpr size_t WS_WIN = 8 * MiB;
constexpr size_t WS_WPA = 24 * MiB, WS_WPH = 26 * MiB, WS_WOUT = 28 * MiB;
constexpr size_t WS_HX = 32 * MiB;
constexpr size_t WS_Q = 100 * MiB;
constexpr size_t WS_K = 164 * MiB;
constexpr size_t WS_V = 232 * MiB;
constexpr size_t WS_UT = 300 * MiB;
constexpr size_t WS_H = 100 * MiB;
constexpr size_t WS_Y = 252 * MiB;
constexpr size_t WS_WGU = 414 * MiB;
constexpr size_t WS_WD = 479 * MiB;
constexpr size_t WS_END = 512 * MiB;
static_assert(WS_WD + (size_t)65 * 1024 * 256 * 2 <= WS_END && WS_Y + (size_t)PMAX_TILES * 256 * 512 <= WS_WGU && WS_H + (size_t)PMAX_TILES * 256 * 512 <= WS_Y, "ws map");

struct Params { const float* in[35]; float* out; unsigned char* ws; };
enum { I_X = 0, I_C, I_CTX, I_CCTX, I_ADAW, I_ADAB, I_N1G, I_N2G, I_WIN, I_LQ1, I_LK1, I_LQ2, I_LK2, I_SUBG, I_HCW, I_HCB, I_FW1, I_FB1, I_FFR, I_FW2, I_FB2, I_FW3, I_HYB,
       I_WPA, I_WPH, I_WOUT, I_RW, I_RB, I_EG, I_EU, I_ED, I_SG, I_SU, I_SD, I_FNG };

__device__ __forceinline__ unsigned cvt_pk_bf16(float lo, float hi) { unsigned r; asm volatile("v_cvt_pk_bf16_f32 %0, %1, %2" : "=v"(r) : "v"(lo), "v"(hi)); return r; }
__device__ __forceinline__ float bf2f(unsigned short h) { return __uint_as_float(((unsigned)h) << 16); }
__device__ __forceinline__ float bflo(unsigned w) { return __uint_as_float(w << 16); }
__device__ __forceinline__ float bfhi(unsigned w) { return __uint_as_float(w & 0xffff0000u); }
__device__ __forceinline__ float wave_sum(float v) {
#pragma unroll
    for (int o = 1; o < 64; o <<= 1) v += __shfl_xor(v, o);
    return v;
}
__device__ __forceinline__ float sigmoidf_(float x) { return 1.f / (1.f + __expf(-x)); }
namespace pg8 {
constexpr int BM = 256, BK = 64, HALF = 128, HTB = HALF * BK * 2  , STAGE_BYTES = 8 * HTB, NXCD = 8, WGM = 8;

__host__ __device__ __forceinline__ int lds_byte(int r, int c) { const int st = (r >> 4) * 2 + (c >> 5), rr = r & 15, cc = c & 31, ob = rr * 64 + cc * 2; return st * 1024 + (ob ^ (((ob >> 9) & 1) << 5)); }
__host__ __device__ __forceinline__ void stage_rc(int b, int& R, int& C) { const int st = b / 1024, sb = b % 1024, swz = sb ^ (((sb >> 9) & 1) << 5); R = (st >> 1) * 16 + swz / 64; C = (st & 1) * 32 + (swz % 64) / 2; }
__host__ __device__ __forceinline__ int perm32(int rho) { const int n = rho >> 4, i = rho & 15; return 8 * (i >> 2) + 4 * n + (i & 3); }

struct Unit { int pm, pn; };
struct Gemm { const bf16_t* A; const bf16_t* Bt; int K; const int* rowidx; };

struct StaticOrder {
    int nM, nN, nwg, G, c;
    __device__ void init(int M, int N, int G_, int c_) { nM = M / BM; nN = N / BM; nwg = nM * nN; G = G_; c = c_; }
    __device__ bool next(int i, Unit& u) const {
        const long L = (long)i * G + c; if (L >= nwg) return false;
        int wgid = (int)L; { const int q = nwg / NXCD, r = nwg % NXCD, xcd = wgid % NXCD, off = wgid / NXCD; wgid = (xcd < r ? xcd * (q + 1) : r * (q + 1) + (xcd - r) * q) + off; }
        const int nig = WGM * nN, gid = wgid / nig, fm = gid * WGM, gsz = (nM - fm) < WGM ? (nM - fm) : WGM;
        u.pm = fm + ((wgid % nig) % gsz); u.pn = (wgid % nig) / gsz; return true;
    }
};

template <class Epi, class Sched, bool GATHER>
__device__ __forceinline__ void gemm_phase(LAS unsigned char* lds, const Gemm g, const Sched& S, const Epi& E) {
    int tid_ = threadIdx.x; asm volatile("" : "+v"(tid_));
    const int tid = tid_, wid = __builtin_amdgcn_readfirstlane(tid >> 6), lane = tid & 63, wr = wid >> 2, wc = wid & 3, fr = lane & 15, fq = lane >> 4;
    const int K = g.K, nt = K / BK;
    int sR[2], sC[2];
    unsigned voffB[2];
#pragma unroll
    for (int i = 0; i < 2; ++i) { int R, C; stage_rc(tid * 16 + i * 8192, R, C); sR[i] = R; sC[i] = C; const int Rb = (R & ~31) + perm32(R & 31); voffB[i] = (unsigned)(Rb * K + C) * 2u; }
    const size_t kstep = (size_t)(BK * 2);
    const size_t hstep = (size_t)HALF * K * 2;
    const size_t tstep = 2 * hstep;
    const unsigned ldsw = (unsigned)wid * 1024u;
    const int aoff = lds_byte(wr * 64 + fr, fq * 8), boff = lds_byte(wc * 32 + fr, fq * 8);
#define PG8_SA(b, h) (((b) * 2 + (h)) * HTB)
#define PG8_SB(b, h) ((4 + (b) * 2 + (h)) * HTB)
#define PG8_STAGEB(bufoff, gbase) do { _Pragma("unroll") for (int _i = 0; _i < 2; ++_i) \
        __builtin_amdgcn_global_load_lds((const unsigned*)((const char*)(gbase) + voffB[_i]), (LAS unsigned*)(lds + (bufoff) + ldsw + _i * 8192), 16, 0, 0); } while (0)
#define PG8_STAGEA(bufoff, gbase, v0, v1) do { \
        __builtin_amdgcn_global_load_lds((const unsigned*)((const char*)(gbase) + (v0)), (LAS unsigned*)(lds + (bufoff) + ldsw), 16, 0, 0); \
        __builtin_amdgcn_global_load_lds((const unsigned*)((const char*)(gbase) + (v1)), (LAS unsigned*)(lds + (bufoff) + ldsw + 8192), 16, 0, 0); } while (0)
#define PG8_LDA(dst, b, h) do { _Pragma("unroll") for (int m = 0; m < 4; ++m) _Pragma("unroll") for (int k = 0; k < 2; ++k) dst[m][k] = *(const LAS bf16x8*)(lds + PG8_SA(b, h) + aoff + m * 2048 + k * 1024); } while (0)
#define PG8_LDB(dst, b, h) do { _Pragma("unroll") for (int n = 0; n < 2; ++n) _Pragma("unroll") for (int k = 0; k < 2; ++k) dst[n][k] = *(const LAS bf16x8*)(lds + PG8_SB(b, h) + boff + n * 2048 + k * 1024); } while (0)
#define PG8_MMA(ai, bj, At, Bt) do { __builtin_amdgcn_s_setprio(1); _Pragma("unroll") for (int m = 0; m < 4; ++m) _Pragma("unroll") for (int n = 0; n < 2; ++n) _Pragma("unroll") for (int k = 0; k < 2; ++k) \
        acc[ai][bj][m][n] = __builtin_amdgcn_mfma_f32_16x16x32_bf16(Bt[n][k], At[m][k], acc[ai][bj][m][n], 0, 0, 0); __builtin_amdgcn_s_setprio(0); } while (0)
#define PG8_WAIT_V(n) asm volatile("s_waitcnt vmcnt(" #n ")" ::: "memory")
#define PG8_WAIT_L(n) asm volatile("s_waitcnt lgkmcnt(" #n ")" ::: "memory")
#define PG8_BAR __builtin_amdgcn_s_barrier()
#define PG8_SCHED __builtin_amdgcn_sched_barrier(0)
    Unit cur, nxt; int ui = 0;
    if (!S.next(0, cur)) return;
    f32x4 acc[2][2][4][2];
#pragma unroll
    for (int a = 0; a < 2; ++a)
#pragma unroll
        for (int b = 0; b < 2; ++b)
#pragma unroll
            for (int m = 0; m < 4; ++m)
#pragma unroll
                for (int n = 0; n < 2; ++n) acc[a][b][m][n] = (f32x4){0.f, 0.f, 0.f, 0.f};
    bf16x8 At[4][2], B0[2][2], B1[2][2];
    unsigned vA[2][2], vN[2][2];
    const char* cA; const char* cB = (const char*)g.Bt + (size_t)cur.pn * tstep;
    if constexpr (GATHER) {
        cA = (const char*)g.A;
#pragma unroll
        for (int h = 0; h < 2; ++h)
#pragma unroll
            for (int i = 0; i < 2; ++i) vA[h][i] = ((unsigned)__hip_atomic_load(g.rowidx + cur.pm * BM + h * HALF + sR[i], __ATOMIC_RELAXED, __HIP_MEMORY_SCOPE_AGENT) * (unsigned)K + (unsigned)sC[i]) * 2u;
    } else {
        cA = (const char*)g.A + (size_t)cur.pm * tstep;
#pragma unroll
        for (int h = 0; h < 2; ++h)
#pragma unroll
            for (int i = 0; i < 2; ++i) vA[h][i] = (unsigned)(sR[i] * K + sC[i]) * 2u + (unsigned)(h * hstep);
    }
    PG8_STAGEB(PG8_SB(0, 0), cB); PG8_STAGEB(PG8_SB(0, 1), cB + hstep); PG8_STAGEA(PG8_SA(0, 0), cA, vA[0][0], vA[0][1]); PG8_STAGEA(PG8_SA(0, 1), cA, vA[1][0], vA[1][1]);
    if (wr == 1) PG8_BAR;
    PG8_WAIT_V(2); PG8_BAR;
    PG8_STAGEB(PG8_SB(1, 0), cB + kstep); PG8_STAGEA(PG8_SA(1, 0), cA + kstep, vA[0][0], vA[0][1]); PG8_STAGEB(PG8_SB(1, 1), cB + hstep + kstep);
    PG8_WAIT_V(6); PG8_BAR;
    for (;;) {
        const bool has_next = S.next(ui + 1, nxt);
        const char* nA; const char* nB = has_next ? (const char*)g.Bt + (size_t)nxt.pn * tstep : cB;
        if constexpr (GATHER) {
            nA = cA;
            if (has_next) {
#pragma unroll
                for (int h = 0; h < 2; ++h)
#pragma unroll
                    for (int i = 0; i < 2; ++i) vN[h][i] = ((unsigned)__hip_atomic_load(g.rowidx + nxt.pm * BM + h * HALF + sR[i], __ATOMIC_RELAXED, __HIP_MEMORY_SCOPE_AGENT) * (unsigned)K + (unsigned)sC[i]) * 2u;
            } else {
#pragma unroll
                for (int h = 0; h < 2; ++h)
#pragma unroll
                    for (int i = 0; i < 2; ++i) vN[h][i] = vA[h][i];
            }
        } else {
            nA = has_next ? (const char*)g.A + (size_t)nxt.pm * tstep : cA;
#pragma unroll
            for (int h = 0; h < 2; ++h)
#pragma unroll
                for (int i = 0; i < 2; ++i) vN[h][i] = vA[h][i];
        }
#pragma unroll 1
        for (int t = 0; t < nt; t += 2) {
            const bool last = (t == nt - 2);
            const char* a1 = cA + (size_t)(t + 1) * kstep;
            const char* a2 = last ? nA : cA + (size_t)(t + 2) * kstep; const char* b2 = last ? nB : cB + (size_t)(t + 2) * kstep;
            const char* a3 = a2 + kstep; const char* b3 = b2 + kstep;
            const unsigned w00 = last ? vN[0][0] : vA[0][0], w01 = last ? vN[0][1] : vA[0][1], w10 = last ? vN[1][0] : vA[1][0], w11 = last ? vN[1][1] : vA[1][1];
            PG8_LDB(B0, 0, 0); PG8_LDB(B1, 0, 1); PG8_SCHED; PG8_LDA(At, 0, 0); PG8_STAGEA(PG8_SA(1, 1), a1, vA[1][0], vA[1][1]);
            PG8_WAIT_V(8); PG8_WAIT_L(0); PG8_BAR; PG8_MMA(0, 0, At, B0); PG8_MMA(0, 1, At, B1); PG8_BAR; PG8_SCHED;
            PG8_LDA(At, 0, 1); PG8_STAGEB(PG8_SB(0, 0), b2); PG8_STAGEB(PG8_SB(0, 1), b2 + hstep); PG8_STAGEA(PG8_SA(0, 0), a2, w00, w01);
            PG8_WAIT_V(8); PG8_WAIT_L(0); PG8_BAR; PG8_MMA(1, 0, At, B0); PG8_MMA(1, 1, At, B1); PG8_BAR; PG8_SCHED;
            PG8_LDB(B0, 1, 0); PG8_LDB(B1, 1, 1); PG8_SCHED; PG8_LDA(At, 1, 0); PG8_STAGEA(PG8_SA(0, 1), a2, w10, w11);
            PG8_WAIT_V(8); PG8_WAIT_L(0); PG8_BAR; PG8_MMA(0, 0, At, B0); PG8_MMA(0, 1, At, B1); PG8_BAR; PG8_SCHED;
            PG8_LDA(At, 1, 1); PG8_STAGEB(PG8_SB(1, 0), b3); PG8_STAGEB(PG8_SB(1, 1), b3 + hstep); PG8_STAGEA(PG8_SA(1, 0), a3, w00, w01);
            PG8_WAIT_V(8); PG8_WAIT_L(0); PG8_BAR; PG8_MMA(1, 0, At, B0); PG8_MMA(1, 1, At, B1); PG8_BAR; PG8_SCHED;
        }
        if (wr == 0) PG8_BAR;
        E(acc, cur, wr, wc, fr, fq);
        if (!has_next) break;
#pragma unroll
        for (int a = 0; a < 2; ++a)
#pragma unroll
            for (int b = 0; b < 2; ++b)
#pragma unroll
                for (int m = 0; m < 4; ++m)
#pragma unroll
                    for (int n = 0; n < 2; ++n) acc[a][b][m][n] = (f32x4){0.f, 0.f, 0.f, 0.f};
        cur = nxt; cA = nA; cB = nB; ++ui;
#pragma unroll
        for (int h = 0; h < 2; ++h)
#pragma unroll
            for (int i = 0; i < 2; ++i) vA[h][i] = vN[h][i];
        if (wr == 1) PG8_BAR;
    }
    PG8_WAIT_V(0);
    PG8_BAR;
#undef PG8_SA
#undef PG8_SB
#undef PG8_STAGEA
#undef PG8_STAGEB
#undef PG8_LDA
#undef PG8_LDB
#undef PG8_MMA
#undef PG8_WAIT_V
#undef PG8_WAIT_L
#undef PG8_BAR
#undef PG8_SCHED
}
}
namespace epi {
using pg8::Unit;
__device__ __forceinline__ u32x4 pack8(const f32x4 v0, const f32x4 v1) { u32x4 w; w.x = cvt_pk_bf16(v0[0], v0[1]); w.y = cvt_pk_bf16(v0[2], v0[3]); w.z = cvt_pk_bf16(v1[0], v1[1]); w.w = cvt_pk_bf16(v1[2], v1[3]); return w; }

struct InProj {
    bf16_t* Q; bf16_t* Kall; bf16_t* Vall; bf16_t* UT; bf16_t* G;
    __device__ __forceinline__ void operator()(const f32x4 (&acc)[2][2][4][2], const Unit& u, int wr, int wc, int fr, int fq) const {
        const int pn = u.pn; const int row0 = u.pm * 256 + wr * 64 + fr; const int cw = wc * 32 + 8 * fq;
        if (pn < 12 && !(pn >= 4 && pn < 8)) {
            const bool isq = pn >= 8; const int colt = (isq ? pn - 8 : pn) * 256;
            float inv[4];
#pragma unroll
            for (int j = 0; j < 4; ++j) inv[j] = exp2f(-(float)(4 * fq + j) * 0.8304820237218406f);
            const int axis = wc & 1;
#pragma unroll
            for (int ai = 0; ai < 2; ++ai)
#pragma unroll
                for (int m = 0; m < 4; ++m) {
                    const int row = row0 + ai * 128 + m * 16;
                    bf16_t* dst; bool rope;
                    if (row < NTOK) { const int b = row >> 12, t = row & 4095; rope = true;
                        dst = isq ? Q + (size_t)row * DM : Kall + ((size_t)b * LKV + t) * DM; }
                    else { const int rc = row - NTOK, b = rc >> 8, j = rc & 255; rope = false; dst = Kall + ((size_t)b * LKV + SEQ + j) * DM; }
                    const int t = row & 4095; const float pos = (float)(axis ? (t & 63) : (t >> 6));
#pragma unroll
                    for (int bj = 0; bj < 2; ++bj) {
                        f32x4 x1 = acc[ai][bj][m][0], x2 = acc[ai][bj][m][1], o1, o2;
                        if (rope) {
#pragma unroll
                            for (int j = 0; j < 4; ++j) { const float a = pos * inv[j]; const float c = __cosf(a), s = __sinf(a); o1[j] = x1[j] * c - x2[j] * s; o2[j] = x2[j] * c + x1[j] * s; }
                        } else { o1 = x1; o2 = x2; }
                        *(u32x4*)(dst + colt + bj * 128 + cw) = pack8(o1, o2);
                    }
                }
        } else if (pn < 8) {
            const int colt = (pn - 4) * 256;
#pragma unroll
            for (int ai = 0; ai < 2; ++ai)
#pragma unroll
                for (int m = 0; m < 4; ++m) {
                    const int row = row0 + ai * 128 + m * 16; bf16_t* dst;
                    if (row < NTOK) { const int b = row >> 12, t = row & 4095; dst = Vall + ((size_t)b * LKV + t) * DM; }
                    else { const int rc = row - NTOK, b = rc >> 8, j = rc & 255; dst = Vall + ((size_t)b * LKV + SEQ + j) * DM; }
#pragma unroll
                    for (int bj = 0; bj < 2; ++bj) *(u32x4*)(dst + colt + bj * 128 + cw) = pack8(acc[ai][bj][m][0], acc[ai][bj][m][1]);
                }
        } else if (pn < 24) {
            const int ch0 = (pn - 12) * 256 + cw;
#pragma unroll
            for (int ai = 0; ai < 2; ++ai)
#pragma unroll
                for (int m = 0; m < 4; ++m) {
                    const int row = row0 + ai * 128 + m * 16; const int b = row >> 12, t = row & 4095;
                    bf16_t* dst = UT + ((size_t)b * 3072 + ch0) * SEQ + t;
#pragma unroll
                    for (int bj = 0; bj < 2; ++bj)
#pragma unroll
                        for (int n = 0; n < 2; ++n)
#pragma unroll
                            for (int j = 0; j < 4; ++j) dst[(size_t)(bj * 128 + n * 4 + j) * SEQ] = (bf16_t)(cvt_pk_bf16(acc[ai][bj][m][n][j], 0.f) & 0xffffu);
                }
        } else {
            const int colt = (pn - 24) * 256;
#pragma unroll
            for (int ai = 0; ai < 2; ++ai)
#pragma unroll
                for (int m = 0; m < 4; ++m) {
                    const int row = row0 + ai * 128 + m * 16; bf16_t* dst = G + (size_t)row * 2048 + colt + cw;
#pragma unroll
                    for (int bj = 0; bj < 2; ++bj) { f32x4 a = acc[ai][bj][m][0], c = acc[ai][bj][m][1];
#pragma unroll
                        for (int j = 0; j < 4; ++j) { a[j] = sigmoidf_(a[j]); c[j] = sigmoidf_(c[j]); }
                        *(u32x4*)(dst + bj * 128) = pack8(a, c); }
                }
        }
    }
};

template <int MODE> struct Merge {
    const bf16_t* G; bf16_t* T1;
    __device__ __forceinline__ void operator()(const f32x4 (&acc)[2][2][4][2], const Unit& u, int wr, int wc, int fr, int fq) const {
        const int row0 = u.pm * 256 + wr * 64 + fr; const int col0 = u.pn * 256 + wc * 32 + 8 * fq;
#pragma unroll
        for (int ai = 0; ai < 2; ++ai)
#pragma unroll
            for (int m = 0; m < 4; ++m) {
                const int row = row0 + ai * 128 + m * 16;
#pragma unroll
                for (int bj = 0; bj < 2; ++bj) {
                    const int col = col0 + bj * 128;
                    const u32x4 gw = *(const u32x4*)(G + (size_t)row * 2048 + MODE * 1024 + col);
                    f32x4 a = acc[ai][bj][m][0], c = acc[ai][bj][m][1];
                    a[0] *= bflo(gw.x); a[1] *= bfhi(gw.x); a[2] *= bflo(gw.y); a[3] *= bfhi(gw.y);
                    c[0] *= bflo(gw.z); c[1] *= bfhi(gw.z); c[2] *= bflo(gw.w); c[3] *= bfhi(gw.w);
                    bf16_t* tp = T1 + (size_t)row * DM + col;
                    if (MODE == 1) { const u32x4 tw = *(const u32x4*)tp;
                        a[0] += bflo(tw.x); a[1] += bfhi(tw.x); a[2] += bflo(tw.y); a[3] += bfhi(tw.y);
                        c[0] += bflo(tw.z); c[1] += bfhi(tw.z); c[2] += bflo(tw.w); c[3] += bfhi(tw.w); }
                    *(u32x4*)tp = pack8(a, c);
                }
            }
    }
};

struct OutProj {
    const float* x; const float* mod; float* xnew;
    __device__ __forceinline__ void operator()(const f32x4 (&acc)[2][2][4][2], const Unit& u, int wr, int wc, int fr, int fq) const {
        const int row0 = u.pm * 256 + wr * 64 + fr; const int col0 = u.pn * 256 + wc * 32 + 8 * fq;
#pragma unroll
        for (int ai = 0; ai < 2; ++ai)
#pragma unroll
            for (int m = 0; m < 4; ++m) {
                const int row = row0 + ai * 128 + m * 16; const int b = row >> 12;
#pragma unroll
                for (int bj = 0; bj < 2; ++bj) {
                    const int col = col0 + bj * 128; const size_t off = (size_t)row * DM + col;
                    const float* gp = mod + b * 6144 + 2048 + col;
#pragma unroll
                    for (int n = 0; n < 2; ++n) { const f32x4 xv = *(const f32x4*)(x + off + 4 * n), gv = *(const f32x4*)(gp + 4 * n);
                        *(f32x4*)(xnew + off + 4 * n) = xv + gv * acc[ai][bj][m][n]; }
                }
            }
    }
};

struct SwiGLU {
    bf16_t* H;
    __device__ __forceinline__ void operator()(const f32x4 (&acc)[2][2][4][2], const Unit& u, int wr, int wc, int fr, int fq) const {
        const int row0 = u.pm * 256 + wr * 64 + fr; const int j = u.pn & 1;
#pragma unroll
        for (int ai = 0; ai < 2; ++ai)
#pragma unroll
            for (int m = 0; m < 4; ++m) {
                const int row = row0 + ai * 128 + m * 16;
#pragma unroll
                for (int bj = 0; bj < 2; ++bj) {
                    const int gi = 16 * bj + 4 * wc + fq;
                    const f32x4 g = acc[ai][bj][m][0], up = acc[ai][bj][m][1]; f32x4 h;
#pragma unroll
                    for (int q = 0; q < 4; ++q) h[q] = g[q] * sigmoidf_(g[q]) * up[q];
                    u32x2 w; w.x = cvt_pk_bf16(h[0], h[1]); w.y = cvt_pk_bf16(h[2], h[3]);
                    *(u32x2*)(H + (size_t)row * EH + 128 * j + 4 * gi) = w;
                }
            }
    }
};

struct Down {
    bf16_t* Y;
    __device__ __forceinline__ void operator()(const f32x4 (&acc)[2][2][4][2], const Unit& u, int wr, int wc, int fr, int fq) const {
        const int row0 = u.pm * 256 + wr * 64 + fr; const int col0 = wc * 32 + 8 * fq;
#pragma unroll
        for (int ai = 0; ai < 2; ++ai)
#pragma unroll
            for (int m = 0; m < 4; ++m) {
                const int row = row0 + ai * 128 + m * 16;
#pragma unroll
                for (int bj = 0; bj < 2; ++bj) *(u32x4*)(Y + (size_t)row * 256 + col0 + bj * 128) = pack8(acc[ai][bj][m][0], acc[ai][bj][m][1]);
            }
    }
};
}
struct Ctx { int tid, lane, wave, G, bid; unsigned char* ws; };

__device__ __forceinline__ void adaln_phase(const Params& p, const Ctx& C, char* lds) {
    float* s = (float*)lds;
    float* red = (float*)(lds + 9 * 1024 * 4);
    const float* c = p.in[I_C]; const float* cc = p.in[I_CCTX]; const float* W = p.in[I_ADAW]; const float* bias = p.in[I_ADAB];
    float* mod = (float*)(C.ws + WS_MOD); float* cmod = (float*)(C.ws + WS_CMOD);
    if (C.bid < 192) {
        for (int i = C.tid; i < 9 * 1024; i += 512) { const int b = i >> 10, k = i & 1023; const float v = b < 8 ? c[b * 1024 + k] : cc[k]; s[i] = v / (1.f + expf(-v)); }
        __syncthreads();
    }
    for (int item = C.bid; item < 192; item += C.G) {
        const int cl = C.tid & 31, kg = C.tid >> 5, col = item * 32 + cl;
        float acc[9];
#pragma unroll
        for (int b = 0; b < 9; ++b) acc[b] = 0.f;
        for (int k = kg; k < 1024; k += 16) { const float w = W[(size_t)k * 6144 + col];
#pragma unroll
            for (int b = 0; b < 9; ++b) acc[b] += s[b * 1024 + k] * w; }
#pragma unroll
        for (int b = 0; b < 9; ++b) red[(kg * 9 + b) * 32 + cl] = acc[b];
        __syncthreads();
        if (C.tid < 9 * 32) { const int b = C.tid >> 5, c2 = C.tid & 31, col2 = item * 32 + c2; float v = 0.f;
            for (int q = 0; q < 16; ++q) v += red[(q * 9 + b) * 32 + c2];
            v += bias[col2];
            if (b < 8) mod[b * 6144 + col2] = v; else if (col2 < 2048) cmod[col2] = v; }
        __syncthreads();
    }
    if (C.bid == (C.G > 200 ? 200 : 0) && C.tid < 64) {
        const float a = wave_sum(p.in[I_LQ1][C.tid] * p.in[I_LK1][C.tid]), b = wave_sum(p.in[I_LQ2][C.tid] * p.in[I_LK2][C.tid]);
        if (C.tid == 0) *(float*)(C.ws + WS_LAM) = expf(a) - expf(b) + 0.2f;
    }
}

__device__ __forceinline__ void hdn_phase(const Params& p, const Ctx& C) {
    const float* w1 = p.in[I_FW1]; const float* b1 = p.in[I_FB1]; const float* fr = p.in[I_FFR]; const float* w2 = p.in[I_FW2]; const float* b2 = p.in[I_FB2];
    float* hdn = (float*)(C.ws + WS_HDN);
    const int gw = C.bid * 8 + C.wave, NGW = C.G * 8, l = C.lane;
    for (int t = gw; t < SEQ; t += NGW) {
        float z = 0.f;
        if (l == 0) z = (float)((double)t / 4095.0);
        else if (l < 33) { const int bi = (l - 1) & 15; const double band = 1e-4 + (double)bi * ((15.0 - 1e-4) / 15.0); const double w = 6.283185307179586476925 * (double)t / 4096.0; const double a = band * w;
            z = (l < 17) ? (float)cos(a) : (float)(-sin(a)); }
        float h = b1[l];
        for (int i = 0; i < 33; ++i) h += __shfl(z, i) * w1[i * 64 + l];
        h = sinf(fr[l] * h);
        float h2 = b2[l];
        for (int i = 0; i < 64; ++i) h2 += __shfl(h, i) * w2[i * 64 + l];
        h2 = sinf(fr[l] * h2);
        hdn[t * 64 + l] = h2;
    }
}

__device__ __forceinline__ void transpose_item(const float* srcl, int ldw, bf16_t* dst, int K, float* scr, int lane) {
#pragma unroll 8
    for (int i = 0; i < 32; ++i) { const int kk = 2 * i + (lane >> 5); scr[kk * 33 + (lane & 31)] = srcl[(size_t)kk * ldw]; }
    asm volatile("s_waitcnt lgkmcnt(0)" ::: "memory");
    const int c = lane & 7;
#pragma unroll
    for (int j = 0; j < 4; ++j) { const int n = (lane >> 3) + 8 * j; const float* s = scr + (8 * c) * 33 + n;
        u32x4 o; o.x = cvt_pk_bf16(s[0 * 33], s[1 * 33]); o.y = cvt_pk_bf16(s[2 * 33], s[3 * 33]); o.z = cvt_pk_bf16(s[4 * 33], s[5 * 33]); o.w = cvt_pk_bf16(s[6 * 33], s[7 * 33]);
        *(u32x4*)(dst + (size_t)n * K + 8 * c) = o; }
    asm volatile("s_waitcnt lgkmcnt(0)" ::: "memory");
}
__device__ __forceinline__ int qk_src_col(int n) {
    const int blk = n & ~63, pp = n & 63, axis = pp >> 5, f = ((pp & 31) >> 3) * 4 + (pp & 3), half = (pp >> 2) & 1;
    return blk + axis * 32 + half * 16 + f;
}
__device__ __forceinline__ void wconv_mixer_phase(const Params& p, const Ctx& C, char* lds) {
    float* scr = (float*)(lds + C.wave * 16384);
    const int gw = C.bid * 8 + C.wave, NGW = C.G * 8, l31 = C.lane & 31;
    constexpr int I_IN = 16 * 256, I_SQ = 16 * 32, NIT = I_IN + 3 * I_SQ;
    for (int it = gw; it < NIT; it += NGW) {
        int r = it;
        if (r < I_IN) { const int kb = r / 256, nb = r % 256, k0 = 64 * kb, n0 = 32 * nb; const int n = n0 + l31;
            const int src = (n < 1024 || (n >= 2048 && n < 3072)) ? qk_src_col(n) : n;
            transpose_item(p.in[I_WIN] + (size_t)k0 * INW + src, INW, (bf16_t*)(C.ws + WS_WIN) + (size_t)n0 * 1024 + k0, 1024, scr, C.lane); continue; }
        r -= I_IN; const int which = r / I_SQ; r %= I_SQ;
        const float* W = which == 0 ? p.in[I_WPA] : which == 1 ? p.in[I_WPH] : p.in[I_WOUT];
        bf16_t* WT = (bf16_t*)(C.ws + (which == 0 ? WS_WPA : which == 1 ? WS_WPH : WS_WOUT));
        const int kb = r / 32, nb = r % 32, k0 = 64 * kb, n0 = 32 * nb;
        transpose_item(W + (size_t)k0 * 1024 + n0 + l31, 1024, WT + (size_t)n0 * 1024 + k0, 1024, scr, C.lane);
    }
}
__device__ __forceinline__ void wconv_moe_phase(const Params& p, const Ctx& C, char* lds) {
    float* scr = (float*)(lds + C.wave * 16384);
    const int gw = C.bid * 8 + C.wave, NGW = C.G * 8, l31 = C.lane & 31;
    constexpr int I_GU = 16 * 16, I_D = 4 * 32, NIT = 65 * (I_GU + I_D);
    for (int it = gw; it < NIT; it += NGW) {
        const int e = it / (I_GU + I_D); int r = it % (I_GU + I_D);
        if (r < I_GU) { const int kb = r / 16, nb = r % 16, k0 = 64 * kb, n0 = 32 * nb; const int n = n0 + l31;
            const int j = n >> 8, gi = (n & 255) >> 3, e8 = n & 7, i = 128 * j + 4 * gi + (e8 & 3);
            const float* mat = (e8 >> 2) ? (e < 64 ? p.in[I_EU] + (size_t)e * 1024 * 256 : p.in[I_SU]) : (e < 64 ? p.in[I_EG] + (size_t)e * 1024 * 256 : p.in[I_SG]);
            transpose_item(mat + (size_t)k0 * 256 + i, 256, (bf16_t*)(C.ws + WS_WGU) + ((size_t)e * 512 + n0) * 1024 + k0, 1024, scr, C.lane); continue; }
        r -= I_GU; const int kb = r / 32, nb = r % 32, k0 = 64 * kb, n0 = 32 * nb;
        const float* mat = e < 64 ? p.in[I_ED] + (size_t)e * 256 * 1024 : p.in[I_SD];
        transpose_item(mat + (size_t)k0 * 1024 + n0 + l31, 1024, (bf16_t*)(C.ws + WS_WD) + ((size_t)e * 1024 + n0) * 256 + k0, 256, scr, C.lane);
    }
}

__device__ __forceinline__ void hx_phase(const Params& p, const Ctx& C) {
    const float* mod = (const float*)(C.ws + WS_MOD); const float* cmod = (const float*)(C.ws + WS_CMOD); const float* g = p.in[I_N1G];
    bf16_t* HX = (bf16_t*)(C.ws + WS_HX);
    const int gw = C.bid * 8 + C.wave, NGW = C.G * 8;
    for (int r = gw; r < MROWS; r += NGW) {
        const float* xr; const float* sh; const float* sc;
        if (r < NTOK) { xr = p.in[I_X] + (size_t)r * DM; const int b = r >> 12; sh = mod + b * 6144; sc = sh + 1024; }
        else { xr = p.in[I_CTX] + (size_t)(r - NTOK) * DM; sh = cmod; sc = cmod + 1024; }
        f32x4 v[4]; float ss = 0.f;
#pragma unroll
        for (int j = 0; j < 4; ++j) { v[j] = *(const f32x4*)(xr + 256 * j + 4 * C.lane); ss += (v[j].x * v[j].x + v[j].y * v[j].y) + (v[j].z * v[j].z + v[j].w * v[j].w); }
        const float rn = 1.0f / sqrtf(wave_sum(ss) * (1.f / DM) + NORM_EPS);
#pragma unroll
        for (int j = 0; j < 4; ++j) { const int k = 256 * j + 4 * C.lane;
            const f32x4 gv = *(const f32x4*)(g + k), scv = *(const f32x4*)(sc + k), shv = *(const f32x4*)(sh + k);
            const f32x4 o = v[j] * rn * gv * (1.f + scv) + shv;
            u32x2 w; w.x = cvt_pk_bf16(o.x, o.y); w.y = cvt_pk_bf16(o.z, o.w);
            *(u32x2*)(HX + (size_t)r * DM + k) = w; }
    }
}
namespace att {
constexpr int KVBLK = 64, NT = LKV / KVBLK;
constexpr float SCALE = 0.125f, THR = 8.f;
constexpr int SHM_V = KVBLK * 128 * 2, SHM_K = KVBLK * 128 * 2;
#define KSWZ(row, colB) ((row) * 256 + ((colB) ^ (((row) & 7) << 4)))
#define SBAR() __builtin_amdgcn_sched_barrier(0)
__device__ __forceinline__ int crow(int r, int hi) { return (r & 3) + 8 * (r >> 2) + 4 * hi; }
__device__ __forceinline__ void partialSM(f32x16& p0, f32x16& p1, float& m_reg, float& mn, float& alpha) {
  constexpr float C = SCALE * 1.4426950408889634f;
  float pmax = p0[0];
#pragma unroll
  for (int r = 1; r < 16; ++r) pmax = fmaxf(pmax, p0[r]);
#pragma unroll
  for (int r = 0; r < 16; ++r) pmax = fmaxf(pmax, p1[r]);
  { auto rr = __builtin_amdgcn_permlane32_swap(__float_as_uint(pmax), __float_as_uint(pmax), false, false);
    pmax = fmaxf(__uint_as_float(rr[0]), __uint_as_float(rr[1])); }
  if (__builtin_expect(__all(pmax - m_reg <= THR / SCALE), 1)) { mn = m_reg; alpha = 1.f; }
  else { mn = fmaxf(m_reg, pmax); alpha = __builtin_amdgcn_exp2f((m_reg - mn) * C); m_reg = mn; }
  float mnC = -mn * C;
#pragma unroll
  for (int r = 0; r < 16; ++r) p0[r] = fmaf(p0[r], C, mnC);
#pragma unroll
  for (int r = 0; r < 16; ++r) p1[r] = fmaf(p1[r], C, mnC);
#pragma unroll
  for (int r = 0; r < 16; ++r) p0[r] = __builtin_amdgcn_exp2f(p0[r]);
}
__device__ __forceinline__ void finishSM(f32x16& p0, f32x16& p1, float alpha, float& l_reg, bf16x8& pa0, bf16x8& pa1, bf16x8& pa2, bf16x8& pa3) {
#pragma unroll
  for (int r = 0; r < 16; ++r) p1[r] = __builtin_amdgcn_exp2f(p1[r]);
  float ps = 0;
#pragma unroll
  for (int r = 0; r < 16; ++r) ps += p0[r];
#pragma unroll
  for (int r = 0; r < 16; ++r) ps += p1[r];
  { auto rr = __builtin_amdgcn_permlane32_swap(__float_as_uint(ps), __float_as_uint(ps), false, false);
    ps = __uint_as_float(rr[0]) + __uint_as_float(rr[1]); }
  l_reg = l_reg * alpha + ps;
#define PK4(P, BASE, OUT) do { unsigned a0 = cvt_pk_bf16(P[BASE + 0], P[BASE + 1]), a1 = cvt_pk_bf16(P[BASE + 2], P[BASE + 3]);   \
    unsigned b0 = cvt_pk_bf16(P[BASE + 4], P[BASE + 5]), b1 = cvt_pk_bf16(P[BASE + 6], P[BASE + 7]);                              \
    auto r0 = __builtin_amdgcn_permlane32_swap(a0, b0, false, false); auto r1 = __builtin_amdgcn_permlane32_swap(a1, b1, false, false); \
    u32x4 w = {r0[0], r1[0], r0[1], r1[1]}; OUT = *reinterpret_cast<bf16x8*>(&w); } while (0)
  PK4(p0, 0, pa0); PK4(p0, 8, pa1); PK4(p1, 0, pa2); PK4(p1, 8, pa3);
#undef PK4
}
__device__ __forceinline__ void qkt(f32x16& p0, f32x16& p1, const char* Ks, const bf16x8* qr, int r32, int hi, int mp) {
  p0 = f32x16{}; p1 = f32x16{};
#pragma unroll
  for (int d0 = 0; d0 < 4; ++d0) { const int cb = ((mp * 4 + d0) * 16 + hi * 8) * 2;
    const bf16x8 b0 = *reinterpret_cast<const bf16x8*>(Ks + KSWZ(r32, cb));
    const bf16x8 b1 = *reinterpret_cast<const bf16x8*>(Ks + KSWZ(32 + r32, cb));
    p0 = __builtin_amdgcn_mfma_f32_32x32x16_bf16(b0, qr[d0], p0, 0, 0, 0);
    p1 = __builtin_amdgcn_mfma_f32_32x32x16_bf16(b1, qr[d0], p1, 0, 0, 0); }
}
__device__ __forceinline__ int v_st(int k, int c) { const int kk = (k & ~0xC) | ((k & 4) << 1) | ((k & 8) >> 1); return ((kk >> 3) * 4 + (c >> 5)) * 512 + ((kk & 7) * 32 + (c & 31)) * 2; }
__device__ __forceinline__ int v_rd_base(int lane) { return ((lane & 3) << 3) | (((lane >> 2) & 3) << 6) | (((lane >> 4) & 1) << 5) | (((lane >> 5) & 1) << 8); }
constexpr int v_rd_off(int d0, int ks, int half) { return d0 * 512 + ks * 4096 + half * 2048; }
template <int OFF> __device__ __forceinline__ s16x4 tr_read(int vb) {
  s16x4 r; asm volatile("ds_read_b64_tr_b16 %0, %1 offset:%2" : "=&v"(r) : "v"(vb), "i"(OFF) : "memory"); return r;
}
template <int D0> __device__ __forceinline__ void pv_one(f32x16& od, int vb, bf16x8 pa0, bf16x8 pa1, bf16x8 pa2, bf16x8 pa3) {
  const s16x4 l0 = tr_read<v_rd_off(D0, 0, 0)>(vb), h0 = tr_read<v_rd_off(D0, 0, 1)>(vb), l1 = tr_read<v_rd_off(D0, 1, 0)>(vb), h1 = tr_read<v_rd_off(D0, 1, 1)>(vb);
  const s16x4 l2 = tr_read<v_rd_off(D0, 2, 0)>(vb), h2 = tr_read<v_rd_off(D0, 2, 1)>(vb), l3 = tr_read<v_rd_off(D0, 3, 0)>(vb), h3 = tr_read<v_rd_off(D0, 3, 1)>(vb);
  asm volatile("s_waitcnt lgkmcnt(0)" ::: "memory"); SBAR();
#define PK(L, H) (bf16x8){L[0], L[1], L[2], L[3], H[0], H[1], H[2], H[3]}
  od = __builtin_amdgcn_mfma_f32_32x32x16_bf16(pa0, PK(l0, h0), od, 0, 0, 0);
  od = __builtin_amdgcn_mfma_f32_32x32x16_bf16(pa1, PK(l1, h1), od, 0, 0, 0);
  od = __builtin_amdgcn_mfma_f32_32x32x16_bf16(pa2, PK(l2, h2), od, 0, 0, 0);
  od = __builtin_amdgcn_mfma_f32_32x32x16_bf16(pa3, PK(l3, h3), od, 0, 0, 0);
#undef PK
}
__device__ __forceinline__ void pv_d0(f32x16* o, int vb, bf16x8 pa0, bf16x8 pa1, bf16x8 pa2, bf16x8 pa3) {
  pv_one<0>(o[0], vb, pa0, pa1, pa2, pa3); pv_one<1>(o[1], vb, pa0, pa1, pa2, pa3); pv_one<2>(o[2], vb, pa0, pa1, pa2, pa3); pv_one<3>(o[3], vb, pa0, pa1, pa2, pa3);
}

__device__ __forceinline__ void attn_unit(const bf16_t* Qg, const bf16_t* Kall, const bf16_t* Vall, bf16_t* AX, float lam, const float* subg, int b, int h, int qb, char* lds) {
  constexpr int LDK = DM;
  int tid_ = threadIdx.x; asm volatile("" : "+v"(tid_));
  const int tid = tid_, wid = tid >> 6, lane = tid & 63, r32 = lane & 31, hi = lane >> 5, rg = wid & 3, mp = wid >> 2;
  char* V_lds = lds; char* K_lds = lds + 2 * SHM_V;
  float* wsf = (float*)(lds + 2 * SHM_V + 2 * SHM_K) + wid * 64; float* li_l = wsf; float* al_l = wsf + 32;
  const bf16_t* Kh = Kall + (size_t)b * LKV * DM + h * 128; const bf16_t* Vh = Vall + (size_t)b * LKV * DM + h * 128;
  float m_reg = -1e30f, l_reg = 0; f32x16 o[4] = {}; bf16x8 qr[4];
  const bf16_t* Qw = Qg + ((size_t)(b * SEQ + qb * 128 + rg * 32 + r32)) * DM + h * 128 + mp * 64 + hi * 8;
#pragma unroll
  for (int d0 = 0; d0 < 4; ++d0) qr[d0] = *reinterpret_cast<const bf16x8*>(Qw + d0 * 16);
  const int sr = tid >> 4, sc = (tid & 15) * 8, vst0 = v_st(sr, sc), vst1 = v_st(32 + sr, sc);
  const int vb0 = (int)(uintptr_t)V_lds + v_rd_base(lane);
  struct { bf16x8 vs0, vs1, ks0, ks1; } sr_[2];
#define SLOAD(i, k0) do { sr_[i].vs0 = *(const bf16x8*)(&Vh[(size_t)((k0) + sr) * LDK + sc]); sr_[i].vs1 = *(const bf16x8*)(&Vh[(size_t)((k0) + 32 + sr) * LDK + sc]); \
    sr_[i].ks0 = *(const bf16x8*)(&Kh[(size_t)((k0) + sr) * LDK + sc]); sr_[i].ks1 = *(const bf16x8*)(&Kh[(size_t)((k0) + 32 + sr) * LDK + sc]); } while (0)
#define SWRITE(bb, i) do { *(bf16x8*)(V_lds + (bb) * SHM_V + vst0) = sr_[i].vs0;          \
    *(bf16x8*)(V_lds + (bb) * SHM_V + vst1) = sr_[i].vs1; int kc = sc * 2;               \
    *(bf16x8*)(K_lds + (bb) * SHM_K + KSWZ(sr, kc)) = sr_[i].ks0;                       \
    *(bf16x8*)(K_lds + (bb) * SHM_K + KSWZ(32 + sr, kc)) = sr_[i].ks1; } while (0)
#define SWAIT() asm volatile("s_waitcnt vmcnt(4)" ::: "memory")
#define RESC(a) do { if (__any((a) < 1.f)) { if (hi == 0) al_l[r32] = (a); asm volatile("s_waitcnt lgkmcnt(0)" ::: "memory"); \
    _Pragma("unroll") for (int d = 0; d < 4; ++d) _Pragma("unroll") for (int r = 0; r < 16; ++r) o[d][r] *= al_l[crow(r, hi)]; } } while (0)
  f32x16 pA0, pA1, pB0, pB1; float mnA, mnB, alA, alB; bf16x8 pa0, pa1, pa2, pa3;
  constexpr int SE = 0, SO = 1;
  SLOAD(SE, 0); asm volatile("s_waitcnt vmcnt(0)" ::: "memory"); SWRITE(0, SE); __syncthreads();
  qkt(pA0, pA1, K_lds, qr, r32, hi, mp); partialSM(pA0, pA1, m_reg, mnA, alA);
  SLOAD(SO, KVBLK); SLOAD(SE, 2 * KVBLK);
  SWAIT(); SWRITE(1, SO); __syncthreads();
  for (int j = 1; j + 1 < NT; j += 2) {
    SBAR(); qkt(pB0, pB1, K_lds + SHM_K, qr, r32, hi, mp);
    finishSM(pA0, pA1, alA, l_reg, pa0, pa1, pa2, pa3); SBAR();
    SLOAD(SO, (j + 2) * KVBLK); SBAR();
    pv_d0(o, vb0, pa0, pa1, pa2, pa3); partialSM(pB0, pB1, m_reg, mnB, alB);
    __syncthreads(); SWAIT(); SWRITE(0, SE);
    RESC(alB); __syncthreads();
    SBAR(); qkt(pA0, pA1, K_lds, qr, r32, hi, mp);
    finishSM(pB0, pB1, alB, l_reg, pa0, pa1, pa2, pa3); SBAR();
    if (j + 3 < NT) SLOAD(SE, (j + 3) * KVBLK); SBAR();
    pv_d0(o, vb0 + SHM_V, pa0, pa1, pa2, pa3); partialSM(pA0, pA1, m_reg, mnA, alA);
    __syncthreads(); SWAIT(); SWRITE(1, SO);
    RESC(alA); __syncthreads();
  }
  SBAR(); qkt(pB0, pB1, K_lds + SHM_K, qr, r32, hi, mp);
  finishSM(pA0, pA1, alA, l_reg, pa0, pa1, pa2, pa3); SBAR();
  pv_d0(o, vb0, pa0, pa1, pa2, pa3); partialSM(pB0, pB1, m_reg, mnB, alB);
  __syncthreads(); RESC(alB);
  finishSM(pB0, pB1, alB, l_reg, pa0, pa1, pa2, pa3); SBAR();
  pv_d0(o, vb0 + SHM_V, pa0, pa1, pa2, pa3);
  if (hi == 0) li_l[r32] = l_reg; asm volatile("s_waitcnt lgkmcnt(0)" ::: "memory");
  float rli[16];
#pragma unroll
  for (int r = 0; r < 16; ++r) rli[r] = __builtin_amdgcn_rcpf(li_l[crow(r, hi)]);
  __syncthreads();
  { float* Ob = (float*)lds + (size_t)(mp * 128 + rg * 32) * 132;
#pragma unroll
    for (int r = 0; r < 16; ++r) { const int orow = crow(r, hi);
#pragma unroll
      for (int d0 = 0; d0 < 4; ++d0) Ob[orow * 132 + d0 * 32 + r32] = o[d0][r] * rli[r]; } }
  __syncthreads();
  { const int row = tid >> 2, q4 = tid & 3;
    const float* o0 = (const float*)lds + (size_t)row * 132 + q4 * 32; const float* o1 = o0 + 128 * 132;
    float d[32]; float ss = 0.f;
#pragma unroll
    for (int i = 0; i < 32; i += 4) { const f32x4 a = *(const f32x4*)(o0 + i), c = *(const f32x4*)(o1 + i);
#pragma unroll
      for (int q = 0; q < 4; ++q) { d[i + q] = a[q] - lam * c[q]; ss += d[i + q] * d[i + q]; } }
    ss += __shfl_xor(ss, 1); ss += __shfl_xor(ss, 2);
    const float rn = 0.8f / sqrtf(ss * (1.f / 128.f) + NORM_EPS);
    bf16_t* op = AX + ((size_t)(b * SEQ + qb * 128 + row)) * DM + h * 128 + q4 * 32; const float* gp = subg + q4 * 32;
#pragma unroll
    for (int i = 0; i < 32; i += 8) { u32x4 w;
      w.x = cvt_pk_bf16(d[i] * rn * gp[i], d[i + 1] * rn * gp[i + 1]); w.y = cvt_pk_bf16(d[i + 2] * rn * gp[i + 2], d[i + 3] * rn * gp[i + 3]);
      w.z = cvt_pk_bf16(d[i + 4] * rn * gp[i + 4], d[i + 5] * rn * gp[i + 5]); w.w = cvt_pk_bf16(d[i + 6] * rn * gp[i + 6], d[i + 7] * rn * gp[i + 7]);
      *(u32x4*)(op + i) = w; } }
  __syncthreads();
#undef SLOAD
#undef SWRITE
#undef SWAIT
#undef RESC
}
__device__ __forceinline__ void attn_phase(const Ctx& C, const float* subg, bf16_t* AXo, char* lds) {
  const bf16_t* Qg = (const bf16_t*)(C.ws + WS_Q); const bf16_t* Kall = (const bf16_t*)(C.ws + WS_K); const bf16_t* Vall = (const bf16_t*)(C.ws + WS_V);
  const float lam = *(const float*)(C.ws + WS_LAM);
  if (C.G == 256) { const int vcu = (C.bid & 7) * 32 + (C.bid >> 3);
    for (int i = 0; i < 8; ++i) { const int bh = (vcu >> 5) * 8 + i, qb = vcu & 31; attn_unit(Qg, Kall, Vall, AXo, lam, subg, bh >> 3, bh & 7, qb, lds); }
  } else {
    for (int L = C.bid; L < 2048; L += C.G) attn_unit(Qg, Kall, Vall, AXo, lam, subg, L >> 8, (L >> 5) & 7, L & 31, lds);
  }
}
#undef KSWZ
#undef SBAR
}
namespace hyn {
__device__ __forceinline__ float block_sum(float v, float* red, int tid) {
    v = wave_sum(v);
    __syncthreads();
    if ((tid & 63) == 0) red[tid >> 6] = v;
    __syncthreads();
    float s = 0.f;
#pragma unroll
    for (int i = 0; i < 8; ++i) s += red[i];
    return s;
}
__device__ __forceinline__ void build_kernel(const Params& p, const Ctx& C, int o, int c, float* kern, float* w3s, float* red) {
    const float* hdn = (const float*)(C.ws + WS_HDN); const float* w3 = p.in[I_FW3];
    __syncthreads();
    if (C.tid < 128) { const int dir = C.tid >> 6, k = C.tid & 63; w3s[C.tid] = w3[(size_t)k * 4096 + o * 2048 + dir * 1024 + c]; }
    __syncthreads();
    const float a = -3.0701134573253944f, bq = -15.350567286626972f;
    const float delta = fabsf(a + (float)c * ((bq - a) / 1023.f));
    float hf[8], hb[8]; float asum = 0.f;
#pragma unroll
    for (int j = 0; j < 8; ++j) { const int t = C.tid + 512 * j; const float* hr = hdn + t * 64; float sf = 0.f, sb = 0.f;
#pragma unroll 8
        for (int k = 0; k < 64; ++k) { const float hv = hr[k]; sf += hv * w3s[k]; sb += hv * w3s[64 + k]; }
        const float dec = expf(-((float)t * (1.f / 4095.f)) * delta);
        hf[j] = sf * dec; hb[j] = sb * dec; asum += fabsf(hf[j]) + (t > 0 ? fabsf(hb[j]) : 0.f); }
    const float tot = block_sum(asum, red, C.tid); const float inv = 1.f / tot;
#pragma unroll
    for (int j = 0; j < 8; ++j) { const int t = C.tid + 512 * j; kern[4096 + t] = hf[j] * inv; if (t > 0) kern[4096 - t] = hb[j] * inv; }
    if (C.tid == 0) kern[0] = 0.f;
    __syncthreads();
}
__device__ __forceinline__ void hyena_naive_phase(const Params& p, const Ctx& C, char* lds) {
    float* kern = (float*)lds;
    float* zb = (float*)(lds + 32768);
    float* w3s = (float*)(lds + 32768 + 65536);
    float* red = w3s + 128;
    const bf16_t* UT = (const bf16_t*)(C.ws + WS_UT); bf16_t* YX = (bf16_t*)(C.ws + WS_HX);
    const float* cw = p.in[I_HCW]; const float* cb = p.in[I_HCB]; const float* hyb = p.in[I_HYB];
    for (int unit = C.bid; unit < 2048; unit += C.G) {
        const int c = unit >> 1, bh = unit & 1;
        float vreg[8][4];
#pragma unroll
        for (int j = 0; j < 8; ++j) { const int t = C.tid + 512 * j;
#pragma unroll
            for (int bb = 0; bb < 4; ++bb) { const bf16_t* u = UT + ((size_t)(bh * 4 + bb) * 3072 + c) * SEQ;
                const float um = t > 0 ? bf2f(u[t - 1]) : 0.f, u0 = bf2f(u[t]), up = t < SEQ - 1 ? bf2f(u[t + 1]) : 0.f;
                vreg[j][bb] = um * cw[c] + u0 * cw[3072 + c] + up * cw[6144 + c] + cb[c]; } }
        for (int o = 0; o < 2; ++o) {
            build_kernel(p, C, o, c, kern, w3s, red);
#pragma unroll
            for (int j = 0; j < 8; ++j) { const int t = C.tid + 512 * j; *(f32x4*)(zb + t * 4) = (f32x4){vreg[j][0], vreg[j][1], vreg[j][2], vreg[j][3]}; }
            __syncthreads();
            float acc[8][4];
#pragma unroll
            for (int j = 0; j < 8; ++j)
#pragma unroll
                for (int bb = 0; bb < 4; ++bb) acc[j][bb] = 0.f;
            for (int s = 0; s < SEQ; ++s) { const f32x4 z4 = *(const f32x4*)(zb + s * 4);
#pragma unroll
                for (int j = 0; j < 8; ++j) { const float kv = kern[4096 + C.tid + 512 * j - s];
#pragma unroll
                    for (int bb = 0; bb < 4; ++bb) acc[j][bb] += kv * z4[bb]; } }
            const float bias = hyb[o * 1024 + c]; const int xc = (o + 1) * 1024 + c;
#pragma unroll
            for (int j = 0; j < 8; ++j) { const int t = C.tid + 512 * j;
#pragma unroll
                for (int bb = 0; bb < 4; ++bb) { const bf16_t* u = UT + ((size_t)(bh * 4 + bb) * 3072 + xc) * SEQ;
                    const float um = t > 0 ? bf2f(u[t - 1]) : 0.f, u0 = bf2f(u[t]), up = t < SEQ - 1 ? bf2f(u[t + 1]) : 0.f;
                    const float xg = um * cw[xc] + u0 * cw[3072 + xc] + up * cw[6144 + xc] + cb[xc];
                    vreg[j][bb] = xg * (acc[j][bb] + vreg[j][bb] * bias); } }
            __syncthreads();
        }
#pragma unroll
        for (int j = 0; j < 8; ++j) { const int t = C.tid + 512 * j;
#pragma unroll
            for (int bb = 0; bb < 4; ++bb) YX[((size_t)(bh * 4 + bb) * SEQ + t) * DM + c] = (bf16_t)(cvt_pk_bf16(vreg[j][bb], 0.f) & 0xffffu); }
    }
}
}
namespace hym {
constexpr size_t WS_TAB0 = WS_WIN;
constexpr size_t WS_TAB1 = 492 * MiB;
constexpr int ZBLK = 134, ZHS = ZBLK * 256, Z_BYTES = 2 * ZHS;
constexpr int KCS = 16448, KC_OFF = Z_BYTES, KC_BYTES = 4 * KCS, SCR_OFF = KC_OFF + KC_BYTES;
static_assert(SCR_OFF + 256 <= 147456, "hyena LDS");

__device__ __forceinline__ void table_phase(const Params& p, const Ctx& C, char* lds) {
    const float* hdn = (const float*)(C.ws + WS_HDN); const float* w3 = p.in[I_FW3];
    float* w3s = (float*)lds;
    float* red = w3s + 512;
    for (int unit = C.bid; unit < 512; unit += C.G) {
        const int o = unit >> 8, c0 = (unit & 255) * 4;
        __syncthreads();
        int tq = C.tid; asm volatile("" : "+v"(tq));
        { const int col = C.tid >> 6, k = C.tid & 63; const int dir = col >> 2, cc = col & 3; w3s[col * 64 + k] = w3[(size_t)k * 4096 + o * 2048 + dir * 1024 + c0 + cc]; }
        __syncthreads();
        float dl[4];
#pragma unroll
        for (int cc = 0; cc < 4; ++cc) { const float a = -3.0701134573253944f, bq = -15.350567286626972f; dl[cc] = fabsf(a + (float)(c0 + cc) * ((bq - a) / 1023.f)); }
        float h[8][8]; float asum[4] = {0.f, 0.f, 0.f, 0.f};
#pragma unroll
        for (int j = 0; j < 8; ++j) { const int t = tq + 512 * j; const float* hr = hdn + t * 64;
            float s[8];
#pragma unroll
            for (int q = 0; q < 8; ++q) s[q] = 0.f;
#pragma unroll 4
            for (int k4 = 0; k4 < 16; ++k4) { const f32x4 hv = *(const f32x4*)(hr + 4 * k4);
#pragma unroll
                for (int q = 0; q < 8; ++q) { const f32x4 wv = *(const f32x4*)(w3s + q * 64 + 4 * k4); s[q] += hv[0] * wv[0] + hv[1] * wv[1] + hv[2] * wv[2] + hv[3] * wv[3]; } }
            const float tn = (float)t * (1.f / 4095.f);
#pragma unroll
            for (int cc = 0; cc < 4; ++cc) { const float dec = expf(-tn * dl[cc]); h[j][cc] = s[cc] * dec; h[j][4 + cc] = s[4 + cc] * dec; asum[cc] += fabsf(h[j][cc]) + (t > 0 ? fabsf(h[j][4 + cc]) : 0.f); } }
#pragma unroll
        for (int cc = 0; cc < 4; ++cc) asum[cc] = wave_sum(asum[cc]);
        if (C.lane == 0) { red[C.wave * 4 + 0] = asum[0]; red[C.wave * 4 + 1] = asum[1]; red[C.wave * 4 + 2] = asum[2]; red[C.wave * 4 + 3] = asum[3]; }
        __syncthreads();
        float inv[4];
#pragma unroll
        for (int cc = 0; cc < 4; ++cc) { float s = 0.f;
#pragma unroll
            for (int w = 0; w < 8; ++w) s += red[w * 4 + cc];
            inv[cc] = 1.f / s; }
        bf16_t* tab = (bf16_t*)(C.ws + (o ? WS_TAB1 : WS_TAB0));
#pragma unroll
        for (int cc = 0; cc < 4; ++cc) { bf16_t* row = tab + (size_t)(c0 + cc) * 8192;
#pragma unroll
            for (int j = 0; j < 8; ++j) { const int t = tq + 512 * j;
                row[4096 - t] = (bf16_t)(cvt_pk_bf16(h[j][cc] * inv[cc], 0.f) & 0xffffu);
                if (t > 0) row[4096 + t] = (bf16_t)(cvt_pk_bf16(h[j][4 + cc] * inv[cc], 0.f) & 0xffffu); }
            if (C.tid == 0) row[0] = 0; }
    }
}

__device__ __forceinline__ int zaddr(int b, int t) {
    const int tp = t + 96, Jp = tp >> 5, g = (tp >> 3) & 3;
    return (b >> 2) * ZHS + Jp * 256 + ((((g ^ (Jp & 3)) << 2) | (b & 3)) << 4) + (tp & 7) * 2;
}
__device__ __forceinline__ void conv3_8(const bf16_t* urow, int t0, float w0, float w1, float w2, float bias, float (&out)[8]) {
    const u32x4 raw = *(const u32x4*)(urow + t0);
    float u[10];
    u[0] = t0 > 0 ? bf2f(urow[t0 - 1]) : 0.f; u[9] = (t0 + 8 < SEQ) ? bf2f(urow[t0 + 8]) : 0.f;
    u[1] = bflo(raw.x); u[2] = bfhi(raw.x); u[3] = bflo(raw.y); u[4] = bfhi(raw.y); u[5] = bflo(raw.z); u[6] = bfhi(raw.z); u[7] = bflo(raw.w); u[8] = bfhi(raw.w);
#pragma unroll
    for (int e = 0; e < 8; ++e) out[e] = u[e] * w0 + u[e + 1] * w1 + u[e + 2] * w2 + bias;
}
__device__ __forceinline__ u32x4 pack8f(const float (&v)[8]) { u32x4 w; w.x = cvt_pk_bf16(v[0], v[1]); w.y = cvt_pk_bf16(v[2], v[3]); w.z = cvt_pk_bf16(v[4], v[5]); w.w = cvt_pk_bf16(v[6], v[7]); return w; }

__device__ __forceinline__ void build_kc(const bf16_t* trow, char* lds, int tid) {
#pragma unroll
    for (int q = 0; q < 2; ++q) { const int m = tid + 512 * q;
        const u32x4 cur = *(const u32x4*)(trow + 8 * m); u32x4 prv = {0u, 0u, 0u, 0u}; if (m > 0) prv = *(const u32x4*)(trow + 8 * m - 8);
        const unsigned s2 = prv.z, s3 = prv.w, s4 = cur.x, s5 = cur.y, s6 = cur.z, s7 = cur.w;
        const u32x4 c0 = cur;
        const u32x4 c1 = {__builtin_amdgcn_alignbit(s4, s3, 16), __builtin_amdgcn_alignbit(s5, s4, 16), __builtin_amdgcn_alignbit(s6, s5, 16), __builtin_amdgcn_alignbit(s7, s6, 16)};
        const u32x4 c2 = {s3, s4, s5, s6};
        const u32x4 c3 = {__builtin_amdgcn_alignbit(s3, s2, 16), __builtin_amdgcn_alignbit(s4, s3, 16), __builtin_amdgcn_alignbit(s5, s4, 16), __builtin_amdgcn_alignbit(s6, s5, 16)};
        *(u32x4*)(lds + KC_OFF + 0 * KCS + 16 * m) = c0; *(u32x4*)(lds + KC_OFF + 1 * KCS + 16 * m) = c1;
        *(u32x4*)(lds + KC_OFF + 2 * KCS + 16 * m) = c2; *(u32x4*)(lds + KC_OFF + 3 * KCS + 16 * m) = c3; }
}

__device__ __forceinline__ void conv_loop(f32x16 (&acc)[4], const char* lds, int wave, int lane) {
    const int i = lane & 31, hh = lane >> 5, jj = (lane >> 3) & 3, bq = lane & 3, bhh = (lane >> 2) & 1;
    const int Xb = 16 * wave;
    for (int dm = 0; dm < 4; ++dm) {
        const int dlo = Xb - 127 + ((dm - (Xb - 127)) & 3);
        const int sw = (jj + 3 - dm) & 3;
        const char* pB0 = lds + bhh * ZHS + bq * 16 + (((hh) ^ sw) << 6) + (jj + 3) * 256 + (Xb - dlo) * 256;
        const char* pB1 = lds + bhh * ZHS + bq * 16 + (((2 + hh) ^ sw) << 6) + (jj + 3) * 256 + (Xb - dlo) * 256;
        const char* pA = lds + KC_OFF + (i & 3) * KCS + 2 * (4096 - (i & ~3) + 8 * hh) - 64 * dlo;
#pragma unroll 1
        for (int d = dlo; d <= Xb + 15; d += 4) {
            const s16x4 a00 = *(const s16x4*)(pA), a01 = *(const s16x4*)(pA + 8), a10 = *(const s16x4*)(pA + 32), a11 = *(const s16x4*)(pA + 40);
            const bf16x8 a0 = {a00[0], a00[1], a00[2], a00[3], a01[0], a01[1], a01[2], a01[3]}, a1 = {a10[0], a10[1], a10[2], a10[3], a11[0], a11[1], a11[2], a11[3]};
#pragma unroll
            for (int k = 0; k < 4; ++k) { const int J0 = Xb + 4 * k - d;
                if (J0 >= -3 && J0 <= 127) {
                    const bf16x8 b0 = *(const bf16x8*)(pB0 + k * 1024), b1 = *(const bf16x8*)(pB1 + k * 1024);
                    acc[k] = __builtin_amdgcn_mfma_f32_32x32x16_bf16(a0, b0, acc[k], 0, 0, 0);
                    acc[k] = __builtin_amdgcn_mfma_f32_32x32x16_bf16(a1, b1, acc[k], 0, 0, 0); } }
            pA -= 256; pB0 -= 1024; pB1 -= 1024;
        }
    }
}

__device__ __forceinline__ void hyena_phase(const Params& p, const Ctx& C, char* lds) {
    const bf16_t* UT = (const bf16_t*)(C.ws + WS_UT); bf16_t* YX = (bf16_t*)(C.ws + WS_HX);
    const float* cw = p.in[I_HCW]; const float* cb = p.in[I_HCB]; const float* hyb = p.in[I_HYB];
    const int lane = C.lane, wave = C.wave, tid = C.tid;
    __syncthreads();
    if (tid < 384) { const int bh = tid / 192, r = tid % 192, blk = r / 32, off = (r % 32) * 8; const int Jp = blk < 3 ? blk : 128 + blk;
        *(unsigned long long*)(lds + bh * ZHS + Jp * 256 + off) = 0ull; }
    for (int c = C.bid; c < 1024; c += C.G) {
        __syncthreads();
        { const bf16_t* urow = UT + ((size_t)wave * 3072 + c) * SEQ; const float w0 = cw[c], w1 = cw[3072 + c], w2 = cw[6144 + c], bs = cb[c];
#pragma unroll 2
            for (int ch = 0; ch < 8; ++ch) { const int t0 = ch * 512 + lane * 8; float v[8]; conv3_8(urow, t0, w0, w1, w2, bs, v); *(u32x4*)(lds + zaddr(wave, t0)) = pack8f(v); } }
#pragma unroll 1
        for (int o = 0; o < 2; ++o) {
            build_kc((const bf16_t*)(C.ws + (o ? WS_TAB1 : WS_TAB0)) + (size_t)c * 8192, lds, tid);
            __syncthreads();
            f32x16 acc[4];
#pragma unroll
            for (int k = 0; k < 4; ++k) acc[k] = f32x16{};
            conv_loop(acc, lds, wave, lane);
            __syncthreads();
            { const int xc = (o + 1) * 1024 + c; const bf16_t* urow = UT + ((size_t)wave * 3072 + xc) * SEQ; const float w0 = cw[xc], w1 = cw[3072 + xc], w2 = cw[6144 + xc], bs = cb[xc];
#pragma unroll 2
                for (int ch = 0; ch < 8; ++ch) { const int t0 = ch * 512 + lane * 8; float v[8]; conv3_8(urow, t0, w0, w1, w2, bs, v); *(u32x4*)(lds + KC_OFF + wave * 8192 + t0 * 2) = pack8f(v); } }
            __syncthreads();
            const float bias = hyb[o * 1024 + c];
            int lb = lane; asm volatile("" : "+v"(lb));
            const int b = lb & 7, jj = (lb >> 3) & 3, hi = lb >> 5, sw = (jj + 3) & 3;
            const int zb = (b >> 2) * ZHS + (16 * wave + jj + 3) * 256 + ((b & 3) << 4) + 8 * hi;
            const int xb = KC_OFF + b * 8192 + 64 * (16 * wave + jj) + 8 * hi;
            bf16_t* yb = YX + ((size_t)b * SEQ + 32 * (16 * wave + jj) + 4 * hi) * DM + c;
#pragma unroll
            for (int g = 0; g < 4; ++g) { const int zg = zb + ((g ^ sw) << 6);
#pragma unroll
                for (int k = 0; k < 4; ++k)
#pragma unroll
                    for (int q = 0; q < 4; ++q) { const int r = 4 * g + q;
                        bf16_t* zp = (bf16_t*)(lds + zg + k * 1024 + 2 * q);
                        const float zin = bf2f(*zp), xg = bf2f(*(const bf16_t*)(lds + xb + k * 256 + 2 * q + 16 * g));
                        const float val = xg * (acc[k][r] + zin * bias);
                        const bf16_t ob = (bf16_t)(cvt_pk_bf16(val, 0.f) & 0xffffu);
                        if (o == 0) *zp = ob; else yb[(size_t)(128 * k + q + 8 * g) * DM] = ob; } }
            __syncthreads();
        }
    }
}
}
namespace moe {
__device__ __forceinline__ void route_phase(const Params& p, const Ctx& C, const float* xnew, char* lds) {
    const float* mod = (const float*)(C.ws + WS_MOD); const float* g = p.in[I_N2G]; const float* rw = p.in[I_RW]; const float* rb = p.in[I_RB];
    bf16_t* HX2 = (bf16_t*)(C.ws + WS_HX); int* eidx = (int*)(C.ws + WS_EIDX); float* wsel = (float*)(C.ws + WS_WSEL); int* counts = (int*)(C.ws + WS_CNT);
    float* hb = (float*)(lds + C.wave * 16384);
    int* hist = (int*)(lds + 8 * 16384);
    if (C.tid < 64) hist[C.tid] = 0;
    __syncthreads();
    const int gw = C.bid * 8 + C.wave, NGW = C.G * 8, lane = C.lane;
    const float bias = rb[lane];
    for (int grp = gw; grp < NTOK / 4; grp += NGW) {
        const int tok0 = grp * 4; const int b = tok0 >> 12;
        const float* sh = mod + b * 6144 + 3072; const float* sc = sh + 1024;
        f32x4 v[4][4];
#pragma unroll
        for (int i = 0; i < 4; ++i) { const float* xr = xnew + (size_t)(tok0 + i) * DM; float ss = 0.f;
#pragma unroll
            for (int j = 0; j < 4; ++j) { v[i][j] = *(const f32x4*)(xr + 256 * j + 4 * lane); ss += (v[i][j].x * v[i][j].x + v[i][j].y * v[i][j].y) + (v[i][j].z * v[i][j].z + v[i][j].w * v[i][j].w); }
            const float rn = 1.0f / sqrtf(wave_sum(ss) * (1.f / DM) + NORM_EPS);
#pragma unroll
            for (int j = 0; j < 4; ++j) { const int k = 256 * j + 4 * lane;
                const f32x4 gv = *(const f32x4*)(g + k), scv = *(const f32x4*)(sc + k), shv = *(const f32x4*)(sh + k);
                v[i][j] = v[i][j] * rn * gv * (1.f + scv) + shv;
                u32x2 w; w.x = cvt_pk_bf16(v[i][j].x, v[i][j].y); w.y = cvt_pk_bf16(v[i][j].z, v[i][j].w);
                *(u32x2*)(HX2 + (size_t)(tok0 + i) * DM + k) = w; } }
#pragma unroll
        for (int j = 0; j < 4; ++j)
#pragma unroll
            for (int e = 0; e < 4; ++e) { const int k = 256 * j + 4 * lane + e; *(f32x4*)(hb + k * 4) = (f32x4){v[0][j][e], v[1][j][e], v[2][j][e], v[3][j][e]}; }
        asm volatile("s_waitcnt lgkmcnt(0)" ::: "memory");
        float acc[4] = {0.f, 0.f, 0.f, 0.f};
#pragma unroll 8
        for (int k = 0; k < DM; ++k) { const float w = rw[k * 64 + lane]; const f32x4 h4 = *(const f32x4*)(hb + k * 4);
            acc[0] += h4[0] * w; acc[1] += h4[1] * w; acc[2] += h4[2] * w; acc[3] += h4[3] * w; }
#pragma unroll
        for (int i = 0; i < 4; ++i) {
            const float s = 1.f / (1.f + expf(-acc[i])); const float ch = s + bias;
            float m1 = ch; m1 = fmaxf(m1, __shfl_xor(m1, 1)); m1 = fmaxf(m1, __shfl_xor(m1, 2)); m1 = fmaxf(m1, __shfl_xor(m1, 4));
            const unsigned long long eq = __ballot(ch == m1); const int gidx = lane >> 3; const unsigned gm = (unsigned)(eq >> (8 * gidx)) & 0xffu; const int first = __builtin_ctz(gm);
            float c2 = ((lane & 7) == first) ? -INFINITY : ch;
            float m2 = c2; m2 = fmaxf(m2, __shfl_xor(m2, 1)); m2 = fmaxf(m2, __shfl_xor(m2, 2)); m2 = fmaxf(m2, __shfl_xor(m2, 4));
            const float gs = m1 + m2; int grank = 0;
#pragma unroll
            for (int g2 = 0; g2 < 8; ++g2) { const float ov = __shfl(gs, 8 * g2); grank += (ov > gs || (ov == gs && g2 < gidx)) ? 1 : 0; }
            const bool gsel = grank < 4; const float mc = gsel ? ch : -INFINITY; int rank = 0;
#pragma unroll 16
            for (int e2 = 0; e2 < 64; ++e2) { const float ov = __shfl(mc, e2); rank += (ov > mc || (ov == mc && e2 < lane)) ? 1 : 0; }
            const bool sel = gsel && rank < 8;
            const float tot = wave_sum(sel ? s : 0.f);
            if (sel) { eidx[(tok0 + i) * 8 + rank] = lane; wsel[(tok0 + i) * 8 + rank] = s / tot * 2.5f; atomicAdd(&hist[lane], 1); }
        }
    }
    __syncthreads();
    if (C.tid < 64 && hist[C.tid] > 0) atomicAdd(&counts[C.tid], hist[C.tid]);
}

__device__ __forceinline__ void place_phase(const Ctx& C, char* lds) {
    int* counts = (int*)(C.ws + WS_CNT); int* cursor = counts + 64; int* ntp = counts + 128; int* tile_e = (int*)(C.ws + WS_TILEE);
    int* row_tok = (int*)(C.ws + WS_ROWTOK); int* pos = (int*)(C.ws + WS_POS); const int* eidx = (const int*)(C.ws + WS_EIDX);
    int* pst = (int*)lds;
    int* lh = pst + 80;
    int* lbase = lh + 64;
    if (C.tid == 0) { int a = 0; for (int e = 0; e < 64; ++e) { pst[e] = a; const int cnt = __hip_atomic_load(counts + e, __ATOMIC_RELAXED, __HIP_MEMORY_SCOPE_AGENT); a += (cnt + 255) / 256 * 256; } pst[64] = a; }
    __syncthreads();
    const int P = pst[64];
    if (C.bid == 0) {
        if (C.tid == 0) *ntp = P / 256 + 128;
        for (int t = C.tid; t < P / 256 + 128; t += 512) { int e = 64; const int r = t * 256; if (r < P) { e = 0; while (pst[e + 1] <= r) ++e; } tile_e[t] = e; }
    }
    for (int chunk = C.bid; chunk < NTOK / 128; chunk += C.G) {
        if (C.tid < 64) lh[C.tid] = 0;
        __syncthreads();
        int e_[2], lr_[2];
#pragma unroll
        for (int q = 0; q < 2; ++q) { const int a = C.tid + 512 * q; const int tok = chunk * 128 + (a >> 3); e_[q] = eidx[tok * 8 + (a & 7)]; lr_[q] = atomicAdd(&lh[e_[q]], 1); }
        __syncthreads();
        if (C.tid < 64) lbase[C.tid] = lh[C.tid] > 0 ? atomicAdd(&cursor[C.tid], lh[C.tid]) : 0;
        __syncthreads();
#pragma unroll
        for (int q = 0; q < 2; ++q) { const int a = C.tid + 512 * q; const int tok = chunk * 128 + (a >> 3); const int dest = pst[e_[q]] + lbase[e_[q]] + lr_[q]; row_tok[dest] = tok; pos[tok * 8 + (a & 7)] = dest; }
        __syncthreads();
    }
    for (int tok = C.bid * 512 + C.tid; tok < NTOK; tok += C.G * 512) row_tok[P + tok] = tok;
}

struct MoeOrder {
    const int* tile_e; int NT, G, c, NJ, PNE, colq;
    __device__ bool next(int i, pg8::Unit& u) const {
        const long L = (long)i * G + c; if (L >= (long)NT * NJ) return false;
        const int t = (int)(L / NJ), j = (int)(L % NJ);
        u.pm = t; u.pn = __hip_atomic_load(tile_e + t, __ATOMIC_RELAXED, __HIP_MEMORY_SCOPE_AGENT) * PNE + (NJ == 2 ? j : colq); return true;
    }
};

template <bool LAST>
__device__ __forceinline__ void combine_phase(const Params& p, const Ctx& C, int q) {
    const float* mod = (const float*)(C.ws + WS_MOD); const bf16_t* Y = (const bf16_t*)(C.ws + WS_Y);
    const int* pos = (const int*)(C.ws + WS_POS); const float* wsel = (const float*)(C.ws + WS_WSEL);
    const int NT = __hip_atomic_load((const int*)(C.ws + WS_CNT) + 128, __ATOMIC_RELAXED, __HIP_MEMORY_SCOPE_AGENT); const int P = (NT - 128) * 256;
    float* out = p.out; const float* fg = p.in[I_FNG];
    const int gw = C.bid * 8 + C.wave, NGW = C.G * 8, lane = C.lane;
    for (int tok = gw; tok < NTOK; tok += NGW) {
        const int b = tok >> 12; const float* g2 = mod + b * 6144 + 5120 + 256 * q + 4 * lane;
        f32x4 a = {0.f, 0.f, 0.f, 0.f};
#pragma unroll
        for (int k = 0; k < 8; ++k) { const int r = pos[tok * 8 + k]; const float w = wsel[tok * 8 + k]; const u32x2 y = *(const u32x2*)(Y + (size_t)r * 256 + 4 * lane);
            a[0] += w * bflo(y.x); a[1] += w * bfhi(y.x); a[2] += w * bflo(y.y); a[3] += w * bfhi(y.y); }
        { const u32x2 y = *(const u32x2*)(Y + (size_t)(P + tok) * 256 + 4 * lane); a[0] += bflo(y.x); a[1] += bfhi(y.x); a[2] += bflo(y.y); a[3] += bfhi(y.y); }
        float* op = out + (size_t)tok * DM;
        const f32x4 xo = *(const f32x4*)(op + 256 * q + 4 * lane); const f32x4 gv = *(const f32x4*)g2;
        const f32x4 xn = xo + gv * a;
        if (!LAST) { *(f32x4*)(op + 256 * q + 4 * lane) = xn; }
        else {
            f32x4 v[4]; float ss = 0.f;
#pragma unroll
            for (int j = 0; j < 4; ++j) { v[j] = (j == 3) ? xn : *(const f32x4*)(op + 256 * j + 4 * lane); ss += (v[j].x * v[j].x + v[j].y * v[j].y) + (v[j].z * v[j].z + v[j].w * v[j].w); }
            const float rn = 1.0f / sqrtf(wave_sum(ss) * (1.f / DM) + NORM_EPS);
#pragma unroll
            for (int j = 0; j < 4; ++j) { const f32x4 gq = *(const f32x4*)(fg + 256 * j + 4 * lane); *(f32x4*)(op + 256 * j + 4 * lane) = v[j] * rn * gq; }
        }
    }
}
}
#define XB_TMO      128
#define XB_XCNT(j)  (256  + 64 * (j))
#define XB_XSUB(j)  (1280 + 64 * (j))
#define XB_XGEN(j)  (2304 + 64 * (j))
#define XB_TOP      3328
#define XB_TOPGEN   3392
#define XCD_BAR_WORDS 3456
#define XB_SPIN_CAP (1u << 21)

__device__ __forceinline__ unsigned xb_ld(unsigned* p)              { return __hip_atomic_load(p, __ATOMIC_RELAXED, __HIP_MEMORY_SCOPE_AGENT); }
__device__ __forceinline__ unsigned xb_add(unsigned* p, unsigned v) { return __hip_atomic_fetch_add(p, v, __ATOMIC_RELAXED, __HIP_MEMORY_SCOPE_AGENT); }
__device__ __forceinline__ unsigned xb_xcc_id() { return (unsigned)__builtin_amdgcn_s_getreg((3 << 11) | 20) & 0xFu; }
#define XB_SPIN(cond, bar) do { unsigned _sp = 0; while (cond) { __builtin_amdgcn_s_sleep(1); \
    if ((++_sp & 255u) == 0u) { if (xb_ld(&(bar)[XB_TMO])) break; if (_sp > XB_SPIN_CAP) { atomicAdd(&(bar)[XB_TMO], 1u); break; } } } } while (0)

struct XcdBarrier {
    unsigned* bar; unsigned x;
    volatile LAS unsigned* st;
};

__device__ __forceinline__ XcdBarrier xcd_barrier_post(unsigned* bar, volatile LAS unsigned* st) {
    XcdBarrier b; b.bar = bar; b.x = xb_xcc_id(); b.st = st;
    if (threadIdx.x == 0) (void)xb_add(&bar[XB_XCNT(b.x)], 1u);
    return b;
}
__device__ __forceinline__ void xcd_barrier_complete(unsigned* bar, unsigned x, unsigned& nloc, unsigned& nx) {
    const unsigned G = gridDim.x * gridDim.y * gridDim.z;
    unsigned sum, cnt, mine, sp = 0u;
    for (;;) {
        sum = 0u; cnt = 0u; mine = 0u;
#pragma unroll
        for (unsigned j = 0; j < 16; ++j) { const unsigned c = xb_ld(&bar[XB_XCNT(j)]); sum += c; cnt += (c > 0u) ? 1u : 0u; mine = (j == x) ? c : mine; }
        if (sum == G) break;
        __builtin_amdgcn_s_sleep(1);
        if ((++sp & 255u) == 0u) { if (xb_ld(&bar[XB_TMO])) break; if (sp > XB_SPIN_CAP) { atomicAdd(&bar[XB_TMO], 1u); break; } }
    }
    nloc = mine > 0u ? mine : 1u; nx = cnt > 0u ? cnt : 1u;
}

__device__ __forceinline__ void xcd_barrier(const XcdBarrier& b) {
    asm volatile("s_waitcnt vmcnt(0)" ::: "memory");
    __syncthreads();
    if (threadIdx.x == 0) {
        unsigned* bar = b.bar;
        __builtin_amdgcn_s_waitcnt(0);
        unsigned nloc = b.st[0], nx = b.st[1];
        if (nloc == 0u) { xcd_barrier_complete(bar, b.x, nloc, nx); b.st[0] = nloc; b.st[1] = nx; }
        const unsigned old = xb_add(&bar[XB_XSUB(b.x)], 1u);
        const unsigned gen = old / nloc;
        if (old + 1u == (gen + 1u) * nloc) {
            __builtin_amdgcn_fence(__ATOMIC_RELEASE, "agent");
            asm volatile("s_waitcnt vmcnt(0)" ::: "memory");
            const unsigned og = xb_add(&bar[XB_TOP], 1u);
            const unsigned tg = og / nx;
            if (og + 1u == (tg + 1u) * nx) xb_add(&bar[XB_TOPGEN], 1u);
            else XB_SPIN(xb_ld(&bar[XB_TOPGEN]) == tg, bar);
            __builtin_amdgcn_fence(__ATOMIC_ACQUIRE, "agent");
            xb_add(&bar[XB_XGEN(b.x)], 1u);
            asm volatile("s_waitcnt vmcnt(0)" ::: "memory");
        } else {
            XB_SPIN(xb_ld(&bar[XB_XGEN(b.x)]) == gen, bar);
            __builtin_amdgcn_fence(__ATOMIC_ACQUIRE, "agent");
            asm volatile("s_waitcnt vmcnt(0)" ::: "memory");
        }
    }
    __syncthreads();
}

constexpr int LDS_BYTES = 147456;
struct InProjOrder {
    pg8::StaticOrder so; int G, c;
    __device__ bool next(int i, pg8::Unit& u) const {
        const long L = (long)i * G + c;
        if (L < 4096) return so.next(i, u);
        const int r = (int)(L - 4096); if (r >= 64) return false;
        u.pm = 128 + r / 8; u.pn = r % 8; return true;
    }
};

template <int PH> __device__ __forceinline__ void run_phase(const Params& p, unsigned char* lds_) {
    int tid_ = threadIdx.x; asm volatile("" : "+v"(tid_));
    Ctx C; C.tid = tid_; C.lane = C.tid & 63; C.wave = __builtin_amdgcn_readfirstlane(C.tid >> 6); C.G = gridDim.x; C.bid = blockIdx.x; C.ws = p.ws;
    char* lds = (char*)lds_; LAS unsigned char* ldsl = (LAS unsigned char*)lds_;
    unsigned char* ws = C.ws;
    if constexpr (PH == 0) { adaln_phase(p, C, lds); __syncthreads(); wconv_mixer_phase(p, C, lds); hdn_phase(p, C); }
    else if constexpr (PH == 1) { hx_phase(p, C); }
    else if constexpr (PH == 2) {
        pg8::Gemm g{(const bf16_t*)(ws + WS_HX), (const bf16_t*)(ws + WS_WIN), 1024, nullptr};
        InProjOrder S; S.so.init(NTOK, INW, C.G, C.bid); S.G = C.G; S.c = C.bid;
        epi::InProj E{(bf16_t*)(ws + WS_Q), (bf16_t*)(ws + WS_K), (bf16_t*)(ws + WS_V), (bf16_t*)(ws + WS_UT), (bf16_t*)p.out};
        pg8::gemm_phase<epi::InProj, InProjOrder, false>(ldsl, g, S, E);
    }
    else if constexpr (PH == 3) { att::attn_phase(C, p.in[I_SUBG], (bf16_t*)(C.ws + WS_Q), lds); }
    else if constexpr (PH == 22) { att::attn_phase(C, p.in[I_SUBG], (bf16_t*)(C.ws + WS_HX), lds); }
    else if constexpr (PH == 4) { hym::hyena_phase(p, C, lds); }
    else if constexpr (PH == 20) { hym::table_phase(p, C, lds); }
    else if constexpr (PH == 21) { hyn::hyena_naive_phase(p, C, lds); }
    else if constexpr (PH == 5) { wconv_moe_phase(p, C, lds); }
    else if constexpr (PH == 6) {
        pg8::Gemm g{(const bf16_t*)(ws + WS_Q), (const bf16_t*)(ws + WS_WPA), 1024, nullptr};
        pg8::StaticOrder S; S.init(NTOK, DM, C.G, C.bid);
        epi::Merge<0> E{(const bf16_t*)p.out, (bf16_t*)(ws + WS_K)};
        pg8::gemm_phase<epi::Merge<0>, pg8::StaticOrder, false>(ldsl, g, S, E);
    }
    else if constexpr (PH == 7) {
        pg8::Gemm g{(const bf16_t*)(ws + WS_HX), (const bf16_t*)(ws + WS_WPH), 1024, nullptr};
        pg8::StaticOrder S; S.init(NTOK, DM, C.G, C.bid);
        epi::Merge<1> E{(const bf16_t*)p.out, (bf16_t*)(ws + WS_K)};
        pg8::gemm_phase<epi::Merge<1>, pg8::StaticOrder, false>(ldsl, g, S, E);
    }
    else if constexpr (PH == 8) {
        pg8::Gemm g{(const bf16_t*)(ws + WS_K), (const bf16_t*)(ws + WS_WOUT), 1024, nullptr};
        pg8::StaticOrder S; S.init(NTOK, DM, C.G, C.bid);
        epi::OutProj E{p.in[I_X], (const float*)(ws + WS_MOD), p.out};
        pg8::gemm_phase<epi::OutProj, pg8::StaticOrder, false>(ldsl, g, S, E);
    }
    else if constexpr (PH == 9) { moe::route_phase(p, C, p.out, lds); }
    else if constexpr (PH == 10) { moe::place_phase(C, lds); }
    else if constexpr (PH == 11) {
        const int NT = __hip_atomic_load((const int*)(ws + WS_CNT) + 128, __ATOMIC_RELAXED, __HIP_MEMORY_SCOPE_AGENT);
        pg8::Gemm g{(const bf16_t*)(ws + WS_HX), (const bf16_t*)(ws + WS_WGU), 1024, (const int*)(ws + WS_ROWTOK)};
        moe::MoeOrder S{(const int*)(ws + WS_TILEE), NT, C.G, C.bid, 2, 2, 0};
        epi::SwiGLU E{(bf16_t*)(ws + WS_H)};
        pg8::gemm_phase<epi::SwiGLU, moe::MoeOrder, true>(ldsl, g, S, E);
    }
    else if constexpr (PH >= 12 && PH < 20 && (PH & 1) == 0) {
        constexpr int q = (PH - 12) / 2;
        const int NT = __hip_atomic_load((const int*)(ws + WS_CNT) + 128, __ATOMIC_RELAXED, __HIP_MEMORY_SCOPE_AGENT);
        pg8::Gemm g{(const bf16_t*)(ws + WS_H), (const bf16_t*)(ws + WS_WD), 256, nullptr};
        moe::MoeOrder S{(const int*)(ws + WS_TILEE), NT, C.G, C.bid, 1, 4, q};
        epi::Down E{(bf16_t*)(ws + WS_Y)};
        pg8::gemm_phase<epi::Down, moe::MoeOrder, false>(ldsl, g, S, E);
    }
    else if constexpr (PH >= 12 && PH < 20 && (PH & 1) == 1) {
        constexpr int q = (PH - 13) / 2;
        moe::combine_phase<q == 3>(p, C, q);
    }
}


__global__ void __launch_bounds__(512, 2) mega_fwd(Params p) {
    extern __shared__ __attribute__((aligned(16))) unsigned char lds[];
    cg::grid_group grid = cg::this_grid();
    volatile LAS unsigned* xst = (volatile LAS unsigned*)((LAS unsigned char*)lds + LDS_BYTES - 16);
    if (threadIdx.x < 4) xst[threadIdx.x] = 0u;
    __syncthreads();
    const XcdBarrier xbar = xcd_barrier_post((unsigned*)(p.ws + WS_BAR), xst);
#define GSYNC() xcd_barrier(xbar)
    run_phase<0>(p, lds); grid.sync();
#ifdef PROBE_REP0
    run_phase<0>(p, lds); GSYNC();
#endif
    run_phase<1>(p, lds); GSYNC();
#ifdef PROBE_REP1
    run_phase<1>(p, lds); GSYNC();
#endif
    run_phase<2>(p, lds); GSYNC();
#ifdef PROBE_REP2
    run_phase<2>(p, lds); GSYNC();
#endif
    run_phase<20>(p, lds); GSYNC();
#ifdef PROBE_REP3
    run_phase<22>(p, lds); __syncthreads();
#endif
    run_phase<3>(p, lds); __syncthreads();
    run_phase<4>(p, lds); GSYNC();
#ifdef PROBE_REP4
    run_phase<4>(p, lds); GSYNC();
#endif
    run_phase<5>(p, lds); __syncthreads();
    run_phase<6>(p, lds); GSYNC();
#ifdef PROBE_REP6
    run_phase<6>(p, lds); GSYNC();
#endif
    run_phase<7>(p, lds); GSYNC();
    run_phase<8>(p, lds); GSYNC();
#ifdef PROBE_REP9
    run_phase<23>(p, lds); GSYNC();
#endif
    run_phase<9>(p, lds); GSYNC();
    run_phase<10>(p, lds); GSYNC();
    run_phase<11>(p, lds); GSYNC();
#ifdef PROBE_REP11
    run_phase<11>(p, lds); GSYNC();
#endif
    run_phase<12>(p, lds); GSYNC();
#ifdef PROBE_REP12
    run_phase<12>(p, lds); GSYNC();
#endif
    run_phase<13>(p, lds); GSYNC();
    run_phase<14>(p, lds); GSYNC();
    run_phase<15>(p, lds); GSYNC();
    run_phase<16>(p, lds); GSYNC();
    run_phase<17>(p, lds); GSYNC();
    run_phase<18>(p, lds); GSYNC();
#ifdef PROBE_SYNC20
    for (int i = 0; i < 20; ++i) GSYNC();
#endif
    run_phase<19>(p, lds);
}

extern "C" void kernel_launch(void* const* d_in, const int* in_sizes, int n_in, void* d_out, int out_size, void* d_ws, size_t ws_size, hipStream_t stream) {
    static int grid = 0;
    if (grid == 0) {
        if (n_in != 35 || out_size != NTOK * DM || ws_size < WS_END) { fprintf(stderr, "kernel_launch: unexpected shapes: n_in %d out %d ws %zu\n", n_in, out_size, ws_size); grid = -1; return; }
        int dev = 0, cus = 0, per_cu = 0; (void)hipGetDevice(&dev); (void)hipDeviceGetAttribute(&cus, hipDeviceAttributeMultiprocessorCount, dev);
        if (hipFuncSetAttribute((const void*)mega_fwd, hipFuncAttributeMaxDynamicSharedMemorySize, LDS_BYTES) != hipSuccess) { fprintf(stderr, "kernel_launch: hipFuncSetAttribute failed\n"); grid = -1; return; }
        if (hipOccupancyMaxActiveBlocksPerMultiprocessor(&per_cu, (const void*)mega_fwd, 512, LDS_BYTES) != hipSuccess || per_cu < 1) { fprintf(stderr, "kernel_launch: occupancy query failed (%d)\n", per_cu); grid = -1; return; }
        grid = cus * 1;
    }
    if (grid < 0) return;
    Params p{};
    for (int i = 0; i < 35; ++i) p.in[i] = (const float*)d_in[i];
    p.out = (float*)d_out; p.ws = (unsigned char*)d_ws;
    (void)hipMemsetAsync((char*)d_ws + WS_ZERO, 0, WS_ZERO_BYTES, stream);
    void* args[] = {&p};
    hipError_t e = hipLaunchCooperativeKernel((const void*)mega_fwd, dim3(grid), dim3(512), args, LDS_BYTES, stream);
    if (e != hipSuccess) fprintf(stderr, "cooperative launch failed: %s (grid %d)\n", hipGetErrorString(e), grid);
}
```

```cpp
#include <hip/hip_runtime.h>
#include <hip/hip_cooperative_groups.h>
#include <cstdio>
#include <cstdint>
#include <cmath>
namespace cg = cooperative_groups;

#define LAS __attribute__((address_space(3)))
typedef unsigned short bf16_t;
typedef short bf16x8 __attribute__((ext_vector_type(8)));
typedef short s16x4 __attribute__((ext_vector_type(4)));
typedef float f32x2 __attribute__((ext_vector_type(2)));
typedef float f32x4 __attribute__((ext_vector_type(4)));
typedef float f32x8 __attribute__((ext_vector_type(8)));
typedef float f32x16 __attribute__((ext_vector_type(16)));
typedef unsigned u32x2 __attribute__((ext_vector_type(2)));
typedef unsigned u32x4 __attribute__((ext_vector_type(4)));

constexpr int NB = 8, SEQ = 4096, DM = 1024, NTOK = NB * SEQ, CTXL = 256, NCTX = NB * CTXL, MROWS = NTOK + NCTX  , LKV = SEQ + CTXL  ;
constexpr int INW = 8192, NEXP = 64, EH = 256;
constexpr int PMAX_TILES = 1087 + 128;
constexpr float NORM_EPS = 1e-6f;

constexpr size_t MiB = 1u << 20;
constexpr size_t WS_MOD = 0;
constexpr size_t WS_CMOD = 256 * 1024;
constexpr size_t WS_LAM = 320 * 1024;
constexpr size_t WS_HDN = 1 * MiB;
constexpr size_t WS_ZERO = 2 * MiB, WS_ZERO_BYTES = 3 * MiB;
constexpr size_t WS_CNT = 2 * MiB;
constexpr size_t WS_TILEE = 2 * MiB + 65536;
constexpr size_t WS_BAR = 2 * MiB + 131072;
constexpr size_t WS_ROWTOK = 3 * MiB;
constexpr size_t WS_POS = 5 * MiB;
constexpr size_t WS_WSEL = 6 * MiB;
constexpr size_t WS_EIDX = 7 * MiB;
constexpr size_t WS_WIN = 8 * MiB;
constexpr size_t WS_WPA = 24 * MiB, WS_WPH = 26 * MiB, WS_WOUT = 28 * MiB;
constexpr size_t WS_HX = 32 * MiB;
constexpr size_t WS_Q = 100 * MiB;
constexpr size_t WS_K = 164 * MiB;
constexpr size_t WS_V = 232 * MiB;
constexpr size_t WS_UT = 300 * MiB;
constexpr size_t WS_H = 100 * MiB;
constexpr size_t WS_Y = 252 * MiB;
constexpr size_t WS_WGU = 414 * MiB;
constexpr size_t WS_WD = 479 * MiB;
constexpr size_t WS_END = 512 * MiB;
static_assert(WS_WD + (size_t)65 * 1024 * 256 * 2 <= WS_END && WS_Y + (size_t)PMAX_TILES * 256 * 512 <= WS_WGU && WS_H + (size_t)PMAX_TILES * 256 * 512 <= WS_Y, "ws map");

struct Params { const float* in[35]; float* out; unsigned char* ws; };
enum { I_X = 0, I_C, I_CTX, I_CCTX, I_ADAW, I_ADAB, I_N1G, I_N2G, I_WIN, I_LQ1, I_LK1, I_LQ2, I_LK2, I_SUBG, I_HCW, I_HCB, I_FW1, I_FB1, I_FFR, I_FW2, I_FB2, I_FW3, I_HYB,
       I_WPA, I_WPH, I_WOUT, I_RW, I_RB, I_EG, I_EU, I_ED, I_SG, I_SU, I_SD, I_FNG };

__device__ __forceinline__ unsigned cvt_pk_bf16(float lo, float hi) { unsigned r; asm volatile("v_cvt_pk_bf16_f32 %0, %1, %2" : "=v"(r) : "v"(lo), "v"(hi)); return r; }
__device__ __forceinline__ float bf2f(unsigned short h) { return __uint_as_float(((unsigned)h) << 16); }
__device__ __forceinline__ float bflo(unsigned w) { return __uint_as_float(w << 16); }
__device__ __forceinline__ float bfhi(unsigned w) { return __uint_as_float(w & 0xffff0000u); }
__device__ __forceinline__ float wave_sum(float v) {
#pragma unroll
    for (int o = 1; o < 64; o <<= 1) v += __shfl_xor(v, o);
    return v;
}
__device__ __forceinline__ float sigmoidf_(float x) { return 1.f / (1.f + __expf(-x)); }
namespace pg8 {
constexpr int BM = 256, BK = 64, HALF = 128, HTB = HALF * BK * 2  , STAGE_BYTES = 8 * HTB, NXCD = 8, WGM = 8;

__host__ __device__ __forceinline__ int lds_byte(int r, int c) { const int st = (r >> 4) * 2 + (c >> 5), rr = r & 15, cc = c & 31, ob = rr * 64 + cc * 2; return st * 1024 + (ob ^ (((ob >> 9) & 1) << 5)); }
__host__ __device__ __forceinline__ void stage_rc(int b, int& R, int& C) { const int st = b / 1024, sb = b % 1024, swz = sb ^ (((sb >> 9) & 1) << 5); R = (st >> 1) * 16 + swz / 64; C = (st & 1) * 32 + (swz % 64) / 2; }
__host__ __device__ __forceinline__ int perm32(int rho) { const int n = rho >> 4, i = rho & 15; return 8 * (i >> 2) + 4 * n + (i & 3); }

struct Unit { int pm, pn; };
struct Gemm { const bf16_t* A; const bf16_t* Bt; int K; const int* rowidx; };

struct StaticOrder {
    int nM, nN, nwg, G, c;
    __device__ void init(int M, int N, int G_, int c_) { nM = M / BM; nN = N / BM; nwg = nM * nN; G = G_; c = c_; }
    __device__ bool next(int i, Unit& u) const {
        const long L = (long)i * G + c; if (L >= nwg) return false;
        int wgid = (int)L; { const int q = nwg / NXCD, r = nwg % NXCD, xcd = wgid % NXCD, off = wgid / NXCD; wgid = (xcd < r ? xcd * (q + 1) : r * (q + 1) + (xcd - r) * q) + off; }
        const int nig = WGM * nN, gid = wgid / nig, fm = gid * WGM, gsz = (nM - fm) < WGM ? (nM - fm) : WGM;
        u.pm = fm + ((wgid % nig) % gsz); u.pn = (wgid % nig) / gsz; return true;
    }
};

template <class Epi, class Sched, bool GATHER>
__device__ __forceinline__ void gemm_phase(LAS unsigned char* lds, const Gemm g, const Sched& S, const Epi& E) {
    int tid_ = threadIdx.x; asm volatile("" : "+v"(tid_));
    const int tid = tid_, wid = __builtin_amdgcn_readfirstlane(tid >> 6), lane = tid & 63, wr = wid >> 2, wc = wid & 3, fr = lane & 15, fq = lane >> 4;
    const int K = g.K, nt = K / BK;
    int sR[2], sC[2];
    unsigned voffB[2];
#pragma unroll
    for (int i = 0; i < 2; ++i) { int R, C; stage_rc(tid * 16 + i * 8192, R, C); sR[i] = R; sC[i] = C; const int Rb = (R & ~31) + perm32(R & 31); voffB[i] = (unsigned)(Rb * K + C) * 2u; }
    const size_t kstep = (size_t)(BK * 2);
    const size_t hstep = (size_t)HALF * K * 2;
    const size_t tstep = 2 * hstep;
    const unsigned ldsw = (unsigned)wid * 1024u;
    const int aoff = lds_byte(wr * 64 + fr, fq * 8), boff = lds_byte(wc * 32 + fr, fq * 8);
#define PG8_SA(b, h) (((b) * 2 + (h)) * HTB)
#define PG8_SB(b, h) ((4 + (b) * 2 + (h)) * HTB)
#define PG8_STAGEB(bufoff, gbase) do { _Pragma("unroll") for (int _i = 0; _i < 2; ++_i) \
        __builtin_amdgcn_global_load_lds((const unsigned*)((const char*)(gbase) + voffB[_i]), (LAS unsigned*)(lds + (bufoff) + ldsw + _i * 8192), 16, 0, 0); } while (0)
#define PG8_STAGEA(bufoff, gbase, v0, v1) do { \
        __builtin_amdgcn_global_load_lds((const unsigned*)((const char*)(gbase) + (v0)), (LAS unsigned*)(lds + (bufoff) + ldsw), 16, 0, 0); \
        __builtin_amdgcn_global_load_lds((const unsigned*)((const char*)(gbase) + (v1)), (LAS unsigned*)(lds + (bufoff) + ldsw + 8192), 16, 0, 0); } while (0)
#define PG8_LDA(dst, b, h) do { _Pragma("unroll") for (int m = 0; m < 4; ++m) _Pragma("unroll") for (int k = 0; k < 2; ++k) dst[m][k] = *(const LAS bf16x8*)(lds + PG8_SA(b, h) + aoff + m * 2048 + k * 1024); } while (0)
#define PG8_LDB(dst, b, h) do { _Pragma("unroll") for (int n = 0; n < 2; ++n) _Pragma("unroll") for (int k = 0; k < 2; ++k) dst[n][k] = *(const LAS bf16x8*)(lds + PG8_SB(b, h) + boff + n * 2048 + k * 1024); } while (0)
#define PG8_MMA(ai, bj, At, Bt) do { __builtin_amdgcn_s_setprio(1); _Pragma("unroll") for (int m = 0; m < 4; ++m) _Pragma("unroll") for (int n = 0; n < 2; ++n) _Pragma("unroll") for (int k = 0; k < 2; ++k) \
        acc[ai][bj][m][n] = __builtin_amdgcn_mfma_f32_16x16x32_bf16(Bt[n][k], At[m][k], acc[ai][bj][m][n], 0, 0, 0); __builtin_amdgcn_s_setprio(0); } while (0)
#define PG8_WAIT_V(n) asm volatile("s_waitcnt vmcnt(" #n ")" ::: "memory")
#define PG8_WAIT_L(n) asm volatile("s_waitcnt lgkmcnt(" #n ")" ::: "memory")
#define PG8_BAR __builtin_amdgcn_s_barrier()
#define PG8_SCHED __builtin_amdgcn_sched_barrier(0)
    Unit cur, nxt; int ui = 0;
    if (!S.next(0, cur)) return;
    f32x4 acc[2][2][4][2];
#pragma unroll
    for (int a = 0; a < 2; ++a)
#pragma unroll
        for (int b = 0; b < 2; ++b)
#pragma unroll
            for (int m = 0; m < 4; ++m)
#pragma unroll
                for (int n = 0; n < 2; ++n) acc[a][b][m][n] = (f32x4){0.f, 0.f, 0.f, 0.f};
    bf16x8 At[4][2], B0[2][2], B1[2][2];
    unsigned vA[2][2], vN[2][2];
    const char* cA; const char* cB = (const char*)g.Bt + (size_t)cur.pn * tstep;
    if constexpr (GATHER) {
        cA = (const char*)g.A;
#pragma unroll
        for (int h = 0; h < 2; ++h)
#pragma unroll
            for (int i = 0; i < 2; ++i) vA[h][i] = ((unsigned)__hip_atomic_load(g.rowidx + cur.pm * BM + h * HALF + sR[i], __ATOMIC_RELAXED, __HIP_MEMORY_SCOPE_AGENT) * (unsigned)K + (unsigned)sC[i]) * 2u;
    } else {
        cA = (const char*)g.A + (size_t)cur.pm * tstep;
#pragma unroll
        for (int h = 0; h < 2; ++h)
#pragma unroll
            for (int i = 0; i < 2; ++i) vA[h][i] = (unsigned)(sR[i] * K + sC[i]) * 2u + (unsigned)(h * hstep);
    }
    PG8_STAGEB(PG8_SB(0, 0), cB); PG8_STAGEB(PG8_SB(0, 1), cB + hstep); PG8_STAGEA(PG8_SA(0, 0), cA, vA[0][0], vA[0][1]); PG8_STAGEA(PG8_SA(0, 1), cA, vA[1][0], vA[1][1]);
    if (wr == 1) PG8_BAR;
    PG8_WAIT_V(2); PG8_BAR;
    PG8_STAGEB(PG8_SB(1, 0), cB + kstep); PG8_STAGEA(PG8_SA(1, 0), cA + kstep, vA[0][0], vA[0][1]); PG8_STAGEB(PG8_SB(1, 1), cB + hstep + kstep);
    PG8_WAIT_V(6); PG8_BAR;
    for (;;) {
        const bool has_next = S.next(ui + 1, nxt);
        const char* nA; const char* nB = has_next ? (const char*)g.Bt + (size_t)nxt.pn * tstep : cB;
        if constexpr (GATHER) {
            nA = cA;
            if (has_next) {
#pragma unroll
                for (int h = 0; h < 2; ++h)
#pragma unroll
                    for (int i = 0; i < 2; ++i) vN[h][i] = ((unsigned)__hip_atomic_load(g.rowidx + nxt.pm * BM + h * HALF + sR[i], __ATOMIC_RELAXED, __HIP_MEMORY_SCOPE_AGENT) * (unsigned)K + (unsigned)sC[i]) * 2u;
            } else {
#pragma unroll
                for (int h = 0; h < 2; ++h)
#pragma unroll
                    for (int i = 0; i < 2; ++i) vN[h][i] = vA[h][i];
            }
        } else {
            nA = has_next ? (const char*)g.A + (size_t)nxt.pm * tstep : cA;
#pragma unroll
            for (int h = 0; h < 2; ++h)
#pragma unroll
                for (int i = 0; i < 2; ++i) vN[h][i] = vA[h][i];
        }
#pragma unroll 1
        for (int t = 0; t < nt; t += 2) {
            const bool last = (t == nt - 2);
            const char* a1 = cA + (size_t)(t + 1) * kstep;
            const char* a2 = last ? nA : cA + (size_t)(t + 2) * kstep; const char* b2 = last ? nB : cB + (size_t)(t + 2) * kstep;
            const char* a3 = a2 + kstep; const char* b3 = b2 + kstep;
            const unsigned w00 = last ? vN[0][0] : vA[0][0], w01 = last ? vN[0][1] : vA[0][1], w10 = last ? vN[1][0] : vA[1][0], w11 = last ? vN[1][1] : vA[1][1];
            PG8_LDB(B0, 0, 0); PG8_LDB(B1, 0, 1); PG8_SCHED; PG8_LDA(At, 0, 0); PG8_STAGEA(PG8_SA(1, 1), a1, vA[1][0], vA[1][1]);
            PG8_WAIT_V(8); PG8_WAIT_L(0); PG8_BAR; PG8_MMA(0, 0, At, B0); PG8_MMA(0, 1, At, B1); PG8_BAR; PG8_SCHED;
            PG8_LDA(At, 0, 1); PG8_STAGEB(PG8_SB(0, 0), b2); PG8_STAGEB(PG8_SB(0, 1), b2 + hstep); PG8_STAGEA(PG8_SA(0, 0), a2, w00, w01);
            PG8_WAIT_V(8); PG8_WAIT_L(0); PG8_BAR; PG8_MMA(1, 0, At, B0); PG8_MMA(1, 1, At, B1); PG8_BAR; PG8_SCHED;
            PG8_LDB(B0, 1, 0); PG8_LDB(B1, 1, 1); PG8_SCHED; PG8_LDA(At, 1, 0); PG8_STAGEA(PG8_SA(0, 1), a2, w10, w11);
            PG8_WAIT_V(8); PG8_WAIT_L(0); PG8_BAR; PG8_MMA(0, 0, At, B0); PG8_MMA(0, 1, At, B1); PG8_BAR; PG8_SCHED;
            PG8_LDA(At, 1, 1); PG8_STAGEB(PG8_SB(1, 0), b3); PG8_STAGEB(PG8_SB(1, 1), b3 + hstep); PG8_STAGEA(PG8_SA(1, 0), a3, w00, w01);
            PG8_WAIT_V(8); PG8_WAIT_L(0); PG8_BAR; PG8_MMA(1, 0, At, B0); PG8_MMA(1, 1, At, B1); PG8_BAR; PG8_SCHED;
        }
        if (wr == 0) PG8_BAR;
        E(acc, cur, wr, wc, fr, fq);
        if (!has_next) break;
#pragma unroll
        for (int a = 0; a < 2; ++a)
#pragma unroll
            for (int b = 0; b < 2; ++b)
#pragma unroll
                for (int m = 0; m < 4; ++m)
#pragma unroll
                    for (int n = 0; n < 2; ++n) acc[a][b][m][n] = (f32x4){0.f, 0.f, 0.f, 0.f};
        cur = nxt; cA = nA; cB = nB; ++ui;
#pragma unroll
        for (int h = 0; h < 2; ++h)
#pragma unroll
            for (int i = 0; i < 2; ++i) vA[h][i] = vN[h][i];
        if (wr == 1) PG8_BAR;
    }
    PG8_WAIT_V(0);
    PG8_BAR;
#undef PG8_SA
#undef PG8_SB
#undef PG8_STAGEA
#undef PG8_STAGEB
#undef PG8_LDA
#undef PG8_LDB
#undef PG8_MMA
#undef PG8_WAIT_V
#undef PG8_WAIT_L
#undef PG8_BAR
#undef PG8_SCHED
}
}
namespace epi {
using pg8::Unit;
__device__ __forceinline__ u32x4 pack8(const f32x4 v0, const f32x4 v1) { u32x4 w; w.x = cvt_pk_bf16(v0[0], v0[1]); w.y = cvt_pk_bf16(v0[2], v0[3]); w.z = cvt_pk_bf16(v1[0], v1[1]); w.w = cvt_pk_bf16(v1[2], v1[3]); return w; }

struct InProj {
    bf16_t* Q; bf16_t* Kall; bf16_t* Vall; bf16_t* UT; bf16_t* G;
    __device__ __forceinline__ void operator()(const f32x4 (&acc)[2][2][4][2], const Unit& u, int wr, int wc, int fr, int fq) const {
        const int pn = u.pn; const int row0 = u.pm * 256 + wr * 64 + fr; const int cw = wc * 32 + 8 * fq;
        if (pn < 12 && !(pn >= 4 && pn < 8)) {
            const bool isq = pn >= 8; const int colt = (isq ? pn - 8 : pn) * 256;
            float inv[4];
#pragma unroll
            for (int j = 0; j < 4; ++j) inv[j] = exp2f(-(float)(4 * fq + j) * 0.8304820237218406f);
            const int axis = wc & 1;
#pragma unroll
            for (int ai = 0; ai < 2; ++ai)
#pragma unroll
                for (int m = 0; m < 4; ++m) {
                    const int row = row0 + ai * 128 + m * 16;
                    bf16_t* dst; bool rope;
                    if (row < NTOK) { const int b = row >> 12, t = row & 4095; rope = true;
                        dst = isq ? Q + (size_t)row * DM : Kall + ((size_t)b * LKV + t) * DM; }
                    else { const int rc = row - NTOK, b = rc >> 8, j = rc & 255; rope = false; dst = Kall + ((size_t)b * LKV + SEQ + j) * DM; }
                    const int t = row & 4095; const float pos = (float)(axis ? (t & 63) : (t >> 6));
#pragma unroll
                    for (int bj = 0; bj < 2; ++bj) {
                        f32x4 x1 = acc[ai][bj][m][0], x2 = acc[ai][bj][m][1], o1, o2;
                        if (rope) {
#pragma unroll
                            for (int j = 0; j < 4; ++j) { const float a = pos * inv[j]; const float c = __cosf(a), s = __sinf(a); o1[j] = x1[j] * c - x2[j] * s; o2[j] = x2[j] * c + x1[j] * s; }
                        } else { o1 = x1; o2 = x2; }
                        *(u32x4*)(dst + colt + bj * 128 + cw) = pack8(o1, o2);
                    }
                }
        } else if (pn < 8) {
            const int colt = (pn - 4) * 256;
#pragma unroll
            for (int ai = 0; ai < 2; ++ai)
#pragma unroll
                for (int m = 0; m < 4; ++m) {
                    const int row = row0 + ai * 128 + m * 16; bf16_t* dst;
                    if (row < NTOK) { const int b = row >> 12, t = row & 4095; dst = Vall + ((size_t)b * LKV + t) * DM; }
                    else { const int rc = row - NTOK, b = rc >> 8, j = rc & 255; dst = Vall + ((size_t)b * LKV + SEQ + j) * DM; }
#pragma unroll
                    for (int bj = 0; bj < 2; ++bj) *(u32x4*)(dst + colt + bj * 128 + cw) = pack8(acc[ai][bj][m][0], acc[ai][bj][m][1]);
                }
        } else if (pn < 24) {
            const int ch0 = (pn - 12) * 256 + cw;
#pragma unroll
            for (int ai = 0; ai < 2; ++ai)
#pragma unroll
                for (int m = 0; m < 4; ++m) {
                    const int row = row0 + ai * 128 + m * 16; const int b = row >> 12, t = row & 4095;
                    bf16_t* dst = UT + ((size_t)b * 3072 + ch0) * SEQ + t;
#pragma unroll
                    for (int bj = 0; bj < 2; ++bj)
#pragma unroll
                        for (int n = 0; n < 2; ++n)
#pragma unroll
                            for (int j = 0; j < 4; ++j) dst[(size_t)(bj * 128 + n * 4 + j) * SEQ] = (bf16_t)(cvt_pk_bf16(acc[ai][bj][m][n][j], 0.f) & 0xffffu);
                }
        } else {
            const int colt = (pn - 24) * 256;
#pragma unroll
            for (int ai = 0; ai < 2; ++ai)
#pragma unroll
                for (int m = 0; m < 4; ++m) {
                    const int row = row0 + ai * 128 + m * 16; bf16_t* dst = G + (size_t)row * 2048 + colt + cw;
#pragma unroll
                    for (int bj = 0; bj < 2; ++bj) { f32x4 a = acc[ai][bj][m][0], c = acc[ai][bj][m][1];
#pragma unroll
                        for (int j = 0; j < 4; ++j) { a[j] = sigmoidf_(a[j]); c[j] = sigmoidf_(c[j]); }
                        *(u32x4*)(dst + bj * 128) = pack8(a, c); }
                }
        }
    }
};

template <int MODE> struct Merge {
    const bf16_t* G; bf16_t* T1;
    __device__ __forceinline__ void operator()(const f32x4 (&acc)[2][2][4][2], const Unit& u, int wr, int wc, int fr, int fq) const {
        const int row0 = u.pm * 256 + wr * 64 + fr; const int col0 = u.pn * 256 + wc * 32 + 8 * fq;
#pragma unroll
        for (int ai = 0; ai < 2; ++ai)
#pragma unroll
            for (int m = 0; m < 4; ++m) {
                const int row = row0 + ai * 128 + m * 16;
#pragma unroll
                for (int bj = 0; bj < 2; ++bj) {
                    const int col = col0 + bj * 128;
                    const u32x4 gw = *(const u32x4*)(G + (size_t)row * 2048 + MODE * 1024 + col);
                    f32x4 a = acc[ai][bj][m][0], c = acc[ai][bj][m][1];
                    a[0] *= bflo(gw.x); a[1] *= bfhi(gw.x); a[2] *= bflo(gw.y); a[3] *= bfhi(gw.y);
                    c[0] *= bflo(gw.z); c[1] *= bfhi(gw.z); c[2] *= bflo(gw.w); c[3] *= bfhi(gw.w);
                    bf16_t* tp = T1 + (size_t)row * DM + col;
                    if (MODE == 1) { const u32x4 tw = *(const u32x4*)tp;
                        a[0] += bflo(tw.x); a[1] += bfhi(tw.x); a[2] += bflo(tw.y); a[3] += bfhi(tw.y);
                        c[0] += bflo(tw.z); c[1] += bfhi(tw.z); c[2] += bflo(tw.w); c[3] += bfhi(tw.w); }
                    *(u32x4*)tp = pack8(a, c);
                }
            }
    }
};

struct OutProj {
    const float* x; const float* mod; float* xnew;
    __device__ __forceinline__ void operator()(const f32x4 (&acc)[2][2][4][2], const Unit& u, int wr, int wc, int fr, int fq) const {
        const int row0 = u.pm * 256 + wr * 64 + fr; const int col0 = u.pn * 256 + wc * 32 + 8 * fq;
#pragma unroll
        for (int ai = 0; ai < 2; ++ai)
#pragma unroll
            for (int m = 0; m < 4; ++m) {
                const int row = row0 + ai * 128 + m * 16; const int b = row >> 12;
#pragma unroll
                for (int bj = 0; bj < 2; ++bj) {
                    const int col = col0 + bj * 128; const size_t off = (size_t)row * DM + col;
                    const float* gp = mod + b * 6144 + 2048 + col;
#pragma unroll
                    for (int n = 0; n < 2; ++n) { const f32x4 xv = *(const f32x4*)(x + off + 4 * n), gv = *(const f32x4*)(gp + 4 * n);
                        *(f32x4*)(xnew + off + 4 * n) = xv + gv * acc[ai][bj][m][n]; }
                }
            }
    }
};

struct SwiGLU {
    bf16_t* H;
    __device__ __forceinline__ void operator()(const f32x4 (&acc)[2][2][4][2], const Unit& u, int wr, int wc, int fr, int fq) const {
        const int row0 = u.pm * 256 + wr * 64 + fr; const int j = u.pn & 1;
#pragma unroll
        for (int ai = 0; ai < 2; ++ai)
#pragma unroll
            for (int m = 0; m < 4; ++m) {
                const int row = row0 + ai * 128 + m * 16;
#pragma unroll
                for (int bj = 0; bj < 2; ++bj) {
                    const int gi = 16 * bj + 4 * wc + fq;
                    const f32x4 g = acc[ai][bj][m][0], up = acc[ai][bj][m][1]; f32x4 h;
#pragma unroll
                    for (int q = 0; q < 4; ++q) h[q] = g[q] * sigmoidf_(g[q]) * up[q];
                    u32x2 w; w.x = cvt_pk_bf16(h[0], h[1]); w.y = cvt_pk_bf16(h[2], h[3]);
                    *(u32x2*)(H + (size_t)row * EH + 128 * j + 4 * gi) = w;
                }
            }
    }
};

struct Down {
    bf16_t* Y;
    __device__ __forceinline__ void operator()(const f32x4 (&acc)[2][2][4][2], const Unit& u, int wr, int wc, int fr, int fq) const {
        const int row0 = u.pm * 256 + wr * 64 + fr; const int col0 = wc * 32 + 8 * fq;
#pragma unroll
        for (int ai = 0; ai < 2; ++ai)
#pragma unroll
            for (int m = 0; m < 4; ++m) {
                const int row = row0 + ai * 128 + m * 16;
#pragma unroll
                for (int bj = 0; bj < 2; ++bj) *(u32x4*)(Y + (size_t)row * 256 + col0 + bj * 128) = pack8(acc[ai][bj][m][0], acc[ai][bj][m][1]);
            }
    }
};
}
struct Ctx { int tid, lane, wave, G, bid; unsigned char* ws; };

__device__ __forceinline__ void adaln_phase(const Params& p, const Ctx& C, char* lds) {
    float* s = (float*)lds;
    float* red = (float*)(lds + 9 * 1024 * 4);
    const float* c = p.in[I_C]; const float* cc = p.in[I_CCTX]; const float* W = p.in[I_ADAW]; const float* bias = p.in[I_ADAB];
    float* mod = (float*)(C.ws + WS_MOD); float* cmod = (float*)(C.ws + WS_CMOD);
    if (C.bid < 192) {
        for (int i = C.tid; i < 9 * 1024; i += 512) { const int b = i >> 10, k = i & 1023; const float v = b < 8 ? c[b * 1024 + k] : cc[k]; s[i] = v / (1.f + expf(-v)); }
        __syncthreads();
    }
    for (int item = C.bid; item < 192; item += C.G) {
        const int cl = C.tid & 31, kg = C.tid >> 5, col = item * 32 + cl;
        float acc[9];
#pragma unroll
        for (int b = 0; b < 9; ++b) acc[b] = 0.f;
        for (int k = kg; k < 1024; k += 16) { const float w = W[(size_t)k * 6144 + col];
#pragma unroll
            for (int b = 0; b < 9; ++b) acc[b] += s[b * 1024 + k] * w; }
#pragma unroll
        for (int b = 0; b < 9; ++b) red[(kg * 9 + b) * 32 + cl] = acc[b];
        __syncthreads();
        if (C.tid < 9 * 32) { const int b = C.tid >> 5, c2 = C.tid & 31, col2 = item * 32 + c2; float v = 0.f;
            for (int q = 0; q < 16; ++q) v += red[(q * 9 + b) * 32 + c2];
            v += bias[col2];
            if (b < 8) mod[b * 6144 + col2] = v; else if (col2 < 2048) cmod[col2] = v; }
        __syncthreads();
    }
    if (C.bid == (C.G > 200 ? 200 : 0) && C.tid < 64) {
        const float a = wave_sum(p.in[I_LQ1][C.tid] * p.in[I_LK1][C.tid]), b = wave_sum(p.in[I_LQ2][C.tid] * p.in[I_LK2][C.tid]);
        if (C.tid == 0) *(float*)(C.ws + WS_LAM) = expf(a) - expf(b) + 0.2f;
    }
}

__device__ __forceinline__ void hdn_phase(const Params& p, const Ctx& C) {
    const float* w1 = p.in[I_FW1]; const float* b1 = p.in[I_FB1]; const float* fr = p.in[I_FFR]; const float* w2 = p.in[I_FW2]; const float* b2 = p.in[I_FB2];
    float* hdn = (float*)(C.ws + WS_HDN);
    const int gw = C.bid * 8 + C.wave, NGW = C.G * 8, l = C.lane;
    for (int t = gw; t < SEQ; t += NGW) {
        float z = 0.f;
        if (l == 0) z = (float)((double)t / 4095.0);
        else if (l < 33) { const int bi = (l - 1) & 15; const double band = 1e-4 + (double)bi * ((15.0 - 1e-4) / 15.0); const double w = 6.283185307179586476925 * (double)t / 4096.0; const double a = band * w;
            z = (l < 17) ? (float)cos(a) : (float)(-sin(a)); }
        float h = b1[l];
        for (int i = 0; i < 33; ++i) h += __shfl(z, i) * w1[i * 64 + l];
        h = sinf(fr[l] * h);
        float h2 = b2[l];
        for (int i = 0; i < 64; ++i) h2 += __shfl(h, i) * w2[i * 64 + l];
        h2 = sinf(fr[l] * h2);
        hdn[t * 64 + l] = h2;
    }
}

__device__ __forceinline__ void transpose_item(const float* srcl, int ldw, bf16_t* dst, int K, float* scr, int lane) {
#pragma unroll 8
    for (int i = 0; i < 32; ++i) { const int kk = 2 * i + (lane >> 5); scr[kk * 33 + (lane & 31)] = srcl[(size_t)kk * ldw]; }
    asm volatile("s_waitcnt lgkmcnt(0)" ::: "memory");
    const int c = lane & 7;
#pragma unroll
    for (int j = 0; j < 4; ++j) { const int n = (lane >> 3) + 8 * j; const float* s = scr + (8 * c) * 33 + n;
        u32x4 o; o.x = cvt_pk_bf16(s[0 * 33], s[1 * 33]); o.y = cvt_pk_bf16(s[2 * 33], s[3 * 33]); o.z = cvt_pk_bf16(s[4 * 33], s[5 * 33]); o.w = cvt_pk_bf16(s[6 * 33], s[7 * 33]);
        *(u32x4*)(dst + (size_t)n * K + 8 * c) = o; }
    asm volatile("s_waitcnt lgkmcnt(0)" ::: "memory");
}
__device__ __forceinline__ int qk_src_col(int n) {
    const int blk = n & ~63, pp = n & 63, axis = pp >> 5, f = ((pp & 31) >> 3) * 4 + (pp & 3), half = (pp >> 2) & 1;
    return blk + axis * 32 + half * 16 + f;
}
__device__ __forceinline__ void wconv_mixer_phase(const Params& p, const Ctx& C, char* lds) {
    float* scr = (float*)(lds + C.wave * 16384);
    const int gw = C.bid * 8 + C.wave, NGW = C.G * 8, l31 = C.lane & 31;
    constexpr int I_IN = 16 * 256, I_SQ = 16 * 32, NIT = I_IN + 3 * I_SQ;
    for (int it = gw; it < NIT; it += NGW) {
        int r = it;
        if (r < I_IN) { const int kb = r / 256, nb = r % 256, k0 = 64 * kb, n0 = 32 * nb; const int n = n0 + l31;
            const int src = (n < 1024 || (n >= 2048 && n < 3072)) ? qk_src_col(n) : n;
            transpose_item(p.in[I_WIN] + (size_t)k0 * INW + src, INW, (bf16_t*)(C.ws + WS_WIN) + (size_t)n0 * 1024 + k0, 1024, scr, C.lane); continue; }
        r -= I_IN; const int which = r / I_SQ; r %= I_SQ;
        const float* W = which == 0 ? p.in[I_WPA] : which == 1 ? p.in[I_WPH] : p.in[I_WOUT];
        bf16_t* WT = (bf16_t*)(C.ws + (which == 0 ? WS_WPA : which == 1 ? WS_WPH : WS_WOUT));
        const int kb = r / 32, nb = r % 32, k0 = 64 * kb, n0 = 32 * nb;
        transpose_item(W + (size_t)k0 * 1024 + n0 + l31, 1024, WT + (size_t)n0 * 1024 + k0, 1024, scr, C.lane);
    }
}
__device__ __forceinline__ void wconv_moe_phase(const Params& p, const Ctx& C, char* lds) {
    float* scr = (float*)(lds + C.wave * 16384);
    const int gw = C.bid * 8 + C.wave, NGW = C.G * 8, l31 = C.lane & 31;
    constexpr int I_GU = 16 * 16, I_D = 4 * 32, NIT = 65 * (I_GU + I_D);
    for (int it = gw; it < NIT; it += NGW) {
        const int e = it / (I_GU + I_D); int r = it % (I_GU + I_D);
        if (r < I_GU) { const int kb = r / 16, nb = r % 16, k0 = 64 * kb, n0 = 32 * nb; const int n = n0 + l31;
            const int j = n >> 8, gi = (n & 255) >> 3, e8 = n & 7, i = 128 * j + 4 * gi + (e8 & 3);
            const float* mat = (e8 >> 2) ? (e < 64 ? p.in[I_EU] + (size_t)e * 1024 * 256 : p.in[I_SU]) : (e < 64 ? p.in[I_EG] + (size_t)e * 1024 * 256 : p.in[I_SG]);
            transpose_item(mat + (size_t)k0 * 256 + i, 256, (bf16_t*)(C.ws + WS_WGU) + ((size_t)e * 512 + n0) * 1024 + k0, 1024, scr, C.lane); continue; }
        r -= I_GU; const int kb = r / 32, nb = r % 32, k0 = 64 * kb, n0 = 32 * nb;
        const float* mat = e < 64 ? p.in[I_ED] + (size_t)e * 256 * 1024 : p.in[I_SD];
        transpose_item(mat + (size_t)k0 * 1024 + n0 + l31, 1024, (bf16_t*)(C.ws + WS_WD) + ((size_t)e * 1024 + n0) * 256 + k0, 256, scr, C.lane);
    }
}

__device__ __forceinline__ void hx_phase(const Params& p, const Ctx& C) {
    const float* mod = (const float*)(C.ws + WS_MOD); const float* cmod = (const float*)(C.ws + WS_CMOD); const float* g = p.in[I_N1G];
    bf16_t* HX = (bf16_t*)(C.ws + WS_HX);
    const int gw = C.bid * 8 + C.wave, NGW = C.G * 8;
    for (int r = gw; r < MROWS; r += NGW) {
        const float* xr; const float* sh; const float* sc;
        if (r < NTOK) { xr = p.in[I_X] + (size_t)r * DM; const int b = r >> 12; sh = mod + b * 6144; sc = sh + 1024; }
        else { xr = p.in[I_CTX] + (size_t)(r - NTOK) * DM; sh = cmod; sc = cmod + 1024; }
        f32x4 v[4]; float ss = 0.f;
#pragma unroll
        for (int j = 0; j < 4; ++j) { v[j] = *(const f32x4*)(xr + 256 * j + 4 * C.lane); ss += (v[j].x * v[j].x + v[j].y * v[j].y) + (v[j].z * v[j].z + v[j].w * v[j].w); }
        const float rn = 1.0f / sqrtf(wave_sum(ss) * (1.f / DM) + NORM_EPS);
#pragma unroll
        for (int j = 0; j < 4; ++j) { const int k = 256 * j + 4 * C.lane;
            const f32x4 gv = *(const f32x4*)(g + k), scv = *(const f32x4*)(sc + k), shv = *(const f32x4*)(sh + k);
            const f32x4 o = v[j] * rn * gv * (1.f + scv) + shv;
            u32x2 w; w.x = cvt_pk_bf16(o.x, o.y); w.y = cvt_pk_bf16(o.z, o.w);
            *(u32x2*)(HX + (size_t)r * DM + k) = w; }
    }
}
namespace att {
constexpr int KVBLK = 64, NT = LKV / KVBLK;
constexpr float SCALE = 0.125f, THR = 8.f;
constexpr int SHM_V = KVBLK * 128 * 2, SHM_K = KVBLK * 128 * 2;
#define KSWZ(row, colB) ((row) * 256 + ((colB) ^ (((row) & 7) << 4)))
#define SBAR() __builtin_amdgcn_sched_barrier(0)
__device__ __forceinline__ int crow(int r, int hi) { return (r & 3) + 8 * (r >> 2) + 4 * hi; }
__device__ __forceinline__ void partialSM(f32x16& p0, f32x16& p1, float& m_reg, float& mn, float& alpha) {
  constexpr float C = SCALE * 1.4426950408889634f;
  float pmax = p0[0];
#pragma unroll
  for (int r = 1; r < 16; ++r) pmax = fmaxf(pmax, p0[r]);
#pragma unroll
  for (int r = 0; r < 16; ++r) pmax = fmaxf(pmax, p1[r]);
  { auto rr = __builtin_amdgcn_permlane32_swap(__float_as_uint(pmax), __float_as_uint(pmax), false, false);
    pmax = fmaxf(__uint_as_float(rr[0]), __uint_as_float(rr[1])); }
  if (__builtin_expect(__all(pmax - m_reg <= THR / SCALE), 1)) { mn = m_reg; alpha = 1.f; }
  else { mn = fmaxf(m_reg, pmax); alpha = __builtin_amdgcn_exp2f((m_reg - mn) * C); m_reg = mn; }
  float mnC = -mn * C;
#pragma unroll
  for (int r = 0; r < 16; ++r) p0[r] = fmaf(p0[r], C, mnC);
#pragma unroll
  for (int r = 0; r < 16; ++r) p1[r] = fmaf(p1[r], C, mnC);
#pragma unroll
  for (int r = 0; r < 16; ++r) p0[r] = __builtin_amdgcn_exp2f(p0[r]);
}
__device__ __forceinline__ void finishSM(f32x16& p0, f32x16& p1, float alpha, float& l_reg, bf16x8& pa0, bf16x8& pa1, bf16x8& pa2, bf16x8& pa3) {
#pragma unroll
  for (int r = 0; r < 16; ++r) p1[r] = __builtin_amdgcn_exp2f(p1[r]);
  float ps = 0;
#pragma unroll
  for (int r = 0; r < 16; ++r) ps += p0[r];
#pragma unroll
  for (int r = 0; r < 16; ++r) ps += p1[r];
  { auto rr = __builtin_amdgcn_permlane32_swap(__float_as_uint(ps), __float_as_uint(ps), false, false);
    ps = __uint_as_float(rr[0]) + __uint_as_float(rr[1]); }
  l_reg = l_reg * alpha + ps;
#define PK4(P, BASE, OUT) do { unsigned a0 = cvt_pk_bf16(P[BASE + 0], P[BASE + 1]), a1 = cvt_pk_bf16(P[BASE + 2], P[BASE + 3]);   \
    unsigned b0 = cvt_pk_bf16(P[BASE + 4], P[BASE + 5]), b1 = cvt_pk_bf16(P[BASE + 6], P[BASE + 7]);                              \
    auto r0 = __builtin_amdgcn_permlane32_swap(a0, b0, false, false); auto r1 = __builtin_amdgcn_permlane32_swap(a1, b1, false, false); \
    u32x4 w = {r0[0], r1[0], r0[1], r1[1]}; OUT = *reinterpret_cast<bf16x8*>(&w); } while (0)
  PK4(p0, 0, pa0); PK4(p0, 8, pa1); PK4(p1, 0, pa2); PK4(p1, 8, pa3);
#undef PK4
}
__device__ __forceinline__ void qkt(f32x16& p0, f32x16& p1, const char* Ks, const bf16x8* qr, int r32, int hi, int mp) {
  p0 = f32x16{}; p1 = f32x16{};
#pragma unroll
  for (int d0 = 0; d0 < 4; ++d0) { const int cb = ((mp * 4 + d0) * 16 + hi * 8) * 2;
    const bf16x8 b0 = *reinterpret_cast<const bf16x8*>(Ks + KSWZ(r32, cb));
    const bf16x8 b1 = *reinterpret_cast<const bf16x8*>(Ks + KSWZ(32 + r32, cb));
    p0 = __builtin_amdgcn_mfma_f32_32x32x16_bf16(b0, qr[d0], p0, 0, 0, 0);
    p1 = __builtin_amdgcn_mfma_f32_32x32x16_bf16(b1, qr[d0], p1, 0, 0, 0); }
}
__device__ __forceinline__ int v_st(int k, int c) { const int kk = (k & ~0xC) | ((k & 4) << 1) | ((k & 8) >> 1); return ((kk >> 3) * 4 + (c >> 5)) * 512 + ((kk & 7) * 32 + (c & 31)) * 2; }
__device__ __forceinline__ int v_rd_base(int lane) { return ((lane & 3) << 3) | (((lane >> 2) & 3) << 6) | (((lane >> 4) & 1) << 5) | (((lane >> 5) & 1) << 8); }
constexpr int v_rd_off(int d0, int ks, int half) { return d0 * 512 + ks * 4096 + half * 2048; }
template <int OFF> __device__ __forceinline__ s16x4 tr_read(int vb) {
  s16x4 r; asm volatile("ds_read_b64_tr_b16 %0, %1 offset:%2" : "=&v"(r) : "v"(vb), "i"(OFF) : "memory"); return r;
}
template <int D0> __device__ __forceinline__ void pv_one(f32x16& od, int vb, bf16x8 pa0, bf16x8 pa1, bf16x8 pa2, bf16x8 pa3) {
  const s16x4 l0 = tr_read<v_rd_off(D0, 0, 0)>(vb), h0 = tr_read<v_rd_off(D0, 0, 1)>(vb), l1 = tr_read<v_rd_off(D0, 1, 0)>(vb), h1 = tr_read<v_rd_off(D0, 1, 1)>(vb);
  const s16x4 l2 = tr_read<v_rd_off(D0, 2, 0)>(vb), h2 = tr_read<v_rd_off(D0, 2, 1)>(vb), l3 = tr_read<v_rd_off(D0, 3, 0)>(vb), h3 = tr_read<v_rd_off(D0, 3, 1)>(vb);
  asm volatile("s_waitcnt lgkmcnt(0)" ::: "memory"); SBAR();
#define PK(L, H) (bf16x8){L[0], L[1], L[2], L[3], H[0], H[1], H[2], H[3]}
  od = __builtin_amdgcn_mfma_f32_32x32x16_bf16(pa0, PK(l0, h0), od, 0, 0, 0);
  od = __builtin_amdgcn_mfma_f32_32x32x16_bf16(pa1, PK(l1, h1), od, 0, 0, 0);
  od = __builtin_amdgcn_mfma_f32_32x32x16_bf16(pa2, PK(l2, h2), od, 0, 0, 0);
  od = __builtin_amdgcn_mfma_f32_32x32x16_bf16(pa3, PK(l3, h3), od, 0, 0, 0);
#undef PK
}
__device__ __forceinline__ void pv_d0(f32x16* o, int vb, bf16x8 pa0, bf16x8 pa1, bf16x8 pa2, bf16x8 pa3) {
  pv_one<0>(o[0], vb, pa0, pa1, pa2, pa3); pv_one<1>(o[1], vb, pa0, pa1, pa2, pa3); pv_one<2>(o[2], vb, pa0, pa1, pa2, pa3); pv_one<3>(o[3], vb, pa0, pa1, pa2, pa3);
}

__device__ __forceinline__ void attn_unit(const bf16_t* Qg, const bf16_t* Kall, const bf16_t* Vall, bf16_t* AX, float lam, const float* subg, int b, int h, int qb, char* lds) {
  constexpr int LDK = DM;
  int tid_ = threadIdx.x; asm volatile("" : "+v"(tid_));
  const int tid = tid_, wid = tid >> 6, lane = tid & 63, r32 = lane & 31, hi = lane >> 5, rg = wid & 3, mp = wid >> 2;
  char* V_lds = lds; char* K_lds = lds + 2 * SHM_V;
  float* wsf = (float*)(lds + 2 * SHM_V + 2 * SHM_K) + wid * 64; float* li_l = wsf; float* al_l = wsf + 32;
  const bf16_t* Kh = Kall + (size_t)b * LKV * DM + h * 128; const bf16_t* Vh = Vall + (size_t)b * LKV * DM + h * 128;
  float m_reg = -1e30f, l_reg = 0; f32x16 o[4] = {}; bf16x8 qr[4];
  const bf16_t* Qw = Qg + ((size_t)(b * SEQ + qb * 128 + rg * 32 + r32)) * DM + h * 128 + mp * 64 + hi * 8;
#pragma unroll
  for (int d0 = 0; d0 < 4; ++d0) qr[d0] = *reinterpret_cast<const bf16x8*>(Qw + d0 * 16);
  const int sr = tid >> 4, sc = (tid & 15) * 8, vst0 = v_st(sr, sc), vst1 = v_st(32 + sr, sc);
  const int vb0 = (int)(uintptr_t)V_lds + v_rd_base(lane);
  struct { bf16x8 vs0, vs1, ks0, ks1; } sr_[2];
#define SLOAD(i, k0) do { sr_[i].vs0 = *(const bf16x8*)(&Vh[(size_t)((k0) + sr) * LDK + sc]); sr_[i].vs1 = *(const bf16x8*)(&Vh[(size_t)((k0) + 32 + sr) * LDK + sc]); \
    sr_[i].ks0 = *(const bf16x8*)(&Kh[(size_t)((k0) + sr) * LDK + sc]); sr_[i].ks1 = *(const bf16x8*)(&Kh[(size_t)((k0) + 32 + sr) * LDK + sc]); } while (0)
#define SWRITE(bb, i) do { *(bf16x8*)(V_lds + (bb) * SHM_V + vst0) = sr_[i].vs0;          \
    *(bf16x8*)(V_lds + (bb) * SHM_V + vst1) = sr_[i].vs1; int kc = sc * 2;               \
    *(bf16x8*)(K_lds + (bb) * SHM_K + KSWZ(sr, kc)) = sr_[i].ks0;                       \
    *(bf16x8*)(K_lds + (bb) * SHM_K + KSWZ(32 + sr, kc)) = sr_[i].ks1; } while (0)
#define SWAIT() asm volatile("s_waitcnt vmcnt(4)" ::: "memory")
#define RESC(a) do { if (__any((a) < 1.f)) { if (hi == 0) al_l[r32] = (a); asm volatile("s_waitcnt lgkmcnt(0)" ::: "memory"); \
    _Pragma("unroll") for (int d = 0; d < 4; ++d) _Pragma("unroll") for (int r = 0; r < 16; ++r) o[d][r] *= al_l[crow(r, hi)]; } } while (0)
  f32x16 pA0, pA1, pB0, pB1; float mnA, mnB, alA, alB; bf16x8 pa0, pa1, pa2, pa3;
  constexpr int SE = 0, SO = 1;
  SLOAD(SE, 0); asm volatile("s_waitcnt vmcnt(0)" ::: "memory"); SWRITE(0, SE); __syncthreads();
  qkt(pA0, pA1, K_lds, qr, r32, hi, mp); partialSM(pA0, pA1, m_reg, mnA, alA);
  SLOAD(SO, KVBLK); SLOAD(SE, 2 * KVBLK);
  SWAIT(); SWRITE(1, SO); __syncthreads();
  for (int j = 1; j + 1 < NT; j += 2) {
    SBAR(); qkt(pB0, pB1, K_lds + SHM_K, qr, r32, hi, mp);
    finishSM(pA0, pA1, alA, l_reg, pa0, pa1, pa2, pa3); SBAR();
    SLOAD(SO, (j + 2) * KVBLK); SBAR();
    pv_d0(o, vb0, pa0, pa1, pa2, pa3); partialSM(pB0, pB1, m_reg, mnB, alB);
    __syncthreads(); SWAIT(); SWRITE(0, SE);
    RESC(alB); __syncthreads();
    SBAR(); qkt(pA0, pA1, K_lds, qr, r32, hi, mp);
    finishSM(pB0, pB1, alB, l_reg, pa0, pa1, pa2, pa3); SBAR();
    if (j + 3 < NT) SLOAD(SE, (j + 3) * KVBLK); SBAR();
    pv_d0(o, vb0 + SHM_V, pa0, pa1, pa2, pa3); partialSM(pA0, pA1, m_reg, mnA, alA);
    __syncthreads(); SWAIT(); SWRITE(1, SO);
    RESC(alA); __syncthreads();
  }
  SBAR(); qkt(pB0, pB1, K_lds + SHM_K, qr, r32, hi, mp);
  finishSM(pA0, pA1, alA, l_reg, pa0, pa1, pa2, pa3); SBAR();
  pv_d0(o, vb0, pa0, pa1, pa2, pa3); partialSM(pB0, pB1, m_reg, mnB, alB);
  __syncthreads(); RESC(alB);
  finishSM(pB0, pB1, alB, l_reg, pa0, pa1, pa2, pa3); SBAR();
  pv_d0(o, vb0 + SHM_V, pa0, pa1, pa2, pa3);
  if (hi == 0) li_l[r32] = l_reg; asm volatile("s_waitcnt lgkmcnt(0)" ::: "memory");
  float rli[16];
#pragma unroll
  for (int r = 0; r < 16; ++r) rli[r] = __builtin_amdgcn_rcpf(li_l[crow(r, hi)]);
  __syncthreads();
  { float* Ob = (float*)lds + (size_t)(mp * 128 + rg * 32) * 132;
#pragma unroll
    for (int r = 0; r < 16; ++r) { const int orow = crow(r, hi);
#pragma unroll
      for (int d0 = 0; d0 < 4; ++d0) Ob[orow * 132 + d0 * 32 + r32] = o[d0][r] * rli[r]; } }
  __syncthreads();
  { const int row = tid >> 2, q4 = tid & 3;
    const float* o0 = (const float*)lds + (size_t)row * 132 + q4 * 32; const float* o1 = o0 + 128 * 132;
    float d[32]; float ss = 0.f;
#pragma unroll
    for (int i = 0; i < 32; i += 4) { const f32x4 a = *(const f32x4*)(o0 + i), c = *(const f32x4*)(o1 + i);
#pragma unroll
      for (int q = 0; q < 4; ++q) { d[i + q] = a[q] - lam * c[q]; ss += d[i + q] * d[i + q]; } }
    ss += __shfl_xor(ss, 1); ss += __shfl_xor(ss, 2);
    const float rn = 0.8f / sqrtf(ss * (1.f / 128.f) + NORM_EPS);
    bf16_t* op = AX + ((size_t)(b * SEQ + qb * 128 + row)) * DM + h * 128 + q4 * 32; const float* gp = subg + q4 * 32;
#pragma unroll
    for (int i = 0; i < 32; i += 8) { u32x4 w;
      w.x = cvt_pk_bf16(d[i] * rn * gp[i], d[i + 1] * rn * gp[i + 1]); w.y = cvt_pk_bf16(d[i + 2] * rn * gp[i + 2], d[i + 3] * rn * gp[i + 3]);
      w.z = cvt_pk_bf16(d[i + 4] * rn * gp[i + 4], d[i + 5] * rn * gp[i + 5]); w.w = cvt_pk_bf16(d[i + 6] * rn * gp[i + 6], d[i + 7] * rn * gp[i + 7]);
      *(u32x4*)(op + i) = w; } }
  __syncthreads();
#undef SLOAD
#undef SWRITE
#undef SWAIT
#undef RESC
}
__device__ __forceinline__ void attn_phase(const Ctx& C, const float* subg, bf16_t* AXo, char* lds) {
  const bf16_t* Qg = (const bf16_t*)(C.ws + WS_Q); const bf16_t* Kall = (const bf16_t*)(C.ws + WS_K); const bf16_t* Vall = (const bf16_t*)(C.ws + WS_V);
  const float lam = *(const float*)(C.ws + WS_LAM);
  if (C.G == 256) { const int vcu = (C.bid & 7) * 32 + (C.bid >> 3);
    for (int i = 0; i < 8; ++i) { const int bh = (vcu >> 5) * 8 + i, qb = vcu & 31; attn_unit(Qg, Kall, Vall, AXo, lam, subg, bh >> 3, bh & 7, qb, lds); }
  } else {
    for (int L = C.bid; L < 2048; L += C.G) attn_unit(Qg, Kall, Vall, AXo, lam, subg, L >> 8, (L >> 5) & 7, L & 31, lds);
  }
}
#undef KSWZ
#undef SBAR
}
namespace hyn {
__device__ __forceinline__ float block_sum(float v, float* red, int tid) {
    v = wave_sum(v);
    __syncthreads();
    if ((tid & 63) == 0) red[tid >> 6] = v;
    __syncthreads();
    float s = 0.f;
#pragma unroll
    for (int i = 0; i < 8; ++i) s += red[i];
    return s;
}
__device__ __forceinline__ void build_kernel(const Params& p, const Ctx& C, int o, int c, float* kern, float* w3s, float* red) {
    const float* hdn = (const float*)(C.ws + WS_HDN); const float* w3 = p.in[I_FW3];
    __syncthreads();
    if (C.tid < 128) { const int dir = C.tid >> 6, k = C.tid & 63; w3s[C.tid] = w3[(size_t)k * 4096 + o * 2048 + dir * 1024 + c]; }
    __syncthreads();
    const float a = -3.0701134573253944f, bq = -15.350567286626972f;
    const float delta = fabsf(a + (float)c * ((bq - a) / 1023.f));
    float hf[8], hb[8]; float asum = 0.f;
#pragma unroll
    for (int j = 0; j < 8; ++j) { const int t = C.tid + 512 * j; const float* hr = hdn + t * 64; float sf = 0.f, sb = 0.f;
#pragma unroll 8
        for (int k = 0; k < 64; ++k) { const float hv = hr[k]; sf += hv * w3s[k]; sb += hv * w3s[64 + k]; }
        const float dec = expf(-((float)t * (1.f / 4095.f)) * delta);
        hf[j] = sf * dec; hb[j] = sb * dec; asum += fabsf(hf[j]) + (t > 0 ? fabsf(hb[j]) : 0.f); }
    const float tot = block_sum(asum, red, C.tid); const float inv = 1.f / tot;
#pragma unroll
    for (int j = 0; j < 8; ++j) { const int t = C.tid + 512 * j; kern[4096 + t] = hf[j] * inv; if (t > 0) kern[4096 - t] = hb[j] * inv; }
    if (C.tid == 0) kern[0] = 0.f;
    __syncthreads();
}
__device__ __forceinline__ void hyena_naive_phase(const Params& p, const Ctx& C, char* lds) {
    float* kern = (float*)lds;
    float* zb = (float*)(lds + 32768);
    float* w3s = (float*)(lds + 32768 + 65536);
    float* red = w3s + 128;
    const bf16_t* UT = (const bf16_t*)(C.ws + WS_UT); bf16_t* YX = (bf16_t*)(C.ws + WS_HX);
    const float* cw = p.in[I_HCW]; const float* cb = p.in[I_HCB]; const float* hyb = p.in[I_HYB];
    for (int unit = C.bid; unit < 2048; unit += C.G) {
        const int c = unit >> 1, bh = unit & 1;
        float vreg[8][4];
#pragma unroll
        for (int j = 0; j < 8; ++j) { const int t = C.tid + 512 * j;
#pragma unroll
            for (int bb = 0; bb < 4; ++bb) { const bf16_t* u = UT + ((size_t)(bh * 4 + bb) * 3072 + c) * SEQ;
                const float um = t > 0 ? bf2f(u[t - 1]) : 0.f, u0 = bf2f(u[t]), up = t < SEQ - 1 ? bf2f(u[t + 1]) : 0.f;
                vreg[j][bb] = um * cw[c] + u0 * cw[3072 + c] + up * cw[6144 + c] + cb[c]; } }
        for (int o = 0; o < 2; ++o) {
            build_kernel(p, C, o, c, kern, w3s, red);
#pragma unroll
            for (int j = 0; j < 8; ++j) { const int t = C.tid + 512 * j; *(f32x4*)(zb + t * 4) = (f32x4){vreg[j][0], vreg[j][1], vreg[j][2], vreg[j][3]}; }
            __syncthreads();
            float acc[8][4];
#pragma unroll
            for (int j = 0; j < 8; ++j)
#pragma unroll
                for (int bb = 0; bb < 4; ++bb) acc[j][bb] = 0.f;
            for (int s = 0; s < SEQ; ++s) { const f32x4 z4 = *(const f32x4*)(zb + s * 4);
#pragma unroll
                for (int j = 0; j < 8; ++j) { const float kv = kern[4096 + C.tid + 512 * j - s];
#pragma unroll
                    for (int bb = 0; bb < 4; ++bb) acc[j][bb] += kv * z4[bb]; } }
            const float bias = hyb[o * 1024 + c]; const int xc = (o + 1) * 1024 + c;
#pragma unroll
            for (int j = 0; j < 8; ++j) { const int t = C.tid + 512 * j;
#pragma unroll
                for (int bb = 0; bb < 4; ++bb) { const bf16_t* u = UT + ((size_t)(bh * 4 + bb) * 3072 + xc) * SEQ;
                    const float um = t > 0 ? bf2f(u[t - 1]) : 0.f, u0 = bf2f(u[t]), up = t < SEQ - 1 ? bf2f(u[t + 1]) : 0.f;
                    const float xg = um * cw[xc] + u0 * cw[3072 + xc] + up * cw[6144 + xc] + cb[xc];
                    vreg[j][bb] = xg * (acc[j][bb] + vreg[j][bb] * bias); } }
            __syncthreads();
        }
#pragma unroll
        for (int j = 0; j < 8; ++j) { const int t = C.tid + 512 * j;
#pragma unroll
            for (int bb = 0; bb < 4; ++bb) YX[((size_t)(bh * 4 + bb) * SEQ + t) * DM + c] = (bf16_t)(cvt_pk_bf16(vreg[j][bb], 0.f) & 0xffffu); }
    }
}
}
namespace hym {
constexpr size_t WS_TAB0 = WS_WIN;
constexpr size_t WS_TAB1 = 492 * MiB;
constexpr int ZBLK = 134, ZHS = ZBLK * 256, Z_BYTES = 2 * ZHS;
constexpr int KCS = 16448, KC_OFF = Z_BYTES, KC_BYTES = 4 * KCS, SCR_OFF = KC_OFF + KC_BYTES;
static_assert(SCR_OFF + 256 <= 147456, "hyena LDS");

__device__ __forceinline__ void table_phase(const Params& p, const Ctx& C, char* lds) {
    const float* hdn = (const float*)(C.ws + WS_HDN); const float* w3 = p.in[I_FW3];
    float* w3s = (float*)lds;
    float* red = w3s + 512;
    for (int unit = C.bid; unit < 512; unit += C.G) {
        const int o = unit >> 8, c0 = (unit & 255) * 4;
        __syncthreads();
        int tq = C.tid; asm volatile("" : "+v"(tq));
        { const int col = C.tid >> 6, k = C.tid & 63; const int dir = col >> 2, cc = col & 3; w3s[col * 64 + k] = w3[(size_t)k * 4096 + o * 2048 + dir * 1024 + c0 + cc]; }
        __syncthreads();
        float dl[4];
#pragma unroll
        for (int cc = 0; cc < 4; ++cc) { const float a = -3.0701134573253944f, bq = -15.350567286626972f; dl[cc] = fabsf(a + (float)(c0 + cc) * ((bq - a) / 1023.f)); }
        float h[8][8]; float asum[4] = {0.f, 0.f, 0.f, 0.f};
#pragma unroll
        for (int j = 0; j < 8; ++j) { const int t = tq + 512 * j; const float* hr = hdn + t * 64;
            float s[8];
#pragma unroll
            for (int q = 0; q < 8; ++q) s[q] = 0.f;
#pragma unroll 4
            for (int k4 = 0; k4 < 16; ++k4) { const f32x4 hv = *(const f32x4*)(hr + 4 * k4);
#pragma unroll
                for (int q = 0; q < 8; ++q) { const f32x4 wv = *(const f32x4*)(w3s + q * 64 + 4 * k4); s[q] += hv[0] * wv[0] + hv[1] * wv[1] + hv[2] * wv[2] + hv[3] * wv[3]; } }
            const float tn = (float)t * (1.f / 4095.f);
#pragma unroll
            for (int cc = 0; cc < 4; ++cc) { const float dec = expf(-tn * dl[cc]); h[j][cc] = s[cc] * dec; h[j][4 + cc] = s[4 + cc] * dec; asum[cc] += fabsf(h[j][cc]) + (t > 0 ? fabsf(h[j][4 + cc]) : 0.f); } }
#pragma unroll
        for (int cc = 0; cc < 4; ++cc) asum[cc] = wave_sum(asum[cc]);
        if (C.lane == 0) { red[C.wave * 4 + 0] = asum[0]; red[C.wave * 4 + 1] = asum[1]; red[C.wave * 4 + 2] = asum[2]; red[C.wave * 4 + 3] = asum[3]; }
        __syncthreads();
        float inv[4];
#pragma unroll
        for (int cc = 0; cc < 4; ++cc) { float s = 0.f;
#pragma unroll
            for (int w = 0; w < 8; ++w) s += red[w * 4 + cc];
            inv[cc] = 1.f / s; }
        bf16_t* tab = (bf16_t*)(C.ws + (o ? WS_TAB1 : WS_TAB0));
#pragma unroll
        for (int cc = 0; cc < 4; ++cc) { bf16_t* row = tab + (size_t)(c0 + cc) * 8192;
#pragma unroll
            for (int j = 0; j < 8; ++j) { const int t = tq + 512 * j;
                row[4096 - t] = (bf16_t)(cvt_pk_bf16(h[j][cc] * inv[cc], 0.f) & 0xffffu);
                if (t > 0) row[4096 + t] = (bf16_t)(cvt_pk_bf16(h[j][4 + cc] * inv[cc], 0.f) & 0xffffu); }
            if (C.tid == 0) row[0] = 0; }
    }
}

__device__ __forceinline__ int zaddr(int b, int t) {
    const int tp = t + 96, Jp = tp >> 5, g = (tp >> 3) & 3;
    return (b >> 2) * ZHS + Jp * 256 + ((((g ^ (Jp & 3)) << 2) | (b & 3)) << 4) + (tp & 7) * 2;
}
__device__ __forceinline__ void conv3_8(const bf16_t* urow, int t0, float w0, float w1, float w2, float bias, float (&out)[8]) {
    const u32x4 raw = *(const u32x4*)(urow + t0);
    float u[10];
    u[0] = t0 > 0 ? bf2f(urow[t0 - 1]) : 0.f; u[9] = (t0 + 8 < SEQ) ? bf2f(urow[t0 + 8]) : 0.f;
    u[1] = bflo(raw.x); u[2] = bfhi(raw.x); u[3] = bflo(raw.y); u[4] = bfhi(raw.y); u[5] = bflo(raw.z); u[6] = bfhi(raw.z); u[7] = bflo(raw.w); u[8] = bfhi(raw.w);
#pragma unroll
    for (int e = 0; e < 8; ++e) out[e] = u[e] * w0 + u[e + 1] * w1 + u[e + 2] * w2 + bias;
}
__device__ __forceinline__ u32x4 pack8f(const float (&v)[8]) { u32x4 w; w.x = cvt_pk_bf16(v[0], v[1]); w.y = cvt_pk_bf16(v[2], v[3]); w.z = cvt_pk_bf16(v[4], v[5]); w.w = cvt_pk_bf16(v[6], v[7]); return w; }

__device__ __forceinline__ void build_kc(const bf16_t* trow, char* lds, int tid) {
#pragma unroll
    for (int q = 0; q < 2; ++q) { const int m = tid + 512 * q;
        const u32x4 cur = *(const u32x4*)(trow + 8 * m); u32x4 prv = {0u, 0u, 0u, 0u}; if (m > 0) prv = *(const u32x4*)(trow + 8 * m - 8);
        const unsigned s2 = prv.z, s3 = prv.w, s4 = cur.x, s5 = cur.y, s6 = cur.z, s7 = cur.w;
        const u32x4 c0 = cur;
        const u32x4 c1 = {__builtin_amdgcn_alignbit(s4, s3, 16), __builtin_amdgcn_alignbit(s5, s4, 16), __builtin_amdgcn_alignbit(s6, s5, 16), __builtin_amdgcn_alignbit(s7, s6, 16)};
        const u32x4 c2 = {s3, s4, s5, s6};
        const u32x4 c3 = {__builtin_amdgcn_alignbit(s3, s2, 16), __builtin_amdgcn_alignbit(s4, s3, 16), __builtin_amdgcn_alignbit(s5, s4, 16), __builtin_amdgcn_alignbit(s6, s5, 16)};
        *(u32x4*)(lds + KC_OFF + 0 * KCS + 16 * m) = c0; *(u32x4*)(lds + KC_OFF + 1 * KCS + 16 * m) = c1;
        *(u32x4*)(lds + KC_OFF + 2 * KCS + 16 * m) = c2; *(u32x4*)(lds + KC_OFF + 3 * KCS + 16 * m) = c3; }
}

struct Frag { bf16x8 a0, a1, b[8]; };
__device__ __forceinline__ void conv_load(Frag& f, const char* pA, const char* pB0, const char* pB1, const char* pz, int d, int Xb) {
    const s16x4 a00 = *(const s16x4*)(pA), a01 = *(const s16x4*)(pA + 8), a10 = *(const s16x4*)(pA + 32), a11 = *(const s16x4*)(pA + 40);
    f.a0 = (bf16x8){a00[0], a00[1], a00[2], a00[3], a01[0], a01[1], a01[2], a01[3]}; f.a1 = (bf16x8){a10[0], a10[1], a10[2], a10[3], a11[0], a11[1], a11[2], a11[3]};
#pragma unroll
    for (int k = 0; k < 4; ++k) { const int J0 = Xb + 4 * k - d; const bool ok = (J0 >= -3 && J0 <= 127);
        const char* q0 = ok ? pB0 + k * 1024 : pz; const char* q1 = ok ? pB1 + k * 1024 : pz;
        f.b[2 * k] = *(const bf16x8*)q0; f.b[2 * k + 1] = *(const bf16x8*)q1; }
}
__device__ __forceinline__ void conv_mma(f32x16 (&acc)[4], const Frag& f) {
#pragma unroll
    for (int k = 0; k < 4; ++k) { acc[k] = __builtin_amdgcn_mfma_f32_32x32x16_bf16(f.a0, f.b[2 * k], acc[k], 0, 0, 0); acc[k] = __builtin_amdgcn_mfma_f32_32x32x16_bf16(f.a1, f.b[2 * k + 1], acc[k], 0, 0, 0); }
}
__device__ __forceinline__ void conv_loop(f32x16 (&acc)[4], const char* lds, int wave, int lane) {
    const int i = lane & 31, hh = lane >> 5, jj = (lane >> 3) & 3, bq = lane & 3, bhh = (lane >> 2) & 1;
    const int Xb = 16 * wave;
    const char* pz = lds + bhh * ZHS + bq * 16;
#pragma unroll 1
    for (int dm = 0; dm < 4; ++dm) {
        const int dlo = Xb - 127 + ((dm - (Xb - 127)) & 3);
        const int cnt = (Xb + 15 - dlo) / 4 + 1;
        const int sw = (jj + 3 - dm) & 3;
        const char* pB0 = lds + bhh * ZHS + bq * 16 + (((hh) ^ sw) << 6) + (jj + 3) * 256 + (Xb - dlo) * 256;
        const char* pB1 = lds + bhh * ZHS + bq * 16 + (((2 + hh) ^ sw) << 6) + (jj + 3) * 256 + (Xb - dlo) * 256;
        const char* pA = lds + KC_OFF + (i & 3) * KCS + 2 * (4096 - (i & ~3) + 8 * hh) - 64 * dlo;
        Frag f0, f1;
        conv_load(f0, pA, pB0, pB1, pz, dlo, Xb);
        int d = dlo;
#pragma unroll 1
        for (int n = 0; n < cnt; n += 2) {
            asm volatile("s_waitcnt lgkmcnt(0)" ::: "memory"); __builtin_amdgcn_sched_barrier(0);
            if (n + 1 < cnt) conv_load(f1, pA - 256, pB0 - 1024, pB1 - 1024, pz, d + 4, Xb);
            __builtin_amdgcn_sched_barrier(0);
            conv_mma(acc, f0);
            __builtin_amdgcn_sched_barrier(0);
            if (n + 1 < cnt) {
                asm volatile("s_waitcnt lgkmcnt(0)" ::: "memory"); __builtin_amdgcn_sched_barrier(0);
                if (n + 2 < cnt) conv_load(f0, pA - 512, pB0 - 2048, pB1 - 2048, pz, d + 8, Xb);
                __builtin_amdgcn_sched_barrier(0);
                conv_mma(acc, f1);
                __builtin_amdgcn_sched_barrier(0);
            }
            pA -= 512; pB0 -= 2048; pB1 -= 2048; d += 8;
        }
    }
}

__device__ __forceinline__ void hyena_phase(const Params& p, const Ctx& C, char* lds) {
    const bf16_t* UT = (const bf16_t*)(C.ws + WS_UT); bf16_t* YXT = (bf16_t*)(C.ws + WS_HX);
    const float* cw = p.in[I_HCW]; const float* cb = p.in[I_HCB]; const float* hyb = p.in[I_HYB];
    const int lane = C.lane, wave = C.wave, tid = C.tid;
    __syncthreads();
    if (tid < 384) { const int bh = tid / 192, r = tid % 192, blk = r / 32, off = (r % 32) * 8; const int Jp = blk < 3 ? blk : 128 + blk;
        *(unsigned long long*)(lds + bh * ZHS + Jp * 256 + off) = 0ull; }
    for (int c = C.bid; c < 1024; c += C.G) {
        __syncthreads();
        { const bf16_t* urow = UT + ((size_t)wave * 3072 + c) * SEQ; const float w0 = cw[c], w1 = cw[3072 + c], w2 = cw[6144 + c], bs = cb[c];
#pragma unroll 2
            for (int ch = 0; ch < 8; ++ch) { const int t0 = ch * 512 + lane * 8; float v[8]; conv3_8(urow, t0, w0, w1, w2, bs, v); *(u32x4*)(lds + zaddr(wave, t0)) = pack8f(v); } }
#pragma unroll 1
        for (int o = 0; o < 2; ++o) {
            build_kc((const bf16_t*)(C.ws + (o ? WS_TAB1 : WS_TAB0)) + (size_t)c * 8192, lds, tid);
            __syncthreads();
            f32x16 acc[4];
#pragma unroll
            for (int k = 0; k < 4; ++k) acc[k] = f32x16{};
            conv_loop(acc, lds, wave, lane);
            __syncthreads();
            { const int xc = (o + 1) * 1024 + c; const bf16_t* urow = UT + ((size_t)wave * 3072 + xc) * SEQ; const float w0 = cw[xc], w1 = cw[3072 + xc], w2 = cw[6144 + xc], bs = cb[xc];
#pragma unroll 2
                for (int ch = 0; ch < 8; ++ch) { const int t0 = ch * 512 + lane * 8; float v[8]; conv3_8(urow, t0, w0, w1, w2, bs, v); *(u32x4*)(lds + KC_OFF + wave * 8192 + t0 * 2) = pack8f(v); } }
            __syncthreads();
            const float bias = hyb[o * 1024 + c];
            int lb = lane; asm volatile("" : "+v"(lb));
            const int b = lb & 7, jj = (lb >> 3) & 3, hi = lb >> 5, sw = (jj + 3) & 3;
            const int zb = (b >> 2) * ZHS + (16 * wave + jj + 3) * 256 + ((b & 3) << 4) + 8 * hi;
            const int xb = KC_OFF + b * 8192 + 64 * (16 * wave + jj) + 8 * hi;
            bf16_t* yb = YXT + ((size_t)b * 1024 + c) * SEQ + 32 * (16 * wave + jj) + 4 * hi;
#pragma unroll
            for (int g = 0; g < 4; ++g) { const int zg = zb + ((g ^ sw) << 6);
#pragma unroll
                for (int k = 0; k < 4; ++k) {
                    u32x2* zp = (u32x2*)(lds + zg + k * 1024);
                    const u32x2 zw = *zp, xw = *(const u32x2*)(lds + xb + k * 256 + 16 * g);
                    const float v0 = bflo(xw.x) * (acc[k][4 * g + 0] + bflo(zw.x) * bias), v1 = bfhi(xw.x) * (acc[k][4 * g + 1] + bfhi(zw.x) * bias);
                    const float v2 = bflo(xw.y) * (acc[k][4 * g + 2] + bflo(zw.y) * bias), v3 = bfhi(xw.y) * (acc[k][4 * g + 3] + bfhi(zw.y) * bias);
                    u32x2 ow; ow.x = cvt_pk_bf16(v0, v1); ow.y = cvt_pk_bf16(v2, v3);
                    if (o == 0) *zp = ow; else *(u32x2*)(yb + 128 * k + 8 * g) = ow; } }
            __syncthreads();
        }
    }
}

constexpr size_t WS_YX2 = WS_UT;
__device__ __forceinline__ void yx_transpose_phase(const Ctx& C, char* lds) {
    const bf16_t* YXT = (const bf16_t*)(C.ws + WS_HX); bf16_t* YX = (bf16_t*)(C.ws + WS_YX2);
    bf16_t* scr = (bf16_t*)(lds + C.wave * 16384);
    const int gw = C.bid * 8 + C.wave, NGW = C.G * 8, lane = C.lane, r8 = lane >> 3, ch = lane & 7;
    for (int tile = gw; tile < 8 * 16 * 64; tile += NGW) {
        const int b = tile >> 10, c0 = ((tile >> 6) & 15) * 64, t0 = (tile & 63) * 64;
#pragma unroll
        for (int i = 0; i < 8; ++i) { const int cr = i * 8 + r8; const u32x4 v = *(const u32x4*)(YXT + ((size_t)b * 1024 + c0 + cr) * SEQ + t0 + 8 * ch);
            bf16_t* sp = scr + (8 * ch) * 72 + cr;
            sp[0 * 72] = (bf16_t)(v.x & 0xffffu); sp[1 * 72] = (bf16_t)(v.x >> 16); sp[2 * 72] = (bf16_t)(v.y & 0xffffu); sp[3 * 72] = (bf16_t)(v.y >> 16);
            sp[4 * 72] = (bf16_t)(v.z & 0xffffu); sp[5 * 72] = (bf16_t)(v.z >> 16); sp[6 * 72] = (bf16_t)(v.w & 0xffffu); sp[7 * 72] = (bf16_t)(v.w >> 16); }
        asm volatile("s_waitcnt lgkmcnt(0)" ::: "memory");
#pragma unroll
        for (int i = 0; i < 8; ++i) { const int tr = i * 8 + r8; const u32x4 v = *(const u32x4*)(scr + tr * 72 + 8 * ch);
            *(u32x4*)(YX + ((size_t)b * SEQ + t0 + tr) * DM + c0 + 8 * ch) = v; }
        asm volatile("s_waitcnt lgkmcnt(0)" ::: "memory");
    }
}
}
namespace moe {
__device__ __forceinline__ void route_phase(const Params& p, const Ctx& C, const float* xnew, char* lds) {
    const float* mod = (const float*)(C.ws + WS_MOD); const float* g = p.in[I_N2G]; const float* rw = p.in[I_RW]; const float* rb = p.in[I_RB];
    bf16_t* HX2 = (bf16_t*)(C.ws + WS_HX); int* eidx = (int*)(C.ws + WS_EIDX); float* wsel = (float*)(C.ws + WS_WSEL); int* counts = (int*)(C.ws + WS_CNT);
    float* hb = (float*)(lds + C.wave * 16384);
    int* hist = (int*)(lds + 8 * 16384);
    if (C.tid < 64) hist[C.tid] = 0;
    __syncthreads();
    const int gw = C.bid * 8 + C.wave, NGW = C.G * 8, lane = C.lane;
    const float bias = rb[lane];
    for (int grp = gw; grp < NTOK / 4; grp += NGW) {
        const int tok0 = grp * 4; const int b = tok0 >> 12;
        const float* sh = mod + b * 6144 + 3072; const float* sc = sh + 1024;
        f32x4 v[4][4];
#pragma unroll
        for (int i = 0; i < 4; ++i) { const float* xr = xnew + (size_t)(tok0 + i) * DM; float ss = 0.f;
#pragma unroll
            for (int j = 0; j < 4; ++j) { v[i][j] = *(const f32x4*)(xr + 256 * j + 4 * lane); ss += (v[i][j].x * v[i][j].x + v[i][j].y * v[i][j].y) + (v[i][j].z * v[i][j].z + v[i][j].w * v[i][j].w); }
            const float rn = 1.0f / sqrtf(wave_sum(ss) * (1.f / DM) + NORM_EPS);
#pragma unroll
            for (int j = 0; j < 4; ++j) { const int k = 256 * j + 4 * lane;
                const f32x4 gv = *(const f32x4*)(g + k), scv = *(const f32x4*)(sc + k), shv = *(const f32x4*)(sh + k);
                v[i][j] = v[i][j] * rn * gv * (1.f + scv) + shv;
                u32x2 w; w.x = cvt_pk_bf16(v[i][j].x, v[i][j].y); w.y = cvt_pk_bf16(v[i][j].z, v[i][j].w);
                *(u32x2*)(HX2 + (size_t)(tok0 + i) * DM + k) = w; } }
#pragma unroll
        for (int j = 0; j < 4; ++j)
#pragma unroll
            for (int e = 0; e < 4; ++e) { const int k = 256 * j + 4 * lane + e; *(f32x4*)(hb + k * 4) = (f32x4){v[0][j][e], v[1][j][e], v[2][j][e], v[3][j][e]}; }
        asm volatile("s_waitcnt lgkmcnt(0)" ::: "memory");
        float acc[4] = {0.f, 0.f, 0.f, 0.f};
#pragma unroll 8
        for (int k = 0; k < DM; ++k) { const float w = rw[k * 64 + lane]; const f32x4 h4 = *(const f32x4*)(hb + k * 4);
            acc[0] += h4[0] * w; acc[1] += h4[1] * w; acc[2] += h4[2] * w; acc[3] += h4[3] * w; }
#pragma unroll
        for (int i = 0; i < 4; ++i) {
            const float s = 1.f / (1.f + expf(-acc[i])); const float ch = s + bias;
            float m1 = ch; m1 = fmaxf(m1, __shfl_xor(m1, 1)); m1 = fmaxf(m1, __shfl_xor(m1, 2)); m1 = fmaxf(m1, __shfl_xor(m1, 4));
            const unsigned long long eq = __ballot(ch == m1); const int gidx = lane >> 3; const unsigned gm = (unsigned)(eq >> (8 * gidx)) & 0xffu; const int first = __builtin_ctz(gm);
            float c2 = ((lane & 7) == first) ? -INFINITY : ch;
            float m2 = c2; m2 = fmaxf(m2, __shfl_xor(m2, 1)); m2 = fmaxf(m2, __shfl_xor(m2, 2)); m2 = fmaxf(m2, __shfl_xor(m2, 4));
            const float gs = m1 + m2; int grank = 0;
#pragma unroll
            for (int g2 = 0; g2 < 8; ++g2) { const float ov = __shfl(gs, 8 * g2); grank += (ov > gs || (ov == gs && g2 < gidx)) ? 1 : 0; }
            const bool gsel = grank < 4; const float mc = gsel ? ch : -INFINITY; int rank = 0;
#pragma unroll 16
            for (int e2 = 0; e2 < 64; ++e2) { const float ov = __shfl(mc, e2); rank += (ov > mc || (ov == mc && e2 < lane)) ? 1 : 0; }
            const bool sel = gsel && rank < 8;
            const float tot = wave_sum(sel ? s : 0.f);
            if (sel) { eidx[(tok0 + i) * 8 + rank] = lane; wsel[(tok0 + i) * 8 + rank] = s / tot * 2.5f; atomicAdd(&hist[lane], 1); }
        }
    }
    __syncthreads();
    if (C.tid < 64 && hist[C.tid] > 0) atomicAdd(&counts[C.tid], hist[C.tid]);
}

__device__ __forceinline__ void place_phase(const Ctx& C, char* lds) {
    int* counts = (int*)(C.ws + WS_CNT); int* cursor = counts + 64; int* ntp = counts + 128; int* tile_e = (int*)(C.ws + WS_TILEE);
    int* row_tok = (int*)(C.ws + WS_ROWTOK); int* pos = (int*)(C.ws + WS_POS); const int* eidx = (const int*)(C.ws + WS_EIDX);
    int* pst = (int*)lds;
    int* lh = pst + 80;
    int* lbase = lh + 64;
    if (C.tid == 0) { int a = 0; for (int e = 0; e < 64; ++e) { pst[e] = a; const int cnt = __hip_atomic_load(counts + e, __ATOMIC_RELAXED, __HIP_MEMORY_SCOPE_AGENT); a += (cnt + 255) / 256 * 256; } pst[64] = a; }
    __syncthreads();
    const int P = pst[64];
    if (C.bid == 0) {
        if (C.tid == 0) *ntp = P / 256 + 128;
        for (int t = C.tid; t < P / 256 + 128; t += 512) { int e = 64; const int r = t * 256; if (r < P) { e = 0; while (pst[e + 1] <= r) ++e; } tile_e[t] = e; }
    }
    for (int chunk = C.bid; chunk < NTOK / 128; chunk += C.G) {
        if (C.tid < 64) lh[C.tid] = 0;
        __syncthreads();
        int e_[2], lr_[2];
#pragma unroll
        for (int q = 0; q < 2; ++q) { const int a = C.tid + 512 * q; const int tok = chunk * 128 + (a >> 3); e_[q] = eidx[tok * 8 + (a & 7)]; lr_[q] = atomicAdd(&lh[e_[q]], 1); }
        __syncthreads();
        if (C.tid < 64) lbase[C.tid] = lh[C.tid] > 0 ? atomicAdd(&cursor[C.tid], lh[C.tid]) : 0;
        __syncthreads();
#pragma unroll
        for (int q = 0; q < 2; ++q) { const int a = C.tid + 512 * q; const int tok = chunk * 128 + (a >> 3); const int dest = pst[e_[q]] + lbase[e_[q]] + lr_[q]; row_tok[dest] = tok; pos[tok * 8 + (a & 7)] = dest; }
        __syncthreads();
    }
    for (int tok = C.bid * 512 + C.tid; tok < NTOK; tok += C.G * 512) row_tok[P + tok] = tok;
}

struct MoeOrder {
    const int* tile_e; int NT, G, c, NJ, PNE, colq;
    __device__ bool next(int i, pg8::Unit& u) const {
        const long L = (long)i * G + c; if (L >= (long)NT * NJ) return false;
        const int t = (int)(L / NJ), j = (int)(L % NJ);
        u.pm = t; u.pn = __hip_atomic_load(tile_e + t, __ATOMIC_RELAXED, __HIP_MEMORY_SCOPE_AGENT) * PNE + (NJ == 2 ? j : colq); return true;
    }
};

template <bool LAST>
__device__ __forceinline__ void combine_phase(const Params& p, const Ctx& C, int q) {
    const float* mod = (const float*)(C.ws + WS_MOD); const bf16_t* Y = (const bf16_t*)(C.ws + WS_Y);
    const int* pos = (const int*)(C.ws + WS_POS); const float* wsel = (const float*)(C.ws + WS_WSEL);
    const int NT = __hip_atomic_load((const int*)(C.ws + WS_CNT) + 128, __ATOMIC_RELAXED, __HIP_MEMORY_SCOPE_AGENT); const int P = (NT - 128) * 256;
    float* out = p.out; const float* fg = p.in[I_FNG];
    const int gw = C.bid * 8 + C.wave, NGW = C.G * 8, lane = C.lane;
    for (int tok = gw; tok < NTOK; tok += NGW) {
        const int b = tok >> 12; const float* g2 = mod + b * 6144 + 5120 + 256 * q + 4 * lane;
        f32x4 a = {0.f, 0.f, 0.f, 0.f};
#pragma unroll
        for (int k = 0; k < 8; ++k) { const int r = pos[tok * 8 + k]; const float w = wsel[tok * 8 + k]; const u32x2 y = *(const u32x2*)(Y + (size_t)r * 256 + 4 * lane);
            a[0] += w * bflo(y.x); a[1] += w * bfhi(y.x); a[2] += w * bflo(y.y); a[3] += w * bfhi(y.y); }
        { const u32x2 y = *(const u32x2*)(Y + (size_t)(P + tok) * 256 + 4 * lane); a[0] += bflo(y.x); a[1] += bfhi(y.x); a[2] += bflo(y.y); a[3] += bfhi(y.y); }
        float* op = out + (size_t)tok * DM;
        const f32x4 xo = *(const f32x4*)(op + 256 * q + 4 * lane); const f32x4 gv = *(const f32x4*)g2;
        const f32x4 xn = xo + gv * a;
        if (!LAST) { *(f32x4*)(op + 256 * q + 4 * lane) = xn; }
        else {
            f32x4 v[4]; float ss = 0.f;
#pragma unroll
            for (int j = 0; j < 4; ++j) { v[j] = (j == 3) ? xn : *(const f32x4*)(op + 256 * j + 4 * lane); ss += (v[j].x * v[j].x + v[j].y * v[j].y) + (v[j].z * v[j].z + v[j].w * v[j].w); }
            const float rn = 1.0f / sqrtf(wave_sum(ss) * (1.f / DM) + NORM_EPS);
#pragma unroll
            for (int j = 0; j < 4; ++j) { const f32x4 gq = *(const f32x4*)(fg + 256 * j + 4 * lane); *(f32x4*)(op + 256 * j + 4 * lane) = v[j] * rn * gq; }
        }
    }
}
}
#define XB_TMO      128
#define XB_XCNT(j)  (256  + 64 * (j))
#define XB_XSUB(j)  (1280 + 64 * (j))
#define XB_XGEN(j)  (2304 + 64 * (j))
#define XB_TOP      3328
#define XB_TOPGEN   3392
#define XCD_BAR_WORDS 3456
#define XB_SPIN_CAP (1u << 21)

__device__ __forceinline__ unsigned xb_ld(unsigned* p)              { return __hip_atomic_load(p, __ATOMIC_RELAXED, __HIP_MEMORY_SCOPE_AGENT); }
__device__ __forceinline__ unsigned xb_add(unsigned* p, unsigned v) { return __hip_atomic_fetch_add(p, v, __ATOMIC_RELAXED, __HIP_MEMORY_SCOPE_AGENT); }
__device__ __forceinline__ unsigned xb_xcc_id() { return (unsigned)__builtin_amdgcn_s_getreg((3 << 11) | 20) & 0xFu; }
#define XB_SPIN(cond, bar) do { unsigned _sp = 0; while (cond) { __builtin_amdgcn_s_sleep(1); \
    if ((++_sp & 255u) == 0u) { if (xb_ld(&(bar)[XB_TMO])) break; if (_sp > XB_SPIN_CAP) { atomicAdd(&(bar)[XB_TMO], 1u); break; } } } } while (0)

struct XcdBarrier {
    unsigned* bar; unsigned x;
    volatile LAS unsigned* st;
};

__device__ __forceinline__ XcdBarrier xcd_barrier_post(unsigned* bar, volatile LAS unsigned* st) {
    XcdBarrier b; b.bar = bar; b.x = xb_xcc_id(); b.st = st;
    if (threadIdx.x == 0) (void)xb_add(&bar[XB_XCNT(b.x)], 1u);
    return b;
}
__device__ __forceinline__ void xcd_barrier_complete(unsigned* bar, unsigned x, unsigned& nloc, unsigned& nx) {
    const unsigned G = gridDim.x * gridDim.y * gridDim.z;
    unsigned sum, cnt, mine, sp = 0u;
    for (;;) {
        sum = 0u; cnt = 0u; mine = 0u;
#pragma unroll
        for (unsigned j = 0; j < 16; ++j) { const unsigned c = xb_ld(&bar[XB_XCNT(j)]); sum += c; cnt += (c > 0u) ? 1u : 0u; mine = (j == x) ? c : mine; }
        if (sum == G) break;
        __builtin_amdgcn_s_sleep(1);
        if ((++sp & 255u) == 0u) { if (xb_ld(&bar[XB_TMO])) break; if (sp > XB_SPIN_CAP) { atomicAdd(&bar[XB_TMO], 1u); break; } }
    }
    nloc = mine > 0u ? mine : 1u; nx = cnt > 0u ? cnt : 1u;
}

__device__ __forceinline__ void xcd_barrier(const XcdBarrier& b) {
    asm volatile("s_waitcnt vmcnt(0)" ::: "memory");
    __syncthreads();
    if (threadIdx.x == 0) {
        unsigned* bar = b.bar;
        __builtin_amdgcn_s_waitcnt(0);
        unsigned nloc = b.st[0], nx = b.st[1];
        if (nloc == 0u) { xcd_barrier_complete(bar, b.x, nloc, nx); b.st[0] = nloc; b.st[1] = nx; }
        const unsigned old = xb_add(&bar[XB_XSUB(b.x)], 1u);
        const unsigned gen = old / nloc;
        if (old + 1u == (gen + 1u) * nloc) {
            __builtin_amdgcn_fence(__ATOMIC_RELEASE, "agent");
            asm volatile("s_waitcnt vmcnt(0)" ::: "memory");
            const unsigned og = xb_add(&bar[XB_TOP], 1u);
            const unsigned tg = og / nx;
            if (og + 1u == (tg + 1u) * nx) xb_add(&bar[XB_TOPGEN], 1u);
            else XB_SPIN(xb_ld(&bar[XB_TOPGEN]) == tg, bar);
            __builtin_amdgcn_fence(__ATOMIC_ACQUIRE, "agent");
            xb_add(&bar[XB_XGEN(b.x)], 1u);
            asm volatile("s_waitcnt vmcnt(0)" ::: "memory");
        } else {
            XB_SPIN(xb_ld(&bar[XB_XGEN(b.x)]) == gen, bar);
            __builtin_amdgcn_fence(__ATOMIC_ACQUIRE, "agent");
            asm volatile("s_waitcnt vmcnt(0)" ::: "memory");
        }
    }
    __syncthreads();
}

constexpr int LDS_BYTES = 147456;
struct InProjOrder {
    pg8::StaticOrder so; int G, c;
    __device__ bool next(int i, pg8::Unit& u) const {
        const long L = (long)i * G + c;
        if (L < 4096) return so.next(i, u);
        const int r = (int)(L - 4096); if (r >= 64) return false;
        u.pm = 128 + r / 8; u.pn = r % 8; return true;
    }
};

template <int PH> __device__ __forceinline__ void run_phase(const Params& p, unsigned char* lds_) {
    int tid_ = threadIdx.x; asm volatile("" : "+v"(tid_));
    Ctx C; C.tid = tid_; C.lane = C.tid & 63; C.wave = __builtin_amdgcn_readfirstlane(C.tid >> 6); C.G = gridDim.x; C.bid = blockIdx.x; C.ws = p.ws;
    char* lds = (char*)lds_; LAS unsigned char* ldsl = (LAS unsigned char*)lds_;
    unsigned char* ws = C.ws;
    if constexpr (PH == 0) { adaln_phase(p, C, lds); __syncthreads(); wconv_mixer_phase(p, C, lds); hdn_phase(p, C); }
    else if constexpr (PH == 1) { hx_phase(p, C); }
    else if constexpr (PH == 2) {
        pg8::Gemm g{(const bf16_t*)(ws + WS_HX), (const bf16_t*)(ws + WS_WIN), 1024, nullptr};
        InProjOrder S; S.so.init(NTOK, INW, C.G, C.bid); S.G = C.G; S.c = C.bid;
        epi::InProj E{(bf16_t*)(ws + WS_Q), (bf16_t*)(ws + WS_K), (bf16_t*)(ws + WS_V), (bf16_t*)(ws + WS_UT), (bf16_t*)p.out};
        pg8::gemm_phase<epi::InProj, InProjOrder, false>(ldsl, g, S, E);
    }
    else if constexpr (PH == 3) { att::attn_phase(C, p.in[I_SUBG], (bf16_t*)(C.ws + WS_Q), lds); }
    else if constexpr (PH == 22) { att::attn_phase(C, p.in[I_SUBG], (bf16_t*)(C.ws + WS_HX), lds); }
    else if constexpr (PH == 4) { hym::hyena_phase(p, C, lds); }
    else if constexpr (PH == 20) { hym::table_phase(p, C, lds); }
    else if constexpr (PH == 21) { hyn::hyena_naive_phase(p, C, lds); }
    else if constexpr (PH == 5) { hym::yx_transpose_phase(C, lds); __syncthreads(); wconv_moe_phase(p, C, lds); }
    else if constexpr (PH == 6) {
        pg8::Gemm g{(const bf16_t*)(ws + WS_Q), (const bf16_t*)(ws + WS_WPA), 1024, nullptr};
        pg8::StaticOrder S; S.init(NTOK, DM, C.G, C.bid);
        epi::Merge<0> E{(const bf16_t*)p.out, (bf16_t*)(ws + WS_K)};
        pg8::gemm_phase<epi::Merge<0>, pg8::StaticOrder, false>(ldsl, g, S, E);
    }
    else if constexpr (PH == 7) {
        pg8::Gemm g{(const bf16_t*)(ws + hym::WS_YX2), (const bf16_t*)(ws + WS_WPH), 1024, nullptr};
        pg8::StaticOrder S; S.init(NTOK, DM, C.G, C.bid);
        epi::Merge<1> E{(const bf16_t*)p.out, (bf16_t*)(ws + WS_K)};
        pg8::gemm_phase<epi::Merge<1>, pg8::StaticOrder, false>(ldsl, g, S, E);
    }
    else if constexpr (PH == 8) {
        pg8::Gemm g{(const bf16_t*)(ws + WS_K), (const bf16_t*)(ws + WS_WOUT), 1024, nullptr};
        pg8::StaticOrder S; S.init(NTOK, DM, C.G, C.bid);
        epi::OutProj E{p.in[I_X], (const float*)(ws + WS_MOD), p.out};
        pg8::gemm_phase<epi::OutProj, pg8::StaticOrder, false>(ldsl, g, S, E);
    }
    else if constexpr (PH == 9) { moe::route_phase(p, C, p.out, lds); }
    else if constexpr (PH == 10) { moe::place_phase(C, lds); }
    else if constexpr (PH == 11) {
        const int NT = __hip_atomic_load((const int*)(ws + WS_CNT) + 128, __ATOMIC_RELAXED, __HIP_MEMORY_SCOPE_AGENT);
        pg8::Gemm g{(const bf16_t*)(ws + WS_HX), (const bf16_t*)(ws + WS_WGU), 1024, (const int*)(ws + WS_ROWTOK)};
        moe::MoeOrder S{(const int*)(ws + WS_TILEE), NT, C.G, C.bid, 2, 2, 0};
        epi::SwiGLU E{(bf16_t*)(ws + WS_H)};
        pg8::gemm_phase<epi::SwiGLU, moe::MoeOrder, true>(ldsl, g, S, E);
    }
    else if constexpr (PH >= 12 && PH < 20 && (PH & 1) == 0) {
        constexpr int q = (PH - 12) / 2;
        const int NT = __hip_atomic_load((const int*)(ws + WS_CNT) + 128, __ATOMIC_RELAXED, __HIP_MEMORY_SCOPE_AGENT);
        pg8::Gemm g{(const bf16_t*)(ws + WS_H), (const bf16_t*)(ws + WS_WD), 256, nullptr};
        moe::MoeOrder S{(const int*)(ws + WS_TILEE), NT, C.G, C.bid, 1, 4, q};
        epi::Down E{(bf16_t*)(ws + WS_Y)};
        pg8::gemm_phase<epi::Down, moe::MoeOrder, false>(ldsl, g, S, E);
    }
    else if constexpr (PH >= 12 && PH < 20 && (PH & 1) == 1) {
        constexpr int q = (PH - 13) / 2;
        moe::combine_phase<q == 3>(p, C, q);
    }
}


__global__ void __launch_bounds__(512, 2) mega_fwd(Params p) {
    extern __shared__ __attribute__((aligned(16))) unsigned char lds[];
    cg::grid_group grid = cg::this_grid();
    volatile LAS unsigned* xst = (volatile LAS unsigned*)((LAS unsigned char*)lds + LDS_BYTES - 16);
    if (threadIdx.x < 4) xst[threadIdx.x] = 0u;
    __syncthreads();
    const XcdBarrier xbar = xcd_barrier_post((unsigned*)(p.ws + WS_BAR), xst);
#define GSYNC() xcd_barrier(xbar)
    run_phase<0>(p, lds); grid.sync();
#ifdef PROBE_REP0
    run_phase<0>(p, lds); GSYNC();
#endif
    run_phase<1>(p, lds); GSYNC();
#ifdef PROBE_REP1
    run_phase<1>(p, lds); GSYNC();
#endif
    run_phase<2>(p, lds); GSYNC();
#ifdef PROBE_REP2
    run_phase<2>(p, lds); GSYNC();
#endif
    run_phase<20>(p, lds); GSYNC();
#ifdef PROBE_REP3
    run_phase<22>(p, lds); __syncthreads();
#endif
    run_phase<3>(p, lds); __syncthreads();
    run_phase<4>(p, lds); GSYNC();
#ifdef PROBE_REP4
    run_phase<4>(p, lds); GSYNC();
#endif
    run_phase<5>(p, lds); __syncthreads();
    run_phase<6>(p, lds); GSYNC();
#ifdef PROBE_REP6
    run_phase<6>(p, lds); GSYNC();
#endif
    run_phase<7>(p, lds); GSYNC();
    run_phase<8>(p, lds); GSYNC();
#ifdef PROBE_REP9
    run_phase<23>(p, lds); GSYNC();
#endif
    run_phase<9>(p, lds); GSYNC();
    run_phase<10>(p, lds); GSYNC();
    run_phase<11>(p, lds); GSYNC();
#ifdef PROBE_REP11
    run_phase<11>(p, lds); GSYNC();
#endif
    run_phase<12>(p, lds); GSYNC();
#ifdef PROBE_REP12
    run_phase<12>(p, lds); GSYNC();
#endif
    run_phase<13>(p, lds); GSYNC();
    run_phase<14>(p, lds); GSYNC();
    run_phase<15>(p, lds); GSYNC();
    run_phase<16>(p, lds); GSYNC();
    run_phase<17>(p, lds); GSYNC();
    run_phase<18>(p, lds); GSYNC();
#ifdef PROBE_SYNC20
    for (int i = 0; i < 20; ++i) GSYNC();
#endif
    run_phase<19>(p, lds);
}

extern "C" void kernel_launch(void* const* d_in, const int* in_sizes, int n_in, void* d_out, int out_size, void* d_ws, size_t ws_size, hipStream_t stream) {
    static int grid = 0;
    if (grid == 0) {
        if (n_in != 35 || out_size != NTOK * DM || ws_size < WS_END) { fprintf(stderr, "kernel_launch: unexpected shapes: n_in %d out %d ws %zu\n", n_in, out_size, ws_size); grid = -1; return; }
        int dev = 0, cus = 0, per_cu = 0; (void)hipGetDevice(&dev); (void)hipDeviceGetAttribute(&cus, hipDeviceAttributeMultiprocessorCount, dev);
        if (hipFuncSetAttribute((const void*)mega_fwd, hipFuncAttributeMaxDynamicSharedMemorySize, LDS_BYTES) != hipSuccess) { fprintf(stderr, "kernel_launch: hipFuncSetAttribute failed\n"); grid = -1; return; }
        if (hipOccupancyMaxActiveBlocksPerMultiprocessor(&per_cu, (const void*)mega_fwd, 512, LDS_BYTES) != hipSuccess || per_cu < 1) { fprintf(stderr, "kernel_launch: occupancy query failed (%d)\n", per_cu); grid = -1; return; }
        grid = cus * 1;
    }
    if (grid < 0) return;
    Params p{};
    for (int i = 0; i < 35; ++i) p.in[i] = (const float*)d_in[i];
    p.out = (float*)d_out; p.ws = (unsigned char*)d_ws;
    (void)hipMemsetAsync((char*)d_ws + WS_ZERO, 0, WS_ZERO_BYTES, stream);
    void* args[] = {&p};
    hipError_t e = hipLaunchCooperativeKernel((const void*)mega_fwd, dim3(grid), dim3(512), args, LDS_BYTES, stream);
    if (e != hipSuccess) fprintf(stderr, "cooperative launch failed: %s (grid %d)\n", hipGetErrorString(e), grid);
}
```

```cpp
#include <hip/hip_runtime.h>
#include <hip/hip_cooperative_groups.h>
#include <cstdio>
#include <cstdint>
#include <cmath>
namespace cg = cooperative_groups;

#define LAS __attribute__((address_space(3)))
typedef unsigned short bf16_t;
typedef short bf16x8 __attribute__((ext_vector_type(8)));
typedef short s16x4 __attribute__((ext_vector_type(4)));
typedef float f32x2 __attribute__((ext_vector_type(2)));
typedef float f32x4 __attribute__((ext_vector_type(4)));
typedef float f32x8 __attribute__((ext_vector_type(8)));
typedef float f32x16 __attribute__((ext_vector_type(16)));
typedef unsigned u32x2 __attribute__((ext_vector_type(2)));
typedef unsigned u32x4 __attribute__((ext_vector_type(4)));

constexpr int NB = 8, SEQ = 4096, DM = 1024, NTOK = NB * SEQ, CTXL = 256, NCTX = NB * CTXL, MROWS = NTOK + NCTX  , LKV = SEQ + CTXL  ;
constexpr int INW = 8192, NEXP = 64, EH = 256;
constexpr int PMAX_TILES = 1087 + 128;
constexpr float NORM_EPS = 1e-6f;

constexpr size_t MiB = 1u << 20;
constexpr size_t WS_MOD = 0;
constexpr size_t WS_CMOD = 256 * 1024;
constexpr size_t WS_LAM = 320 * 1024;
constexpr size_t WS_HDN = 1 * MiB;
constexpr size_t WS_ZERO = 2 * MiB, WS_ZERO_BYTES = 3 * MiB;
constexpr size_t WS_CNT = 2 * MiB;
constexpr size_t WS_TILEE = 2 * MiB + 65536;
constexpr size_t WS_BAR = 2 * MiB + 131072;
constexpr size_t WS_ROWTOK = 3 * MiB;
constexpr size_t WS_POS = 5 * MiB;
constexpr size_t WS_WSEL = 6 * MiB;
constexpr size_t WS_EIDX = 7 * MiB;
constexpr size_t WS_WIN = 8 * MiB;
constexpr size_t WS_WPA = 24 * MiB, WS_WPH = 26 * MiB, WS_WOUT = 28 * MiB;
constexpr size_t WS_HX = 32 * MiB;
constexpr size_t WS_Q = 100 * MiB;
constexpr size_t WS_K = 164 * MiB;
constexpr size_t WS_V = 232 * MiB;
constexpr size_t WS_UT = 300 * MiB;
constexpr size_t WS_H = 100 * MiB;
constexpr size_t WS_Y = 252 * MiB;
constexpr size_t WS_WGU = 414 * MiB;
constexpr size_t WS_WD = 479 * MiB;
constexpr size_t WS_END = 512 * MiB;
static_assert(WS_WD + (size_t)65 * 1024 * 256 * 2 <= WS_END && WS_Y + (size_t)PMAX_TILES * 256 * 512 <= WS_WGU && WS_H + (size_t)PMAX_TILES * 256 * 512 <= WS_Y, "ws map");

struct Params { const float* in[35]; float* out; unsigned char* ws; };
enum { I_X = 0, I_C, I_CTX, I_CCTX, I_ADAW, I_ADAB, I_N1G, I_N2G, I_WIN, I_LQ1, I_LK1, I_LQ2, I_LK2, I_SUBG, I_HCW, I_HCB, I_FW1, I_FB1, I_FFR, I_FW2, I_FB2, I_FW3, I_HYB,
       I_WPA, I_WPH, I_WOUT, I_RW, I_RB, I_EG, I_EU, I_ED, I_SG, I_SU, I_SD, I_FNG };

__device__ __forceinline__ unsigned cvt_pk_bf16(float lo, float hi) { unsigned r; asm volatile("v_cvt_pk_bf16_f32 %0, %1, %2" : "=v"(r) : "v"(lo), "v"(hi)); return r; }
__device__ __forceinline__ float bf2f(unsigned short h) { return __uint_as_float(((unsigned)h) << 16); }
__device__ __forceinline__ float bflo(unsigned w) { return __uint_as_float(w << 16); }
__device__ __forceinline__ float bfhi(unsigned w) { return __uint_as_float(w & 0xffff0000u); }
__device__ __forceinline__ float wave_sum(float v) {
#pragma unroll
    for (int o = 1; o < 64; o <<= 1) v += __shfl_xor(v, o);
    return v;
}
__device__ __forceinline__ float sigmoidf_(float x) { return 1.f / (1.f + __expf(-x)); }
namespace pg8 {
constexpr int BM = 256, BK = 64, HALF = 128, HTB = HALF * BK * 2  , STAGE_BYTES = 8 * HTB, NXCD = 8, WGM = 8;

__host__ __device__ __forceinline__ int lds_byte(int r, int c) { const int st = (r >> 4) * 2 + (c >> 5), rr = r & 15, cc = c & 31, ob = rr * 64 + cc * 2; return st * 1024 + (ob ^ (((ob >> 9) & 1) << 5)); }
__host__ __device__ __forceinline__ void stage_rc(int b, int& R, int& C) { const int st = b / 1024, sb = b % 1024, swz = sb ^ (((sb >> 9) & 1) << 5); R = (st >> 1) * 16 + swz / 64; C = (st & 1) * 32 + (swz % 64) / 2; }
__host__ __device__ __forceinline__ int perm32(int rho) { const int n = rho >> 4, i = rho & 15; return 8 * (i >> 2) + 4 * n + (i & 3); }

struct Unit { int pm, pn; };
struct Gemm { const bf16_t* A; const bf16_t* Bt; int K; const int* rowidx; };

struct StaticOrder {
    int nM, nN, nwg, G, c;
    __device__ void init(int M, int N, int G_, int c_) { nM = M / BM; nN = N / BM; nwg = nM * nN; G = G_; c = c_; }
    __device__ bool next(int i, Unit& u) const {
        const long L = (long)i * G + c; if (L >= nwg) return false;
        int wgid = (int)L; { const int q = nwg / NXCD, r = nwg % NXCD, xcd = wgid % NXCD, off = wgid / NXCD; wgid = (xcd < r ? xcd * (q + 1) : r * (q + 1) + (xcd - r) * q) + off; }
        const int nig = WGM * nN, gid = wgid / nig, fm = gid * WGM, gsz = (nM - fm) < WGM ? (nM - fm) : WGM;
        u.pm = fm + ((wgid % nig) % gsz); u.pn = (wgid % nig) / gsz; return true;
    }
};

template <class Epi, class Sched, bool GATHER>
__device__ __forceinline__ void gemm_phase(LAS unsigned char* lds, const Gemm g, const Sched& S, const Epi& E) {
    int tid_ = threadIdx.x; asm volatile("" : "+v"(tid_));
    const int tid = tid_, wid = __builtin_amdgcn_readfirstlane(tid >> 6), lane = tid & 63, wr = wid >> 2, wc = wid & 3, fr = lane & 15, fq = lane >> 4;
    const int K = g.K, nt = K / BK;
    int sR[2], sC[2];
    unsigned voffB[2];
#pragma unroll
    for (int i = 0; i < 2; ++i) { int R, C; stage_rc(tid * 16 + i * 8192, R, C); sR[i] = R; sC[i] = C; const int Rb = (R & ~31) + perm32(R & 31); voffB[i] = (unsigned)(Rb * K + C) * 2u; }
    const size_t kstep = (size_t)(BK * 2);
    const size_t hstep = (size_t)HALF * K * 2;
    const size_t tstep = 2 * hstep;
    const unsigned ldsw = (unsigned)wid * 1024u;
    const int aoff = lds_byte(wr * 64 + fr, fq * 8), boff = lds_byte(wc * 32 + fr, fq * 8);
#define PG8_SA(b, h) (((b) * 2 + (h)) * HTB)
#define PG8_SB(b, h) ((4 + (b) * 2 + (h)) * HTB)
#define PG8_STAGEB(bufoff, gbase) do { _Pragma("unroll") for (int _i = 0; _i < 2; ++_i) \
        __builtin_amdgcn_global_load_lds((const unsigned*)((const char*)(gbase) + voffB[_i]), (LAS unsigned*)(lds + (bufoff) + ldsw + _i * 8192), 16, 0, 0); } while (0)
#define PG8_STAGEA(bufoff, gbase, v0, v1) do { \
        __builtin_amdgcn_global_load_lds((const unsigned*)((const char*)(gbase) + (v0)), (LAS unsigned*)(lds + (bufoff) + ldsw), 16, 0, 0); \
        __builtin_amdgcn_global_load_lds((const unsigned*)((const char*)(gbase) + (v1)), (LAS unsigned*)(lds + (bufoff) + ldsw + 8192), 16, 0, 0); } while (0)
#define PG8_LDA(dst, b, h) do { _Pragma("unroll") for (int m = 0; m < 4; ++m) _Pragma("unroll") for (int k = 0; k < 2; ++k) dst[m][k] = *(const LAS bf16x8*)(lds + PG8_SA(b, h) + aoff + m * 2048 + k * 1024); } while (0)
#define PG8_LDB(dst, b, h) do { _Pragma("unroll") for (int n = 0; n < 2; ++n) _Pragma("unroll") for (int k = 0; k < 2; ++k) dst[n][k] = *(const LAS bf16x8*)(lds + PG8_SB(b, h) + boff + n * 2048 + k * 1024); } while (0)
#define PG8_MMA(ai, bj, At, Bt) do { __builtin_amdgcn_s_setprio(1); _Pragma("unroll") for (int m = 0; m < 4; ++m) _Pragma("unroll") for (int n = 0; n < 2; ++n) _Pragma("unroll") for (int k = 0; k < 2; ++k) \
        acc[ai][bj][m][n] = __builtin_amdgcn_mfma_f32_16x16x32_bf16(Bt[n][k], At[m][k], acc[ai][bj][m][n], 0, 0, 0); __builtin_amdgcn_s_setprio(0); } while (0)
#define PG8_WAIT_V(n) asm volatile("s_waitcnt vmcnt(" #n ")" ::: "memory")
#define PG8_WAIT_L(n) asm volatile("s_waitcnt lgkmcnt(" #n ")" ::: "memory")
#define PG8_BAR __builtin_amdgcn_s_barrier()
#define PG8_SCHED __builtin_amdgcn_sched_barrier(0)
    Unit cur, nxt; int ui = 0;
    if (!S.next(0, cur)) return;
    f32x4 acc[2][2][4][2];
#pragma unroll
    for (int a = 0; a < 2; ++a)
#pragma unroll
        for (int b = 0; b < 2; ++b)
#pragma unroll
            for (int m = 0; m < 4; ++m)
#pragma unroll
                for (int n = 0; n < 2; ++n) acc[a][b][m][n] = (f32x4){0.f, 0.f, 0.f, 0.f};
    bf16x8 At[4][2], B0[2][2], B1[2][2];
    unsigned vA[2][2], vN[2][2];
    const char* cA; const char* cB = (const char*)g.Bt + (size_t)cur.pn * tstep;
    if constexpr (GATHER) {
        cA = (const char*)g.A;
#pragma unroll
        for (int h = 0; h < 2; ++h)
#pragma unroll
            for (int i = 0; i < 2; ++i) vA[h][i] = ((unsigned)__hip_atomic_load(g.rowidx + cur.pm * BM + h * HALF + sR[i], __ATOMIC_RELAXED, __HIP_MEMORY_SCOPE_AGENT) * (unsigned)K + (unsigned)sC[i]) * 2u;
    } else {
        cA = (const char*)g.A + (size_t)cur.pm * tstep;
#pragma unroll
        for (int h = 0; h < 2; ++h)
#pragma unroll
            for (int i = 0; i < 2; ++i) vA[h][i] = (unsigned)(sR[i] * K + sC[i]) * 2u + (unsigned)(h * hstep);
    }
    PG8_STAGEB(PG8_SB(0, 0), cB); PG8_STAGEB(PG8_SB(0, 1), cB + hstep); PG8_STAGEA(PG8_SA(0, 0), cA, vA[0][0], vA[0][1]); PG8_STAGEA(PG8_SA(0, 1), cA, vA[1][0], vA[1][1]);
    if (wr == 1) PG8_BAR;
    PG8_WAIT_V(2); PG8_BAR;
    PG8_STAGEB(PG8_SB(1, 0), cB + kstep); PG8_STAGEA(PG8_SA(1, 0), cA + kstep, vA[0][0], vA[0][1]); PG8_STAGEB(PG8_SB(1, 1), cB + hstep + kstep);
    PG8_WAIT_V(6); PG8_BAR;
    for (;;) {
        const bool has_next = S.next(ui + 1, nxt);
        const char* nA; const char* nB = has_next ? (const char*)g.Bt + (size_t)nxt.pn * tstep : cB;
        if constexpr (GATHER) {
            nA = cA;
            if (has_next) {
#pragma unroll
                for (int h = 0; h < 2; ++h)
#pragma unroll
                    for (int i = 0; i < 2; ++i) vN[h][i] = ((unsigned)__hip_atomic_load(g.rowidx + nxt.pm * BM + h * HALF + sR[i], __ATOMIC_RELAXED, __HIP_MEMORY_SCOPE_AGENT) * (unsigned)K + (unsigned)sC[i]) * 2u;
            } else {
#pragma unroll
                for (int h = 0; h < 2; ++h)
#pragma unroll
                    for (int i = 0; i < 2; ++i) vN[h][i] = vA[h][i];
            }
        } else {
            nA = has_next ? (const char*)g.A + (size_t)nxt.pm * tstep : cA;
#pragma unroll
            for (int h = 0; h < 2; ++h)
#pragma unroll
                for (int i = 0; i < 2; ++i) vN[h][i] = vA[h][i];
        }
#pragma unroll 1
        for (int t = 0; t < nt; t += 2) {
            const bool last = (t == nt - 2);
            const char* a1 = cA + (size_t)(t + 1) * kstep;
            const char* a2 = last ? nA : cA + (size_t)(t + 2) * kstep; const char* b2 = last ? nB : cB + (size_t)(t + 2) * kstep;
            const char* a3 = a2 + kstep; const char* b3 = b2 + kstep;
            const unsigned w00 = last ? vN[0][0] : vA[0][0], w01 = last ? vN[0][1] : vA[0][1], w10 = last ? vN[1][0] : vA[1][0], w11 = last ? vN[1][1] : vA[1][1];
            PG8_LDB(B0, 0, 0); PG8_LDB(B1, 0, 1); PG8_SCHED; PG8_LDA(At, 0, 0); PG8_STAGEA(PG8_SA(1, 1), a1, vA[1][0], vA[1][1]);
            PG8_WAIT_V(8); PG8_WAIT_L(0); PG8_BAR; PG8_MMA(0, 0, At, B0); PG8_MMA(0, 1, At, B1); PG8_BAR; PG8_SCHED;
            PG8_LDA(At, 0, 1); PG8_STAGEB(PG8_SB(0, 0), b2); PG8_STAGEB(PG8_SB(0, 1), b2 + hstep); PG8_STAGEA(PG8_SA(0, 0), a2, w00, w01);
            PG8_WAIT_V(8); PG8_WAIT_L(0); PG8_BAR; PG8_MMA(1, 0, At, B0); PG8_MMA(1, 1, At, B1); PG8_BAR; PG8_SCHED;
            PG8_LDB(B0, 1, 0); PG8_LDB(B1, 1, 1); PG8_SCHED; PG8_LDA(At, 1, 0); PG8_STAGEA(PG8_SA(0, 1), a2, w10, w11);
            PG8_WAIT_V(8); PG8_WAIT_L(0); PG8_BAR; PG8_MMA(0, 0, At, B0); PG8_MMA(0, 1, At, B1); PG8_BAR; PG8_SCHED;
            PG8_LDA(At, 1, 1); PG8_STAGEB(PG8_SB(1, 0), b3); PG8_STAGEB(PG8_SB(1, 1), b3 + hstep); PG8_STAGEA(PG8_SA(1, 0), a3, w00, w01);
            PG8_WAIT_V(8); PG8_WAIT_L(0); PG8_BAR; PG8_MMA(1, 0, At, B0); PG8_MMA(1, 1, At, B1); PG8_BAR; PG8_SCHED;
        }
        if (wr == 0) PG8_BAR;
        E(acc, cur, wr, wc, fr, fq);
        if (!has_next) break;
#pragma unroll
        for (int a = 0; a < 2; ++a)
#pragma unroll
            for (int b = 0; b < 2; ++b)
#pragma unroll
                for (int m = 0; m < 4; ++m)
#pragma unroll
                    for (int n = 0; n < 2; ++n) acc[a][b][m][n] = (f32x4){0.f, 0.f, 0.f, 0.f};
        cur = nxt; cA = nA; cB = nB; ++ui;
#pragma unroll
        for (int h = 0; h < 2; ++h)
#pragma unroll
            for (int i = 0; i < 2; ++i) vA[h][i] = vN[h][i];
        if (wr == 1) PG8_BAR;
    }
    PG8_WAIT_V(0);
    PG8_BAR;
#undef PG8_SA
#undef PG8_SB
#undef PG8_STAGEA
#undef PG8_STAGEB
#undef PG8_LDA
#undef PG8_LDB
#undef PG8_MMA
#undef PG8_WAIT_V
#undef PG8_WAIT_L
#undef PG8_BAR
#undef PG8_SCHED
}
}
namespace epi {
using pg8::Unit;
__device__ __forceinline__ u32x4 pack8(const f32x4 v0, const f32x4 v1) { u32x4 w; w.x = cvt_pk_bf16(v0[0], v0[1]); w.y = cvt_pk_bf16(v0[2], v0[3]); w.z = cvt_pk_bf16(v1[0], v1[1]); w.w = cvt_pk_bf16(v1[2], v1[3]); return w; }

struct InProj {
    bf16_t* Q; bf16_t* Kall; bf16_t* Vall; bf16_t* UT; bf16_t* G;
    __device__ __forceinline__ void operator()(const f32x4 (&acc)[2][2][4][2], const Unit& u, int wr, int wc, int fr, int fq) const {
        const int pn = u.pn; const int row0 = u.pm * 256 + wr * 64 + fr; const int cw = wc * 32 + 8 * fq;
        if (pn < 12 && !(pn >= 4 && pn < 8)) {
            const bool isq = pn >= 8; const int colt = (isq ? pn - 8 : pn) * 256;
            float inv[4];
#pragma unroll
            for (int j = 0; j < 4; ++j) inv[j] = exp2f(-(float)(4 * fq + j) * 0.8304820237218406f);
            const int axis = wc & 1;
#pragma unroll
            for (int ai = 0; ai < 2; ++ai)
#pragma unroll
                for (int m = 0; m < 4; ++m) {
                    const int row = row0 + ai * 128 + m * 16;
                    bf16_t* dst; bool rope;
                    if (row < NTOK) { const int b = row >> 12, t = row & 4095; rope = true;
                        dst = isq ? Q + (size_t)row * DM : Kall + ((size_t)b * LKV + t) * DM; }
                    else { const int rc = row - NTOK, b = rc >> 8, j = rc & 255; rope = false; dst = Kall + ((size_t)b * LKV + SEQ + j) * DM; }
                    const int t = row & 4095; const float pos = (float)(axis ? (t & 63) : (t >> 6));
#pragma unroll
                    for (int bj = 0; bj < 2; ++bj) {
                        f32x4 x1 = acc[ai][bj][m][0], x2 = acc[ai][bj][m][1], o1, o2;
                        if (rope) {
#pragma unroll
                            for (int j = 0; j < 4; ++j) { const float a = pos * inv[j]; const float c = __cosf(a), s = __sinf(a); o1[j] = x1[j] * c - x2[j] * s; o2[j] = x2[j] * c + x1[j] * s; }
                        } else { o1 = x1; o2 = x2; }
                        *(u32x4*)(dst + colt + bj * 128 + cw) = pack8(o1, o2);
                    }
                }
        } else if (pn < 8) {
            const int colt = (pn - 4) * 256;
#pragma unroll
            for (int ai = 0; ai < 2; ++ai)
#pragma unroll
                for (int m = 0; m < 4; ++m) {
                    const int row = row0 + ai * 128 + m * 16; bf16_t* dst;
                    if (row < NTOK) { const int b = row >> 12, t = row & 4095; dst = Vall + ((size_t)b * LKV + t) * DM; }
                    else { const int rc = row - NTOK, b = rc >> 8, j = rc & 255; dst = Vall + ((size_t)b * LKV + SEQ + j) * DM; }
#pragma unroll
                    for (int bj = 0; bj < 2; ++bj) *(u32x4*)(dst + colt + bj * 128 + cw) = pack8(acc[ai][bj][m][0], acc[ai][bj][m][1]);
                }
        } else if (pn < 24) {
            const int ch0 = (pn - 12) * 256 + cw;
#pragma unroll
            for (int ai = 0; ai < 2; ++ai)
#pragma unroll
                for (int m = 0; m < 4; ++m) {
                    const int row = row0 + ai * 128 + m * 16; const int b = row >> 12, t = row & 4095;
                    bf16_t* dst = UT + ((size_t)b * 3072 + ch0) * SEQ + t;
#pragma unroll
                    for (int bj = 0; bj < 2; ++bj)
#pragma unroll
                        for (int n = 0; n < 2; ++n)
#pragma unroll
                            for (int j = 0; j < 4; ++j) dst[(size_t)(bj * 128 + n * 4 + j) * SEQ] = (bf16_t)(cvt_pk_bf16(acc[ai][bj][m][n][j], 0.f) & 0xffffu);
                }
        } else {
            const int colt = (pn - 24) * 256;
#pragma unroll
            for (int ai = 0; ai < 2; ++ai)
#pragma unroll
                for (int m = 0; m < 4; ++m) {
                    const int row = row0 + ai * 128 + m * 16; bf16_t* dst = G + (size_t)row * 2048 + colt + cw;
#pragma unroll
                    for (int bj = 0; bj < 2; ++bj) { f32x4 a = acc[ai][bj][m][0], c = acc[ai][bj][m][1];
#pragma unroll
                        for (int j = 0; j < 4; ++j) { a[j] = sigmoidf_(a[j]); c[j] = sigmoidf_(c[j]); }
                        *(u32x4*)(dst + bj * 128) = pack8(a, c); }
                }
        }
    }
};

template <int MODE> struct Merge {
    const bf16_t* G; bf16_t* T1;
    __device__ __forceinline__ void operator()(const f32x4 (&acc)[2][2][4][2], const Unit& u, int wr, int wc, int fr, int fq) const {
        const int row0 = u.pm * 256 + wr * 64 + fr; const int col0 = u.pn * 256 + wc * 32 + 8 * fq;
#pragma unroll
        for (int ai = 0; ai < 2; ++ai)
#pragma unroll
            for (int m = 0; m < 4; ++m) {
                const int row = row0 + ai * 128 + m * 16;
#pragma unroll
                for (int bj = 0; bj < 2; ++bj) {
                    const int col = col0 + bj * 128;
                    const u32x4 gw = *(const u32x4*)(G + (size_t)row * 2048 + MODE * 1024 + col);
                    f32x4 a = acc[ai][bj][m][0], c = acc[ai][bj][m][1];
                    a[0] *= bflo(gw.x); a[1] *= bfhi(gw.x); a[2] *= bflo(gw.y); a[3] *= bfhi(gw.y);
                    c[0] *= bflo(gw.z); c[1] *= bfhi(gw.z); c[2] *= bflo(gw.w); c[3] *= bfhi(gw.w);
                    bf16_t* tp = T1 + (size_t)row * DM + col;
                    if (MODE == 1) { const u32x4 tw = *(const u32x4*)tp;
                        a[0] += bflo(tw.x); a[1] += bfhi(tw.x); a[2] += bflo(tw.y); a[3] += bfhi(tw.y);
                        c[0] += bflo(tw.z); c[1] += bfhi(tw.z); c[2] += bflo(tw.w); c[3] += bfhi(tw.w); }
                    *(u32x4*)tp = pack8(a, c);
                }
            }
    }
};

struct OutProj {
    const float* x; const float* mod; float* xnew;
    __device__ __forceinline__ void operator()(const f32x4 (&acc)[2][2][4][2], const Unit& u, int wr, int wc, int fr, int fq) const {
        const int row0 = u.pm * 256 + wr * 64 + fr; const int col0 = u.pn * 256 + wc * 32 + 8 * fq;
#pragma unroll
        for (int ai = 0; ai < 2; ++ai)
#pragma unroll
            for (int m = 0; m < 4; ++m) {
                const int row = row0 + ai * 128 + m * 16; const int b = row >> 12;
#pragma unroll
                for (int bj = 0; bj < 2; ++bj) {
                    const int col = col0 + bj * 128; const size_t off = (size_t)row * DM + col;
                    const float* gp = mod + b * 6144 + 2048 + col;
#pragma unroll
                    for (int n = 0; n < 2; ++n) { const f32x4 xv = *(const f32x4*)(x + off + 4 * n), gv = *(const f32x4*)(gp + 4 * n);
                        *(f32x4*)(xnew + off + 4 * n) = xv + gv * acc[ai][bj][m][n]; }
                }
            }
    }
};

struct SwiGLU {
    bf16_t* H;
    __device__ __forceinline__ void operator()(const f32x4 (&acc)[2][2][4][2], const Unit& u, int wr, int wc, int fr, int fq) const {
        const int row0 = u.pm * 256 + wr * 64 + fr; const int j = u.pn & 1;
#pragma unroll
        for (int ai = 0; ai < 2; ++ai)
#pragma unroll
            for (int m = 0; m < 4; ++m) {
                const int row = row0 + ai * 128 + m * 16;
#pragma unroll
                for (int bj = 0; bj < 2; ++bj) {
                    const int gi = 16 * bj + 4 * wc + fq;
                    const f32x4 g = acc[ai][bj][m][0], up = acc[ai][bj][m][1]; f32x4 h;
#pragma unroll
                    for (int q = 0; q < 4; ++q) h[q] = g[q] * sigmoidf_(g[q]) * up[q];
                    u32x2 w; w.x = cvt_pk_bf16(h[0], h[1]); w.y = cvt_pk_bf16(h[2], h[3]);
                    *(u32x2*)(H + (size_t)row * EH + 128 * j + 4 * gi) = w;
                }
            }
    }
};

struct Down {
    bf16_t* Y;
    __device__ __forceinline__ void operator()(const f32x4 (&acc)[2][2][4][2], const Unit& u, int wr, int wc, int fr, int fq) const {
        const int row0 = u.pm * 256 + wr * 64 + fr; const int col0 = wc * 32 + 8 * fq;
#pragma unroll
        for (int ai = 0; ai < 2; ++ai)
#pragma unroll
            for (int m = 0; m < 4; ++m) {
                const int row = row0 + ai * 128 + m * 16;
#pragma unroll
                for (int bj = 0; bj < 2; ++bj) *(u32x4*)(Y + (size_t)row * 256 + col0 + bj * 128) = pack8(acc[ai][bj][m][0], acc[ai][bj][m][1]);
            }
    }
};
}
struct Ctx { int tid, lane, wave, G, bid; unsigned char* ws; };

__device__ __forceinline__ void adaln_phase(const Params& p, const Ctx& C, char* lds) {
    float* s = (float*)lds;
    float* red = (float*)(lds + 9 * 1024 * 4);
    const float* c = p.in[I_C]; const float* cc = p.in[I_CCTX]; const float* W = p.in[I_ADAW]; const float* bias = p.in[I_ADAB];
    float* mod = (float*)(C.ws + WS_MOD); float* cmod = (float*)(C.ws + WS_CMOD);
    if (C.bid < 192) {
        for (int i = C.tid; i < 9 * 1024; i += 512) { const int b = i >> 10, k = i & 1023; const float v = b < 8 ? c[b * 1024 + k] : cc[k]; s[i] = v / (1.f + expf(-v)); }
        __syncthreads();
    }
    for (int item = C.bid; item < 192; item += C.G) {
        const int cl = C.tid & 31, kg = C.tid >> 5, col = item * 32 + cl;
        float acc[9];
#pragma unroll
        for (int b = 0; b < 9; ++b) acc[b] = 0.f;
        for (int k = kg; k < 1024; k += 16) { const float w = W[(size_t)k * 6144 + col];
#pragma unroll
            for (int b = 0; b < 9; ++b) acc[b] += s[b * 1024 + k] * w; }
#pragma unroll
        for (int b = 0; b < 9; ++b) red[(kg * 9 + b) * 32 + cl] = acc[b];
        __syncthreads();
        if (C.tid < 9 * 32) { const int b = C.tid >> 5, c2 = C.tid & 31, col2 = item * 32 + c2; float v = 0.f;
            for (int q = 0; q < 16; ++q) v += red[(q * 9 + b) * 32 + c2];
            v += bias[col2];
            if (b < 8) mod[b * 6144 + col2] = v; else if (col2 < 2048) cmod[col2] = v; }
        __syncthreads();
    }
    if (C.bid == (C.G > 200 ? 200 : 0) && C.tid < 64) {
        const float a = wave_sum(p.in[I_LQ1][C.tid] * p.in[I_LK1][C.tid]), b = wave_sum(p.in[I_LQ2][C.tid] * p.in[I_LK2][C.tid]);
        if (C.tid == 0) *(float*)(C.ws + WS_LAM) = expf(a) - expf(b) + 0.2f;
    }
}

__device__ __forceinline__ void hdn_phase(const Params& p, const Ctx& C) {
    const float* w1 = p.in[I_FW1]; const float* b1 = p.in[I_FB1]; const float* fr = p.in[I_FFR]; const float* w2 = p.in[I_FW2]; const float* b2 = p.in[I_FB2];
    float* hdn = (float*)(C.ws + WS_HDN);
    const int gw = C.bid * 8 + C.wave, NGW = C.G * 8, l = C.lane;
    for (int t = gw; t < SEQ; t += NGW) {
        float z = 0.f;
        if (l == 0) z = (float)((double)t / 4095.0);
        else if (l < 33) { const int bi = (l - 1) & 15; const double band = 1e-4 + (double)bi * ((15.0 - 1e-4) / 15.0); const double w = 6.283185307179586476925 * (double)t / 4096.0; const double a = band * w;
            z = (l < 17) ? (float)cos(a) : (float)(-sin(a)); }
        float h = b1[l];
        for (int i = 0; i < 33; ++i) h += __shfl(z, i) * w1[i * 64 + l];
        h = sinf(fr[l] * h);
        float h2 = b2[l];
        for (int i = 0; i < 64; ++i) h2 += __shfl(h, i) * w2[i * 64 + l];
        h2 = sinf(fr[l] * h2);
        hdn[t * 64 + l] = h2;
    }
}

__device__ __forceinline__ void transpose_item(const float* srcl, int ldw, bf16_t* dst, int K, float* scr, int lane) {
#pragma unroll 8
    for (int i = 0; i < 32; ++i) { const int kk = 2 * i + (lane >> 5); scr[kk * 33 + (lane & 31)] = srcl[(size_t)kk * ldw]; }
    asm volatile("s_waitcnt lgkmcnt(0)" ::: "memory");
    const int c = lane & 7;
#pragma unroll
    for (int j = 0; j < 4; ++j) { const int n = (lane >> 3) + 8 * j; const float* s = scr + (8 * c) * 33 + n;
        u32x4 o; o.x = cvt_pk_bf16(s[0 * 33], s[1 * 33]); o.y = cvt_pk_bf16(s[2 * 33], s[3 * 33]); o.z = cvt_pk_bf16(s[4 * 33], s[5 * 33]); o.w = cvt_pk_bf16(s[6 * 33], s[7 * 33]);
        *(u32x4*)(dst + (size_t)n * K + 8 * c) = o; }
    asm volatile("s_waitcnt lgkmcnt(0)" ::: "memory");
}
__device__ __forceinline__ int qk_src_col(int n) {
    const int blk = n & ~63, pp = n & 63, axis = pp >> 5, f = ((pp & 31) >> 3) * 4 + (pp & 3), half = (pp >> 2) & 1;
    return blk + axis * 32 + half * 16 + f;
}
__device__ __forceinline__ void wconv_mixer_phase(const Params& p, const Ctx& C, char* lds) {
    float* scr = (float*)(lds + C.wave * 16384);
    const int gw = C.bid * 8 + C.wave, NGW = C.G * 8, l31 = C.lane & 31;
    constexpr int I_IN = 16 * 256, I_SQ = 16 * 32, NIT = I_IN + 3 * I_SQ;
    for (int it = gw; it < NIT; it += NGW) {
        int r = it;
        if (r < I_IN) { const int kb = r / 256, nb = r % 256, k0 = 64 * kb, n0 = 32 * nb; const int n = n0 + l31;
            const int src = (n < 1024 || (n >= 2048 && n < 3072)) ? qk_src_col(n) : n;
            transpose_item(p.in[I_WIN] + (size_t)k0 * INW + src, INW, (bf16_t*)(C.ws + WS_WIN) + (size_t)n0 * 1024 + k0, 1024, scr, C.lane); continue; }
        r -= I_IN; const int which = r / I_SQ; r %= I_SQ;
        const float* W = which == 0 ? p.in[I_WPA] : which == 1 ? p.in[I_WPH] : p.in[I_WOUT];
        bf16_t* WT = (bf16_t*)(C.ws + (which == 0 ? WS_WPA : which == 1 ? WS_WPH : WS_WOUT));
        const int kb = r / 32, nb = r % 32, k0 = 64 * kb, n0 = 32 * nb;
        transpose_item(W + (size_t)k0 * 1024 + n0 + l31, 1024, WT + (size_t)n0 * 1024 + k0, 1024, scr, C.lane);
    }
}
__device__ __forceinline__ void wconv_moe_phase(const Params& p, const Ctx& C, char* lds) {
    float* scr = (float*)(lds + C.wave * 16384);
    const int gw = C.bid * 8 + C.wave, NGW = C.G * 8, l31 = C.lane & 31;
    constexpr int I_GU = 16 * 16, I_D = 4 * 32, NIT = 65 * (I_GU + I_D);
    for (int it = gw; it < NIT; it += NGW) {
        const int e = it / (I_GU + I_D); int r = it % (I_GU + I_D);
        if (r < I_GU) { const int kb = r / 16, nb = r % 16, k0 = 64 * kb, n0 = 32 * nb; const int n = n0 + l31;
            const int j = n >> 8, gi = (n & 255) >> 3, e8 = n & 7, i = 128 * j + 4 * gi + (e8 & 3);
            const float* mat = (e8 >> 2) ? (e < 64 ? p.in[I_EU] + (size_t)e * 1024 * 256 : p.in[I_SU]) : (e < 64 ? p.in[I_EG] + (size_t)e * 1024 * 256 : p.in[I_SG]);
            transpose_item(mat + (size_t)k0 * 256 + i, 256, (bf16_t*)(C.ws + WS_WGU) + ((size_t)e * 512 + n0) * 1024 + k0, 1024, scr, C.lane); continue; }
        r -= I_GU; const int kb = r / 32, nb = r % 32, k0 = 64 * kb, n0 = 32 * nb;
        const float* mat = e < 64 ? p.in[I_ED] + (size_t)e * 256 * 1024 : p.in[I_SD];
        transpose_item(mat + (size_t)k0 * 1024 + n0 + l31, 1024, (bf16_t*)(C.ws + WS_WD) + ((size_t)e * 1024 + n0) * 256 + k0, 256, scr, C.lane);
    }
}

__device__ __forceinline__ void hx_phase(const Params& p, const Ctx& C) {
    const float* mod = (const float*)(C.ws + WS_MOD); const float* cmod = (const float*)(C.ws + WS_CMOD); const float* g = p.in[I_N1G];
    bf16_t* HX = (bf16_t*)(C.ws + WS_HX);
    const int gw = C.bid * 8 + C.wave, NGW = C.G * 8;
    for (int r = gw; r < MROWS; r += NGW) {
        const float* xr; const float* sh; const float* sc;
        if (r < NTOK) { xr = p.in[I_X] + (size_t)r * DM; const int b = r >> 12; sh = mod + b * 6144; sc = sh + 1024; }
        else { xr = p.in[I_CTX] + (size_t)(r - NTOK) * DM; sh = cmod; sc = cmod + 1024; }
        f32x4 v[4]; float ss = 0.f;
#pragma unroll
        for (int j = 0; j < 4; ++j) { v[j] = *(const f32x4*)(xr + 256 * j + 4 * C.lane); ss += (v[j].x * v[j].x + v[j].y * v[j].y) + (v[j].z * v[j].z + v[j].w * v[j].w); }
        const float rn = 1.0f / sqrtf(wave_sum(ss) * (1.f / DM) + NORM_EPS);
#pragma unroll
        for (int j = 0; j < 4; ++j) { const int k = 256 * j + 4 * C.lane;
            const f32x4 gv = *(const f32x4*)(g + k), scv = *(const f32x4*)(sc + k), shv = *(const f32x4*)(sh + k);
            const f32x4 o = v[j] * rn * gv * (1.f + scv) + shv;
            u32x2 w; w.x = cvt_pk_bf16(o.x, o.y); w.y = cvt_pk_bf16(o.z, o.w);
            *(u32x2*)(HX + (size_t)r * DM + k) = w; }
    }
}
namespace att {
constexpr int KVBLK = 64, NT = LKV / KVBLK;
constexpr float SCALE = 0.125f, THR = 8.f;
constexpr int SHM_V = KVBLK * 128 * 2, SHM_K = KVBLK * 128 * 2;
#define KSWZ(row, colB) ((row) * 256 + ((colB) ^ (((row) & 7) << 4)))
#define SBAR() __builtin_amdgcn_sched_barrier(0)
__device__ __forceinline__ int crow(int r, int hi) { return (r & 3) + 8 * (r >> 2) + 4 * hi; }
__device__ __forceinline__ void partialSM(f32x16& p0, f32x16& p1, float& m_reg, float& mn, float& alpha) {
  constexpr float C = SCALE * 1.4426950408889634f;
  float pmax = p0[0];
#pragma unroll
  for (int r = 1; r < 16; ++r) pmax = fmaxf(pmax, p0[r]);
#pragma unroll
  for (int r = 0; r < 16; ++r) pmax = fmaxf(pmax, p1[r]);
  { auto rr = __builtin_amdgcn_permlane32_swap(__float_as_uint(pmax), __float_as_uint(pmax), false, false);
    pmax = fmaxf(__uint_as_float(rr[0]), __uint_as_float(rr[1])); }
  if (__builtin_expect(__all(pmax - m_reg <= THR / SCALE), 1)) { mn = m_reg; alpha = 1.f; }
  else { mn = fmaxf(m_reg, pmax); alpha = __builtin_amdgcn_exp2f((m_reg - mn) * C); m_reg = mn; }
  float mnC = -mn * C;
#pragma unroll
  for (int r = 0; r < 16; ++r) p0[r] = fmaf(p0[r], C, mnC);
#pragma unroll
  for (int r = 0; r < 16; ++r) p1[r] = fmaf(p1[r], C, mnC);
#pragma unroll
  for (int r = 0; r < 16; ++r) p0[r] = __builtin_amdgcn_exp2f(p0[r]);
}
__device__ __forceinline__ void finishSM(f32x16& p0, f32x16& p1, float alpha, float& l_reg, bf16x8& pa0, bf16x8& pa1, bf16x8& pa2, bf16x8& pa3) {
#pragma unroll
  for (int r = 0; r < 16; ++r) p1[r] = __builtin_amdgcn_exp2f(p1[r]);
  float ps = 0;
#pragma unroll
  for (int r = 0; r < 16; ++r) ps += p0[r];
#pragma unroll
  for (int r = 0; r < 16; ++r) ps += p1[r];
  { auto rr = __builtin_amdgcn_permlane32_swap(__float_as_uint(ps), __float_as_uint(ps), false, false);
    ps = __uint_as_float(rr[0]) + __uint_as_float(rr[1]); }
  l_reg = l_reg * alpha + ps;
#define PK4(P, BASE, OUT) do { unsigned a0 = cvt_pk_bf16(P[BASE + 0], P[BASE + 1]), a1 = cvt_pk_bf16(P[BASE + 2], P[BASE + 3]);   \
    unsigned b0 = cvt_pk_bf16(P[BASE + 4], P[BASE + 5]), b1 = cvt_pk_bf16(P[BASE + 6], P[BASE + 7]);                              \
    auto r0 = __builtin_amdgcn_permlane32_swap(a0, b0, false, false); auto r1 = __builtin_amdgcn_permlane32_swap(a1, b1, false, false); \
    u32x4 w = {r0[0], r1[0], r0[1], r1[1]}; OUT = *reinterpret_cast<bf16x8*>(&w); } while (0)
  PK4(p0, 0, pa0); PK4(p0, 8, pa1); PK4(p1, 0, pa2); PK4(p1, 8, pa3);
#undef PK4
}
__device__ __forceinline__ void qkt(f32x16& p0, f32x16& p1, const char* Ks, const bf16x8* qr, int r32, int hi, int mp) {
  p0 = f32x16{}; p1 = f32x16{};
#pragma unroll
  for (int d0 = 0; d0 < 4; ++d0) { const int cb = ((mp * 4 + d0) * 16 + hi * 8) * 2;
    const bf16x8 b0 = *reinterpret_cast<const bf16x8*>(Ks + KSWZ(r32, cb));
    const bf16x8 b1 = *reinterpret_cast<const bf16x8*>(Ks + KSWZ(32 + r32, cb));
    p0 = __builtin_amdgcn_mfma_f32_32x32x16_bf16(b0, qr[d0], p0, 0, 0, 0);
    p1 = __builtin_amdgcn_mfma_f32_32x32x16_bf16(b1, qr[d0], p1, 0, 0, 0); }
}
__device__ __forceinline__ int v_st(int k, int c) { const int kk = (k & ~0xC) | ((k & 4) << 1) | ((k & 8) >> 1); return ((kk >> 3) * 4 + (c >> 5)) * 512 + ((kk & 7) * 32 + (c & 31)) * 2; }
__device__ __forceinline__ int v_rd_base(int lane) { return ((lane & 3) << 3) | (((lane >> 2) & 3) << 6) | (((lane >> 4) & 1) << 5) | (((lane >> 5) & 1) << 8); }
constexpr int v_rd_off(int d0, int ks, int half) { return d0 * 512 + ks * 4096 + half * 2048; }
template <int OFF> __device__ __forceinline__ s16x4 tr_read(int vb) {
  s16x4 r; asm volatile("ds_read_b64_tr_b16 %0, %1 offset:%2" : "=&v"(r) : "v"(vb), "i"(OFF) : "memory"); return r;
}
template <int D0> __device__ __forceinline__ void pv_one(f32x16& od, int vb, bf16x8 pa0, bf16x8 pa1, bf16x8 pa2, bf16x8 pa3) {
  const s16x4 l0 = tr_read<v_rd_off(D0, 0, 0)>(vb), h0 = tr_read<v_rd_off(D0, 0, 1)>(vb), l1 = tr_read<v_rd_off(D0, 1, 0)>(vb), h1 = tr_read<v_rd_off(D0, 1, 1)>(vb);
  const s16x4 l2 = tr_read<v_rd_off(D0, 2, 0)>(vb), h2 = tr_read<v_rd_off(D0, 2, 1)>(vb), l3 = tr_read<v_rd_off(D0, 3, 0)>(vb), h3 = tr_read<v_rd_off(D0, 3, 1)>(vb);
  asm volatile("s_waitcnt lgkmcnt(0)" ::: "memory"); SBAR();
#define PK(L, H) (bf16x8){L[0], L[1], L[2], L[3], H[0], H[1], H[2], H[3]}
  od = __builtin_amdgcn_mfma_f32_32x32x16_bf16(pa0, PK(l0, h0), od, 0, 0, 0);
  od = __builtin_amdgcn_mfma_f32_32x32x16_bf16(pa1, PK(l1, h1), od, 0, 0, 0);
  od = __builtin_amdgcn_mfma_f32_32x32x16_bf16(pa2, PK(l2, h2), od, 0, 0, 0);
  od = __builtin_amdgcn_mfma_f32_32x32x16_bf16(pa3, PK(l3, h3), od, 0, 0, 0);
#undef PK
}
__device__ __forceinline__ void pv_d0(f32x16* o, int vb, bf16x8 pa0, bf16x8 pa1, bf16x8 pa2, bf16x8 pa3) {
  pv_one<0>(o[0], vb, pa0, pa1, pa2, pa3); pv_one<1>(o[1], vb, pa0, pa1, pa2, pa3); pv_one<2>(o[2], vb, pa0, pa1, pa2, pa3); pv_one<3>(o[3], vb, pa0, pa1, pa2, pa3);
}

__device__ __forceinline__ void attn_unit(const bf16_t* Qg, const bf16_t* Kall, const bf16_t* Vall, bf16_t* AX, float lam, const float* subg, int b, int h, int qb, char* lds) {
  constexpr int LDK = DM;
  int tid_ = threadIdx.x; asm volatile("" : "+v"(tid_));
  const int tid = tid_, wid = tid >> 6, lane = tid & 63, r32 = lane & 31, hi = lane >> 5, rg = wid & 3, mp = wid >> 2;
  char* V_lds = lds; char* K_lds = lds + 2 * SHM_V;
  float* wsf = (float*)(lds + 2 * SHM_V + 2 * SHM_K) + wid * 64; float* li_l = wsf; float* al_l = wsf + 32;
  const bf16_t* Kh = Kall + (size_t)b * LKV * DM + h * 128; const bf16_t* Vh = Vall + (size_t)b * LKV * DM + h * 128;
  float m_reg = -1e30f, l_reg = 0; f32x16 o[4] = {}; bf16x8 qr[4];
  const bf16_t* Qw = Qg + ((size_t)(b * SEQ + qb * 128 + rg * 32 + r32)) * DM + h * 128 + mp * 64 + hi * 8;
#pragma unroll
  for (int d0 = 0; d0 < 4; ++d0) qr[d0] = *reinterpret_cast<const bf16x8*>(Qw + d0 * 16);
  const int sr = tid >> 4, sc = (tid & 15) * 8, vst0 = v_st(sr, sc), vst1 = v_st(32 + sr, sc);
  const int vb0 = (int)(uintptr_t)V_lds + v_rd_base(lane);
  struct { bf16x8 vs0, vs1, ks0, ks1; } sr_[2];
#define SLOAD(i, k0) do { sr_[i].vs0 = *(const bf16x8*)(&Vh[(size_t)((k0) + sr) * LDK + sc]); sr_[i].vs1 = *(const bf16x8*)(&Vh[(size_t)((k0) + 32 + sr) * LDK + sc]); \
    sr_[i].ks0 = *(const bf16x8*)(&Kh[(size_t)((k0) + sr) * LDK + sc]); sr_[i].ks1 = *(const bf16x8*)(&Kh[(size_t)((k0) + 32 + sr) * LDK + sc]); } while (0)
#define SWRITE(bb, i) do { *(bf16x8*)(V_lds + (bb) * SHM_V + vst0) = sr_[i].vs0;          \
    *(bf16x8*)(V_lds + (bb) * SHM_V + vst1) = sr_[i].vs1; int kc = sc * 2;               \
    *(bf16x8*)(K_lds + (bb) * SHM_K + KSWZ(sr, kc)) = sr_[i].ks0;                       \
    *(bf16x8*)(K_lds + (bb) * SHM_K + KSWZ(32 + sr, kc)) = sr_[i].ks1; } while (0)
#define SWAIT() asm volatile("s_waitcnt vmcnt(4)" ::: "memory")
#define RESC(a) do { if (__any((a) < 1.f)) { if (hi == 0) al_l[r32] = (a); asm volatile("s_waitcnt lgkmcnt(0)" ::: "memory"); \
    _Pragma("unroll") for (int d = 0; d < 4; ++d) _Pragma("unroll") for (int r = 0; r < 16; ++r) o[d][r] *= al_l[crow(r, hi)]; } } while (0)
  f32x16 pA0, pA1, pB0, pB1; float mnA, mnB, alA, alB; bf16x8 pa0, pa1, pa2, pa3;
  constexpr int SE = 0, SO = 1;
  SLOAD(SE, 0); asm volatile("s_waitcnt vmcnt(0)" ::: "memory"); SWRITE(0, SE); __syncthreads();
  qkt(pA0, pA1, K_lds, qr, r32, hi, mp); partialSM(pA0, pA1, m_reg, mnA, alA);
  SLOAD(SO, KVBLK); SLOAD(SE, 2 * KVBLK);
  SWAIT(); SWRITE(1, SO); __syncthreads();
  for (int j = 1; j + 1 < NT; j += 2) {
    SBAR(); qkt(pB0, pB1, K_lds + SHM_K, qr, r32, hi, mp);
    finishSM(pA0, pA1, alA, l_reg, pa0, pa1, pa2, pa3); SBAR();
    SLOAD(SO, (j + 2) * KVBLK); SBAR();
    pv_d0(o, vb0, pa0, pa1, pa2, pa3); partialSM(pB0, pB1, m_reg, mnB, alB);
    __syncthreads(); SWAIT(); SWRITE(0, SE);
    RESC(alB); __syncthreads();
    SBAR(); qkt(pA0, pA1, K_lds, qr, r32, hi, mp);
    finishSM(pB0, pB1, alB, l_reg, pa0, pa1, pa2, pa3); SBAR();
    if (j + 3 < NT) SLOAD(SE, (j + 3) * KVBLK); SBAR();
    pv_d0(o, vb0 + SHM_V, pa0, pa1, pa2, pa3); partialSM(pA0, pA1, m_reg, mnA, alA);
    __syncthreads(); SWAIT(); SWRITE(1, SO);
    RESC(alA); __syncthreads();
  }
  SBAR(); qkt(pB0, pB1, K_lds + SHM_K, qr, r32, hi, mp);
  finishSM(pA0, pA1, alA, l_reg, pa0, pa1, pa2, pa3); SBAR();
  pv_d0(o, vb0, pa0, pa1, pa2, pa3); partialSM(pB0, pB1, m_reg, mnB, alB);
  __syncthreads(); RESC(alB);
  finishSM(pB0, pB1, alB, l_reg, pa0, pa1, pa2, pa3); SBAR();
  pv_d0(o, vb0 + SHM_V, pa0, pa1, pa2, pa3);
  if (hi == 0) li_l[r32] = l_reg; asm volatile("s_waitcnt lgkmcnt(0)" ::: "memory");
  float rli[16];
#pragma unroll
  for (int r = 0; r < 16; ++r) rli[r] = __builtin_amdgcn_rcpf(li_l[crow(r, hi)]);
  __syncthreads();
  { float* Ob = (float*)lds + (size_t)(mp * 128 + rg * 32) * 132;
#pragma unroll
    for (int r = 0; r < 16; ++r) { const int orow = crow(r, hi);
#pragma unroll
      for (int d0 = 0; d0 < 4; ++d0) Ob[orow * 132 + d0 * 32 + r32] = o[d0][r] * rli[r]; } }
  __syncthreads();
  { const int row = tid >> 2, q4 = tid & 3;
    const float* o0 = (const float*)lds + (size_t)row * 132 + q4 * 32; const float* o1 = o0 + 128 * 132;
    float d[32]; float ss = 0.f;
#pragma unroll
    for (int i = 0; i < 32; i += 4) { const f32x4 a = *(const f32x4*)(o0 + i), c = *(const f32x4*)(o1 + i);
#pragma unroll
      for (int q = 0; q < 4; ++q) { d[i + q] = a[q] - lam * c[q]; ss += d[i + q] * d[i + q]; } }
    ss += __shfl_xor(ss, 1); ss += __shfl_xor(ss, 2);
    const float rn = 0.8f / sqrtf(ss * (1.f / 128.f) + NORM_EPS);
    bf16_t* op = AX + ((size_t)(b * SEQ + qb * 128 + row)) * DM + h * 128 + q4 * 32; const float* gp = subg + q4 * 32;
#pragma unroll
    for (int i = 0; i < 32; i += 8) { u32x4 w;
      w.x = cvt_pk_bf16(d[i] * rn * gp[i], d[i + 1] * rn * gp[i + 1]); w.y = cvt_pk_bf16(d[i + 2] * rn * gp[i + 2], d[i + 3] * rn * gp[i + 3]);
      w.z = cvt_pk_bf16(d[i + 4] * rn * gp[i + 4], d[i + 5] * rn * gp[i + 5]); w.w = cvt_pk_bf16(d[i + 6] * rn * gp[i + 6], d[i + 7] * rn * gp[i + 7]);
      *(u32x4*)(op + i) = w; } }
  __syncthreads();
#undef SLOAD
#undef SWRITE
#undef SWAIT
#undef RESC
}
__device__ __forceinline__ void attn_phase(const Ctx& C, const float* subg, bf16_t* AXo, char* lds) {
  const bf16_t* Qg = (const bf16_t*)(C.ws + WS_Q); const bf16_t* Kall = (const bf16_t*)(C.ws + WS_K); const bf16_t* Vall = (const bf16_t*)(C.ws + WS_V);
  const float lam = *(const float*)(C.ws + WS_LAM);
  if (C.G == 256) { const int vcu = (C.bid & 7) * 32 + (C.bid >> 3);
    for (int i = 0; i < 8; ++i) { const int bh = (vcu >> 5) * 8 + i, qb = vcu & 31; attn_unit(Qg, Kall, Vall, AXo, lam, subg, bh >> 3, bh & 7, qb, lds); }
  } else {
    for (int L = C.bid; L < 2048; L += C.G) attn_unit(Qg, Kall, Vall, AXo, lam, subg, L >> 8, (L >> 5) & 7, L & 31, lds);
  }
}
#undef KSWZ
#undef SBAR
}
namespace hyn {
__device__ __forceinline__ float block_sum(float v, float* red, int tid) {
    v = wave_sum(v);
    __syncthreads();
    if ((tid & 63) == 0) red[tid >> 6] = v;
    __syncthreads();
    float s = 0.f;
#pragma unroll
    for (int i = 0; i < 8; ++i) s += red[i];
    return s;
}
__device__ __forceinline__ void build_kernel(const Params& p, const Ctx& C, int o, int c, float* kern, float* w3s, float* red) {
    const float* hdn = (const float*)(C.ws + WS_HDN); const float* w3 = p.in[I_FW3];
    __syncthreads();
    if (C.tid < 128) { const int dir = C.tid >> 6, k = C.tid & 63; w3s[C.tid] = w3[(size_t)k * 4096 + o * 2048 + dir * 1024 + c]; }
    __syncthreads();
    const float a = -3.0701134573253944f, bq = -15.350567286626972f;
    const float delta = fabsf(a + (float)c * ((bq - a) / 1023.f));
    float hf[8], hb[8]; float asum = 0.f;
#pragma unroll
    for (int j = 0; j < 8; ++j) { const int t = C.tid + 512 * j; const float* hr = hdn + t * 64; float sf = 0.f, sb = 0.f;
#pragma unroll 8
        for (int k = 0; k < 64; ++k) { const float hv = hr[k]; sf += hv * w3s[k]; sb += hv * w3s[64 + k]; }
        const float dec = expf(-((float)t * (1.f / 4095.f)) * delta);
        hf[j] = sf * dec; hb[j] = sb * dec; asum += fabsf(hf[j]) + (t > 0 ? fabsf(hb[j]) : 0.f); }
    const float tot = block_sum(asum, red, C.tid); const float inv = 1.f / tot;
#pragma unroll
    for (int j = 0; j < 8; ++j) { const int t = C.tid + 512 * j; kern[4096 + t] = hf[j] * inv; if (t > 0) kern[4096 - t] = hb[j] * inv; }
    if (C.tid == 0) kern[0] = 0.f;
    __syncthreads();
}
__device__ __forceinline__ void hyena_naive_phase(const Params& p, const Ctx& C, char* lds) {
    float* kern = (float*)lds;
    float* zb = (float*)(lds + 32768);
    float* w3s = (float*)(lds + 32768 + 65536);
    float* red = w3s + 128;
    const bf16_t* UT = (const bf16_t*)(C.ws + WS_UT); bf16_t* YX = (bf16_t*)(C.ws + WS_HX);
    const float* cw = p.in[I_HCW]; const float* cb = p.in[I_HCB]; const float* hyb = p.in[I_HYB];
    for (int unit = C.bid; unit < 2048; unit += C.G) {
        const int c = unit >> 1, bh = unit & 1;
        float vreg[8][4];
#pragma unroll
        for (int j = 0; j < 8; ++j) { const int t = C.tid + 512 * j;
#pragma unroll
            for (int bb = 0; bb < 4; ++bb) { const bf16_t* u = UT + ((size_t)(bh * 4 + bb) * 3072 + c) * SEQ;
                const float um = t > 0 ? bf2f(u[t - 1]) : 0.f, u0 = bf2f(u[t]), up = t < SEQ - 1 ? bf2f(u[t + 1]) : 0.f;
                vreg[j][bb] = um * cw[c] + u0 * cw[3072 + c] + up * cw[6144 + c] + cb[c]; } }
        for (int o = 0; o < 2; ++o) {
            build_kernel(p, C, o, c, kern, w3s, red);
#pragma unroll
            for (int j = 0; j < 8; ++j) { const int t = C.tid + 512 * j; *(f32x4*)(zb + t * 4) = (f32x4){vreg[j][0], vreg[j][1], vreg[j][2], vreg[j][3]}; }
            __syncthreads();
            float acc[8][4];
#pragma unroll
            for (int j = 0; j < 8; ++j)
#pragma unroll
                for (int bb = 0; bb < 4; ++bb) acc[j][bb] = 0.f;
            for (int s = 0; s < SEQ; ++s) { const f32x4 z4 = *(const f32x4*)(zb + s * 4);
#pragma unroll
                for (int j = 0; j < 8; ++j) { const float kv = kern[4096 + C.tid + 512 * j - s];
#pragma unroll
                    for (int bb = 0; bb < 4; ++bb) acc[j][bb] += kv * z4[bb]; } }
            const float bias = hyb[o * 1024 + c]; const int xc = (o + 1) * 1024 + c;
#pragma unroll
            for (int j = 0; j < 8; ++j) { const int t = C.tid + 512 * j;
#pragma unroll
                for (int bb = 0; bb < 4; ++bb) { const bf16_t* u = UT + ((size_t)(bh * 4 + bb) * 3072 + xc) * SEQ;
                    const float um = t > 0 ? bf2f(u[t - 1]) : 0.f, u0 = bf2f(u[t]), up = t < SEQ - 1 ? bf2f(u[t + 1]) : 0.f;
                    const float xg = um * cw[xc] + u0 * cw[3072 + xc] + up * cw[6144 + xc] + cb[xc];
                    vreg[j][bb] = xg * (acc[j][bb] + vreg[j][bb] * bias); } }
            __syncthreads();
        }
#pragma unroll
        for (int j = 0; j < 8; ++j) { const int t = C.tid + 512 * j;
#pragma unroll
            for (int bb = 0; bb < 4; ++bb) YX[((size_t)(bh * 4 + bb) * SEQ + t) * DM + c] = (bf16_t)(cvt_pk_bf16(vreg[j][bb], 0.f) & 0xffffu); }
    }
}
}
namespace hym {
constexpr size_t WS_TAB0 = WS_WIN;
constexpr size_t WS_TAB1 = 492 * MiB;
constexpr int ZBLK = 134, ZHS = ZBLK * 256, Z_BYTES = 2 * ZHS;
constexpr int KCS = 16448, KC_OFF = Z_BYTES, KC_BYTES = 4 * KCS, SCR_OFF = KC_OFF + KC_BYTES;
static_assert(SCR_OFF + 256 <= 147456, "hyena LDS");

__device__ __forceinline__ void table_phase(const Params& p, const Ctx& C, char* lds) {
    const float* hdn = (const float*)(C.ws + WS_HDN); const float* w3 = p.in[I_FW3];
    float* w3s = (float*)lds;
    float* red = w3s + 512;
    for (int unit = C.bid; unit < 512; unit += C.G) {
        const int o = unit >> 8, c0 = (unit & 255) * 4;
        __syncthreads();
        int tq = C.tid; asm volatile("" : "+v"(tq));
        { const int col = C.tid >> 6, k = C.tid & 63; const int dir = col >> 2, cc = col & 3; w3s[col * 64 + k] = w3[(size_t)k * 4096 + o * 2048 + dir * 1024 + c0 + cc]; }
        __syncthreads();
        float dl[4];
#pragma unroll
        for (int cc = 0; cc < 4; ++cc) { const float a = -3.0701134573253944f, bq = -15.350567286626972f; dl[cc] = fabsf(a + (float)(c0 + cc) * ((bq - a) / 1023.f)); }
        float h[8][8]; float asum[4] = {0.f, 0.f, 0.f, 0.f};
#pragma unroll
        for (int j = 0; j < 8; ++j) { const int t = tq + 512 * j; const float* hr = hdn + t * 64;
            float s[8];
#pragma unroll
            for (int q = 0; q < 8; ++q) s[q] = 0.f;
#pragma unroll 4
            for (int k4 = 0; k4 < 16; ++k4) { const f32x4 hv = *(const f32x4*)(hr + 4 * k4);
#pragma unroll
                for (int q = 0; q < 8; ++q) { const f32x4 wv = *(const f32x4*)(w3s + q * 64 + 4 * k4); s[q] += hv[0] * wv[0] + hv[1] * wv[1] + hv[2] * wv[2] + hv[3] * wv[3]; } }
            const float tn = (float)t * (1.f / 4095.f);
#pragma unroll
            for (int cc = 0; cc < 4; ++cc) { const float dec = expf(-tn * dl[cc]); h[j][cc] = s[cc] * dec; h[j][4 + cc] = s[4 + cc] * dec; asum[cc] += fabsf(h[j][cc]) + (t > 0 ? fabsf(h[j][4 + cc]) : 0.f); } }
#pragma unroll
        for (int cc = 0; cc < 4; ++cc) asum[cc] = wave_sum(asum[cc]);
        if (C.lane == 0) { red[C.wave * 4 + 0] = asum[0]; red[C.wave * 4 + 1] = asum[1]; red[C.wave * 4 + 2] = asum[2]; red[C.wave * 4 + 3] = asum[3]; }
        __syncthreads();
        float inv[4];
#pragma unroll
        for (int cc = 0; cc < 4; ++cc) { float s = 0.f;
#pragma unroll
            for (int w = 0; w < 8; ++w) s += red[w * 4 + cc];
            inv[cc] = 1.f / s; }
        bf16_t* tab = (bf16_t*)(C.ws + (o ? WS_TAB1 : WS_TAB0));
#pragma unroll
        for (int cc = 0; cc < 4; ++cc) { bf16_t* row = tab + (size_t)(c0 + cc) * 8192;
#pragma unroll
            for (int j = 0; j < 8; ++j) { const int t = tq + 512 * j;
                row[4096 - t] = (bf16_t)(cvt_pk_bf16(h[j][cc] * inv[cc], 0.f) & 0xffffu);
                if (t > 0) row[4096 + t] = (bf16_t)(cvt_pk_bf16(h[j][4 + cc] * inv[cc], 0.f) & 0xffffu); }
            if (C.tid == 0) row[0] = 0; }
    }
}

__device__ __forceinline__ int zaddr(int b, int t) {
    const int tp = t + 96, Jp = tp >> 5, g = (tp >> 3) & 3;
    return (b >> 2) * ZHS + Jp * 256 + ((((g ^ (Jp & 3)) << 2) | (b & 3)) << 4) + (tp & 7) * 2;
}
__device__ __forceinline__ void conv3_8(const bf16_t* urow, int t0, float w0, float w1, float w2, float bias, float (&out)[8]) {
    const u32x4 raw = *(const u32x4*)(urow + t0);
    float u[10];
    u[0] = t0 > 0 ? bf2f(urow[t0 - 1]) : 0.f; u[9] = (t0 + 8 < SEQ) ? bf2f(urow[t0 + 8]) : 0.f;
    u[1] = bflo(raw.x); u[2] = bfhi(raw.x); u[3] = bflo(raw.y); u[4] = bfhi(raw.y); u[5] = bflo(raw.z); u[6] = bfhi(raw.z); u[7] = bflo(raw.w); u[8] = bfhi(raw.w);
#pragma unroll
    for (int e = 0; e < 8; ++e) out[e] = u[e] * w0 + u[e + 1] * w1 + u[e + 2] * w2 + bias;
}
__device__ __forceinline__ u32x4 pack8f(const float (&v)[8]) { u32x4 w; w.x = cvt_pk_bf16(v[0], v[1]); w.y = cvt_pk_bf16(v[2], v[3]); w.z = cvt_pk_bf16(v[4], v[5]); w.w = cvt_pk_bf16(v[6], v[7]); return w; }

__device__ __forceinline__ void build_kc(const bf16_t* trow, char* lds, int tid) {
#pragma unroll
    for (int q = 0; q < 2; ++q) { const int m = tid + 512 * q;
        const u32x4 cur = *(const u32x4*)(trow + 8 * m); u32x4 prv = {0u, 0u, 0u, 0u}; if (m > 0) prv = *(const u32x4*)(trow + 8 * m - 8);
        const unsigned s2 = prv.z, s3 = prv.w, s4 = cur.x, s5 = cur.y, s6 = cur.z, s7 = cur.w;
        const u32x4 c0 = cur;
        const u32x4 c1 = {__builtin_amdgcn_alignbit(s4, s3, 16), __builtin_amdgcn_alignbit(s5, s4, 16), __builtin_amdgcn_alignbit(s6, s5, 16), __builtin_amdgcn_alignbit(s7, s6, 16)};
        const u32x4 c2 = {s3, s4, s5, s6};
        const u32x4 c3 = {__builtin_amdgcn_alignbit(s3, s2, 16), __builtin_amdgcn_alignbit(s4, s3, 16), __builtin_amdgcn_alignbit(s5, s4, 16), __builtin_amdgcn_alignbit(s6, s5, 16)};
        *(u32x4*)(lds + KC_OFF + 0 * KCS + 16 * m) = c0; *(u32x4*)(lds + KC_OFF + 1 * KCS + 16 * m) = c1;
        *(u32x4*)(lds + KC_OFF + 2 * KCS + 16 * m) = c2; *(u32x4*)(lds + KC_OFF + 3 * KCS + 16 * m) = c3; }
}

template <int OFF> __device__ __forceinline__ s16x4 lds_read_b64(unsigned addr) { s16x4 r; asm volatile("ds_read_b64 %0, %1 offset:%2" : "=&v"(r) : "v"(addr), "i"(OFF) : "memory"); return r; }
template <int OFF> __device__ __forceinline__ bf16x8 lds_read_b128(unsigned addr) { bf16x8 r; asm volatile("ds_read_b128 %0, %1 offset:%2" : "=&v"(r) : "v"(addr), "i"(OFF) : "memory"); return r; }
#define LGKM_WAIT0() asm volatile("s_waitcnt lgkmcnt(0)" ::: "memory")
#define HSB() __builtin_amdgcn_sched_barrier(0)
struct AFrag { s16x4 q[4]; };
struct WFrag { bf16x8 lo, hi; };
__device__ __forceinline__ bf16x8 cat4(const s16x4 a, const s16x4 b) { return (bf16x8){a[0], a[1], a[2], a[3], b[0], b[1], b[2], b[3]}; }
__device__ __forceinline__ void conv_loop(f32x16 (&acc)[4], const char* lds, int wave, int lane) {
    const int i = lane & 31, hh = lane >> 5, jj = (lane >> 3) & 3, bq = lane & 3, bhh = (lane >> 2) & 1;
    const int Xb = 16 * wave;
    const unsigned l0 = (unsigned)(uintptr_t)lds;
    const unsigned pz = l0 + bhh * ZHS + bq * 16;
#pragma unroll 1
    for (int dm = 0; dm < 4; ++dm) {
        const int dlo = Xb - 127 + ((dm - (Xb - 127)) & 3);
        const int cnt = (Xb + 15 - dlo) / 4 + 1;
        const int sw = (jj + 3 - dm) & 3;
        unsigned pB = l0 + bhh * ZHS + bq * 16 + (jj + 3) * 256 + (Xb - dlo) * 256;
        const unsigned o0 = ((hh) ^ sw) << 6, o1 = ((2 + hh) ^ sw) << 6;
        unsigned pA = l0 + KC_OFF + (i & 3) * KCS + 2 * (4096 - (i & ~3) + 8 * hh) - 64 * dlo;
        int J0 = Xb - dlo;
        AFrag A0, A1; WFrag W0, W1, W2, W3;
        W1.lo = W1.hi = W2.lo = W2.hi = W3.lo = W3.hi = (bf16x8){0, 0, 0, 0, 0, 0, 0, 0};
#define LOADW(W) do { const bool ok_ = (J0 >= -3 && J0 <= 127); const unsigned q0_ = ok_ ? pB + o0 : pz, q1_ = ok_ ? pB + o1 : pz; \
        W.lo = lds_read_b128<0>(q0_); W.hi = lds_read_b128<0>(q1_); pB -= 1024; J0 -= 4; } while (0)
#define LOADA(A) do { A.q[0] = lds_read_b64<0>(pA); A.q[1] = lds_read_b64<8>(pA); A.q[2] = lds_read_b64<32>(pA); A.q[3] = lds_read_b64<40>(pA); pA -= 256; } while (0)
#define MMA2(K, A, W) do { acc[K] = __builtin_amdgcn_mfma_f32_32x32x16_bf16(cat4(A.q[0], A.q[1]), W.lo, acc[K], 0, 0, 0); \
        acc[K] = __builtin_amdgcn_mfma_f32_32x32x16_bf16(cat4(A.q[2], A.q[3]), W.hi, acc[K], 0, 0, 0); } while (0)
#define STEP(A, AN, WK0, WK1, WK2, WK3, MORE) do { LGKM_WAIT0(); HSB(); MMA2(3, A, WK3); HSB(); \
        if (MORE) { LOADW(WK3); LOADA(AN); } HSB(); MMA2(2, A, WK2); MMA2(1, A, WK1); MMA2(0, A, WK0); HSB(); } while (0)
        LOADW(W0); LOADA(A0);
#pragma unroll 1
        for (int n = 0; n < cnt; n += 4) {
            STEP(A0, A1, W0, W3, W2, W1, (n + 1 < cnt));
            if (n + 1 < cnt) STEP(A1, A0, W1, W0, W3, W2, (n + 2 < cnt));
            if (n + 2 < cnt) STEP(A0, A1, W2, W1, W0, W3, (n + 3 < cnt));
            if (n + 3 < cnt) STEP(A1, A0, W3, W2, W1, W0, (n + 4 < cnt));
        }
        LGKM_WAIT0();
#undef LOADW
#undef LOADA
#undef MMA2
#undef STEP
    }
}

struct RowPre { u32x4 raw[8]; };
__device__ __forceinline__ void row_load(RowPre& r, const bf16_t* urow, int lane) {
#pragma unroll
    for (int ch = 0; ch < 8; ++ch) r.raw[ch] = *(const u32x4*)(urow + ch * 512 + lane * 8);
}
template <class F> __device__ __forceinline__ void row_conv_store(const RowPre& r, int lane, float w0, float w1, float w2, float bias, F dst) {
#pragma unroll
    for (int ch = 0; ch < 8; ++ch) {
        const unsigned lastv = r.raw[ch].w >> 16, firstv = r.raw[ch].x & 0xffffu;
        unsigned left = __shfl_up(lastv, 1), right = __shfl_down(firstv, 1);
        if (ch > 0) { const unsigned pl = __shfl(r.raw[ch - 1].w >> 16, 63); if (lane == 0) left = pl; } else if (lane == 0) left = 0u;
        if (ch < 7) { const unsigned nf = __shfl(r.raw[ch + 1].x & 0xffffu, 0); if (lane == 63) right = nf; } else if (lane == 63) right = 0u;
        float u[10]; u[0] = __uint_as_float(left << 16); u[9] = __uint_as_float(right << 16);
        u[1] = bflo(r.raw[ch].x); u[2] = bfhi(r.raw[ch].x); u[3] = bflo(r.raw[ch].y); u[4] = bfhi(r.raw[ch].y); u[5] = bflo(r.raw[ch].z); u[6] = bfhi(r.raw[ch].z); u[7] = bflo(r.raw[ch].w); u[8] = bfhi(r.raw[ch].w);
        float v[8];
#pragma unroll
        for (int e = 0; e < 8; ++e) v[e] = u[e] * w0 + u[e + 1] * w1 + u[e + 2] * w2 + bias;
        *(u32x4*)dst(ch) = pack8f(v);
    }
}
struct TabPre { u32x4 cur[2], prv[2]; };
__device__ __forceinline__ void tab_load(TabPre& t, const bf16_t* trow, int tid) {
#pragma unroll
    for (int q = 0; q < 2; ++q) { const int m = tid + 512 * q; t.cur[q] = *(const u32x4*)(trow + 8 * m); t.prv[q] = (u32x4){0u, 0u, 0u, 0u}; if (m > 0) t.prv[q] = *(const u32x4*)(trow + 8 * m - 8); }
}
__device__ __forceinline__ void tab_store(const TabPre& t, char* lds, int tid) {
#pragma unroll
    for (int q = 0; q < 2; ++q) { const int m = tid + 512 * q;
        const unsigned s2 = t.prv[q].z, s3 = t.prv[q].w, s4 = t.cur[q].x, s5 = t.cur[q].y, s6 = t.cur[q].z, s7 = t.cur[q].w;
        const u32x4 c1 = {__builtin_amdgcn_alignbit(s4, s3, 16), __builtin_amdgcn_alignbit(s5, s4, 16), __builtin_amdgcn_alignbit(s6, s5, 16), __builtin_amdgcn_alignbit(s7, s6, 16)};
        const u32x4 c2 = {s3, s4, s5, s6};
        const u32x4 c3 = {__builtin_amdgcn_alignbit(s3, s2, 16), __builtin_amdgcn_alignbit(s4, s3, 16), __builtin_amdgcn_alignbit(s5, s4, 16), __builtin_amdgcn_alignbit(s6, s5, 16)};
        *(u32x4*)(lds + KC_OFF + 0 * KCS + 16 * m) = t.cur[q]; *(u32x4*)(lds + KC_OFF + 1 * KCS + 16 * m) = c1;
        *(u32x4*)(lds + KC_OFF + 2 * KCS + 16 * m) = c2; *(u32x4*)(lds + KC_OFF + 3 * KCS + 16 * m) = c3; }
}

__device__ __forceinline__ void hyena_phase(const Params& p, const Ctx& C, char* lds) {
    const bf16_t* UT = (const bf16_t*)(C.ws + WS_UT); bf16_t* YXT = (bf16_t*)(C.ws + WS_HX);
    const bf16_t* TAB0 = (const bf16_t*)(C.ws + WS_TAB0); const bf16_t* TAB1 = (const bf16_t*)(C.ws + WS_TAB1);
    const float* cw = p.in[I_HCW]; const float* cb = p.in[I_HCB]; const float* hyb = p.in[I_HYB];
    const int lane = C.lane, wave = C.wave, tid = C.tid;
    __syncthreads();
    if (tid < 384) { const int bh = tid / 192, r = tid % 192, blk = r / 32, off = (r % 32) * 8; const int Jp = blk < 3 ? blk : 128 + blk;
        *(unsigned long long*)(lds + bh * ZHS + Jp * 256 + off) = 0ull; }
#ifdef PROBE_CONV2
    { float keep = 0.f;
#pragma unroll 1
      for (int rep = 0; rep < 8; ++rep) { f32x16 acc2[4];
#pragma unroll
        for (int k = 0; k < 4; ++k) acc2[k] = f32x16{};
        conv_loop(acc2, lds, wave, lane);
#pragma unroll
        for (int k = 0; k < 4; ++k)
#pragma unroll
          for (int r = 0; r < 16; ++r) keep += acc2[k][r];
        __syncthreads(); }
      if (keep == 12345.678f) *(float*)(C.ws + WS_LAM + 64) = keep; }
#endif
    RowPre rp; TabPre tp;
    int c = C.bid;
    if (c < 1024) { row_load(rp, UT + ((size_t)wave * 3072 + c) * SEQ, lane); tab_load(tp, TAB0 + (size_t)c * 8192, tid); }
#pragma unroll 1
    for (; c < 1024; c += C.G) {
        __syncthreads();
        row_conv_store(rp, lane, cw[c], cw[3072 + c], cw[6144 + c], cb[c], [&](int ch) { return lds + zaddr(wave, ch * 512 + lane * 8); });
        tab_store(tp, lds, tid);
        __syncthreads();
#pragma unroll 1
        for (int o = 0; o < 2; ++o) {
            const int xc = (o + 1) * 1024 + c;
            row_load(rp, UT + ((size_t)wave * 3072 + xc) * SEQ, lane);
            __builtin_amdgcn_sched_barrier(0);
            f32x16 acc[4];
#pragma unroll
            for (int k = 0; k < 4; ++k) acc[k] = f32x16{};
            conv_loop(acc, lds, wave, lane);
            __syncthreads();
            row_conv_store(rp, lane, cw[xc], cw[3072 + xc], cw[6144 + xc], cb[xc], [&](int ch) { return lds + KC_OFF + wave * 8192 + (ch * 512 + lane * 8) * 2; });
            if (o == 0) tab_load(tp, TAB1 + (size_t)c * 8192, tid);
            else if (c + C.G < 1024) { row_load(rp, UT + ((size_t)wave * 3072 + c + C.G) * SEQ, lane); tab_load(tp, TAB0 + (size_t)(c + C.G) * 8192, tid); }
            __syncthreads();
            const float bias = hyb[o * 1024 + c];
            int lb = lane; asm volatile("" : "+v"(lb));
            const int b = lb & 7, jj = (lb >> 3) & 3, hi = lb >> 5, sw = (jj + 3) & 3;
            const int zb = (b >> 2) * ZHS + (16 * wave + jj + 3) * 256 + ((b & 3) << 4) + 8 * hi;
            const int xb = KC_OFF + b * 8192 + 64 * (16 * wave + jj) + 8 * hi;
            bf16_t* yb = YXT + ((size_t)b * 1024 + c) * SEQ + 32 * (16 * wave + jj) + 4 * hi;
#pragma unroll
            for (int g = 0; g < 4; ++g) { const int zg = zb + ((g ^ sw) << 6);
#pragma unroll
                for (int k = 0; k < 4; ++k) {
                    u32x2* zp = (u32x2*)(lds + zg + k * 1024);
                    const u32x2 zw = *zp, xw = *(const u32x2*)(lds + xb + k * 256 + 16 * g);
                    const float v0 = bflo(xw.x) * (acc[k][4 * g + 0] + bflo(zw.x) * bias), v1 = bfhi(xw.x) * (acc[k][4 * g + 1] + bfhi(zw.x) * bias);
                    const float v2 = bflo(xw.y) * (acc[k][4 * g + 2] + bflo(zw.y) * bias), v3 = bfhi(xw.y) * (acc[k][4 * g + 3] + bfhi(zw.y) * bias);
                    u32x2 ow; ow.x = cvt_pk_bf16(v0, v1); ow.y = cvt_pk_bf16(v2, v3);
                    if (o == 0) *zp = ow; else *(u32x2*)(yb + 128 * k + 8 * g) = ow; } }
            if (o == 0) { __syncthreads(); tab_store(tp, lds, tid); __syncthreads(); }
        }
    }
}

constexpr size_t WS_YX2 = WS_UT;
__device__ __forceinline__ void yx_transpose_phase(const Ctx& C, char* lds) {
    const bf16_t* YXT = (const bf16_t*)(C.ws + WS_HX); bf16_t* YX = (bf16_t*)(C.ws + WS_YX2);
    bf16_t* scr = (bf16_t*)(lds + C.wave * 16384);
    const int gw = C.bid * 8 + C.wave, NGW = C.G * 8, lane = C.lane, r8 = lane >> 3, ch = lane & 7;
    for (int tile = gw; tile < 8 * 16 * 64; tile += NGW) {
        const int b = tile >> 10, c0 = ((tile >> 6) & 15) * 64, t0 = (tile & 63) * 64;
#pragma unroll
        for (int i = 0; i < 8; ++i) { const int cr = i * 8 + r8; const u32x4 v = *(const u32x4*)(YXT + ((size_t)b * 1024 + c0 + cr) * SEQ + t0 + 8 * ch);
            bf16_t* sp = scr + (8 * ch) * 72 + cr;
            sp[0 * 72] = (bf16_t)(v.x & 0xffffu); sp[1 * 72] = (bf16_t)(v.x >> 16); sp[2 * 72] = (bf16_t)(v.y & 0xffffu); sp[3 * 72] = (bf16_t)(v.y >> 16);
            sp[4 * 72] = (bf16_t)(v.z & 0xffffu); sp[5 * 72] = (bf16_t)(v.z >> 16); sp[6 * 72] = (bf16_t)(v.w & 0xffffu); sp[7 * 72] = (bf16_t)(v.w >> 16); }
        asm volatile("s_waitcnt lgkmcnt(0)" ::: "memory");
#pragma unroll
        for (int i = 0; i < 8; ++i) { const int tr = i * 8 + r8; const u32x4 v = *(const u32x4*)(scr + tr * 72 + 8 * ch);
            *(u32x4*)(YX + ((size_t)b * SEQ + t0 + tr) * DM + c0 + 8 * ch) = v; }
        asm volatile("s_waitcnt lgkmcnt(0)" ::: "memory");
    }
}
}
namespace moe {
__device__ __forceinline__ void route_phase(const Params& p, const Ctx& C, const float* xnew, char* lds) {
    const float* mod = (const float*)(C.ws + WS_MOD); const float* g = p.in[I_N2G]; const float* rw = p.in[I_RW]; const float* rb = p.in[I_RB];
    bf16_t* HX2 = (bf16_t*)(C.ws + WS_HX); int* eidx = (int*)(C.ws + WS_EIDX); float* wsel = (float*)(C.ws + WS_WSEL); int* counts = (int*)(C.ws + WS_CNT);
    float* hb = (float*)(lds + C.wave * 16384);
    int* hist = (int*)(lds + 8 * 16384);
    if (C.tid < 64) hist[C.tid] = 0;
    __syncthreads();
    const int gw = C.bid * 8 + C.wave, NGW = C.G * 8, lane = C.lane;
    const float bias = rb[lane];
    for (int grp = gw; grp < NTOK / 4; grp += NGW) {
        const int tok0 = grp * 4; const int b = tok0 >> 12;
        const float* sh = mod + b * 6144 + 3072; const float* sc = sh + 1024;
        f32x4 v[4][4];
#pragma unroll
        for (int i = 0; i < 4; ++i) { const float* xr = xnew + (size_t)(tok0 + i) * DM; float ss = 0.f;
#pragma unroll
            for (int j = 0; j < 4; ++j) { v[i][j] = *(const f32x4*)(xr + 256 * j + 4 * lane); ss += (v[i][j].x * v[i][j].x + v[i][j].y * v[i][j].y) + (v[i][j].z * v[i][j].z + v[i][j].w * v[i][j].w); }
            const float rn = 1.0f / sqrtf(wave_sum(ss) * (1.f / DM) + NORM_EPS);
#pragma unroll
            for (int j = 0; j < 4; ++j) { const int k = 256 * j + 4 * lane;
                const f32x4 gv = *(const f32x4*)(g + k), scv = *(const f32x4*)(sc + k), shv = *(const f32x4*)(sh + k);
                v[i][j] = v[i][j] * rn * gv * (1.f + scv) + shv;
                u32x2 w; w.x = cvt_pk_bf16(v[i][j].x, v[i][j].y); w.y = cvt_pk_bf16(v[i][j].z, v[i][j].w);
                *(u32x2*)(HX2 + (size_t)(tok0 + i) * DM + k) = w; } }
#pragma unroll
        for (int j = 0; j < 4; ++j)
#pragma unroll
            for (int e = 0; e < 4; ++e) { const int k = 256 * j + 4 * lane + e; *(f32x4*)(hb + k * 4) = (f32x4){v[0][j][e], v[1][j][e], v[2][j][e], v[3][j][e]}; }
        asm volatile("s_waitcnt lgkmcnt(0)" ::: "memory");
        float acc[4] = {0.f, 0.f, 0.f, 0.f};
#pragma unroll 8
        for (int k = 0; k < DM; ++k) { const float w = rw[k * 64 + lane]; const f32x4 h4 = *(const f32x4*)(hb + k * 4);
            acc[0] += h4[0] * w; acc[1] += h4[1] * w; acc[2] += h4[2] * w; acc[3] += h4[3] * w; }
#pragma unroll
        for (int i = 0; i < 4; ++i) {
            const float s = 1.f / (1.f + expf(-acc[i])); const float ch = s + bias;
            float m1 = ch; m1 = fmaxf(m1, __shfl_xor(m1, 1)); m1 = fmaxf(m1, __shfl_xor(m1, 2)); m1 = fmaxf(m1, __shfl_xor(m1, 4));
            const unsigned long long eq = __ballot(ch == m1); const int gidx = lane >> 3; const unsigned gm = (unsigned)(eq >> (8 * gidx)) & 0xffu; const int first = __builtin_ctz(gm);
            float c2 = ((lane & 7) == first) ? -INFINITY : ch;
            float m2 = c2; m2 = fmaxf(m2, __shfl_xor(m2, 1)); m2 = fmaxf(m2, __shfl_xor(m2, 2)); m2 = fmaxf(m2, __shfl_xor(m2, 4));
            const float gs = m1 + m2; int grank = 0;
#pragma unroll
            for (int g2 = 0; g2 < 8; ++g2) { const float ov = __shfl(gs, 8 * g2); grank += (ov > gs || (ov == gs && g2 < gidx)) ? 1 : 0; }
            const bool gsel = grank < 4; const float mc = gsel ? ch : -INFINITY; int rank = 0;
#pragma unroll 16
            for (int e2 = 0; e2 < 64; ++e2) { const float ov = __shfl(mc, e2); rank += (ov > mc || (ov == mc && e2 < lane)) ? 1 : 0; }
            const bool sel = gsel && rank < 8;
            const float tot = wave_sum(sel ? s : 0.f);
            if (sel) { eidx[(tok0 + i) * 8 + rank] = lane; wsel[(tok0 + i) * 8 + rank] = s / tot * 2.5f; atomicAdd(&hist[lane], 1); }
        }
    }
    __syncthreads();
    if (C.tid < 64 && hist[C.tid] > 0) atomicAdd(&counts[C.tid], hist[C.tid]);
}

__device__ __forceinline__ void place_phase(const Ctx& C, char* lds) {
    int* counts = (int*)(C.ws + WS_CNT); int* cursor = counts + 64; int* ntp = counts + 128; int* tile_e = (int*)(C.ws + WS_TILEE);
    int* row_tok = (int*)(C.ws + WS_ROWTOK); int* pos = (int*)(C.ws + WS_POS); const int* eidx = (const int*)(C.ws + WS_EIDX);
    int* pst = (int*)lds;
    int* lh = pst + 80;
    int* lbase = lh + 64;
    if (C.tid == 0) { int a = 0; for (int e = 0; e < 64; ++e) { pst[e] = a; const int cnt = __hip_atomic_load(counts + e, __ATOMIC_RELAXED, __HIP_MEMORY_SCOPE_AGENT); a += (cnt + 255) / 256 * 256; } pst[64] = a; }
    __syncthreads();
    const int P = pst[64];
    if (C.bid == 0) {
        if (C.tid == 0) *ntp = P / 256 + 128;
        for (int t = C.tid; t < P / 256 + 128; t += 512) { int e = 64; const int r = t * 256; if (r < P) { e = 0; while (pst[e + 1] <= r) ++e; } tile_e[t] = e; }
    }
    for (int chunk = C.bid; chunk < NTOK / 128; chunk += C.G) {
        if (C.tid < 64) lh[C.tid] = 0;
        __syncthreads();
        int e_[2], lr_[2];
#pragma unroll
        for (int q = 0; q < 2; ++q) { const int a = C.tid + 512 * q; const int tok = chunk * 128 + (a >> 3); e_[q] = eidx[tok * 8 + (a & 7)]; lr_[q] = atomicAdd(&lh[e_[q]], 1); }
        __syncthreads();
        if (C.tid < 64) lbase[C.tid] = lh[C.tid] > 0 ? atomicAdd(&cursor[C.tid], lh[C.tid]) : 0;
        __syncthreads();
#pragma unroll
        for (int q = 0; q < 2; ++q) { const int a = C.tid + 512 * q; const int tok = chunk * 128 + (a >> 3); const int dest = pst[e_[q]] + lbase[e_[q]] + lr_[q]; row_tok[dest] = tok; pos[tok * 8 + (a & 7)] = dest; }
        __syncthreads();
    }
    for (int tok = C.bid * 512 + C.tid; tok < NTOK; tok += C.G * 512) row_tok[P + tok] = tok;
}

struct MoeOrder {
    const int* tile_e; int NT, G, c, NJ, PNE, colq;
    __device__ bool next(int i, pg8::Unit& u) const {
        const long L = (long)i * G + c; if (L >= (long)NT * NJ) return false;
        const int t = (int)(L / NJ), j = (int)(L % NJ);
        u.pm = t; u.pn = __hip_atomic_load(tile_e + t, __ATOMIC_RELAXED, __HIP_MEMORY_SCOPE_AGENT) * PNE + (NJ == 2 ? j : colq); return true;
    }
};

template <bool LAST>
__device__ __forceinline__ void combine_phase(const Params& p, const Ctx& C, int q) {
    const float* mod = (const float*)(C.ws + WS_MOD); const bf16_t* Y = (const bf16_t*)(C.ws + WS_Y);
    const int* pos = (const int*)(C.ws + WS_POS); const float* wsel = (const float*)(C.ws + WS_WSEL);
    const int NT = __hip_atomic_load((const int*)(C.ws + WS_CNT) + 128, __ATOMIC_RELAXED, __HIP_MEMORY_SCOPE_AGENT); const int P = (NT - 128) * 256;
    float* out = p.out; const float* fg = p.in[I_FNG];
    const int gw = C.bid * 8 + C.wave, NGW = C.G * 8, lane = C.lane;
    for (int tok = gw; tok < NTOK; tok += NGW) {
        const int b = tok >> 12; const float* g2 = mod + b * 6144 + 5120 + 256 * q + 4 * lane;
        f32x4 a = {0.f, 0.f, 0.f, 0.f};
#pragma unroll
        for (int k = 0; k < 8; ++k) { const int r = pos[tok * 8 + k]; const float w = wsel[tok * 8 + k]; const u32x2 y = *(const u32x2*)(Y + (size_t)r * 256 + 4 * lane);
            a[0] += w * bflo(y.x); a[1] += w * bfhi(y.x); a[2] += w * bflo(y.y); a[3] += w * bfhi(y.y); }
        { const u32x2 y = *(const u32x2*)(Y + (size_t)(P + tok) * 256 + 4 * lane); a[0] += bflo(y.x); a[1] += bfhi(y.x); a[2] += bflo(y.y); a[3] += bfhi(y.y); }
        float* op = out + (size_t)tok * DM;
        const f32x4 xo = *(const f32x4*)(op + 256 * q + 4 * lane); const f32x4 gv = *(const f32x4*)g2;
        const f32x4 xn = xo + gv * a;
        if (!LAST) { *(f32x4*)(op + 256 * q + 4 * lane) = xn; }
        else {
            f32x4 v[4]; float ss = 0.f;
#pragma unroll
            for (int j = 0; j < 4; ++j) { v[j] = (j == 3) ? xn : *(const f32x4*)(op + 256 * j + 4 * lane); ss += (v[j].x * v[j].x + v[j].y * v[j].y) + (v[j].z * v[j].z + v[j].w * v[j].w); }
            const float rn = 1.0f / sqrtf(wave_sum(ss) * (1.f / DM) + NORM_EPS);
#pragma unroll
            for (int j = 0; j < 4; ++j) { const f32x4 gq = *(const f32x4*)(fg + 256 * j + 4 * lane); *(f32x4*)(op + 256 * j + 4 * lane) = v[j] * rn * gq; }
        }
    }
}
}
#define XB_TMO      128
#define XB_XCNT(j)  (256  + 64 * (j))
#define XB_XSUB(j)  (1280 + 64 * (j))
#define XB_XGEN(j)  (2304 + 64 * (j))
#define XB_TOP      3328
#define XB_TOPGEN   3392
#define XCD_BAR_WORDS 3456
#define XB_SPIN_CAP (1u << 21)

__device__ __forceinline__ unsigned xb_ld(unsigned* p)              { return __hip_atomic_load(p, __ATOMIC_RELAXED, __HIP_MEMORY_SCOPE_AGENT); }
__device__ __forceinline__ unsigned xb_add(unsigned* p, unsigned v) { return __hip_atomic_fetch_add(p, v, __ATOMIC_RELAXED, __HIP_MEMORY_SCOPE_AGENT); }
__device__ __forceinline__ unsigned xb_xcc_id() { return (unsigned)__builtin_amdgcn_s_getreg((3 << 11) | 20) & 0xFu; }
#define XB_SPIN(cond, bar) do { unsigned _sp = 0; while (cond) { __builtin_amdgcn_s_sleep(1); \
    if ((++_sp & 255u) == 0u) { if (xb_ld(&(bar)[XB_TMO])) break; if (_sp > XB_SPIN_CAP) { atomicAdd(&(bar)[XB_TMO], 1u); break; } } } } while (0)

struct XcdBarrier {
    unsigned* bar; unsigned x;
    volatile LAS unsigned* st;
};

__device__ __forceinline__ XcdBarrier xcd_barrier_post(unsigned* bar, volatile LAS unsigned* st) {
    XcdBarrier b; b.bar = bar; b.x = xb_xcc_id(); b.st = st;
    if (threadIdx.x == 0) (void)xb_add(&bar[XB_XCNT(b.x)], 1u);
    return b;
}
__device__ __forceinline__ void xcd_barrier_complete(unsigned* bar, unsigned x, unsigned& nloc, unsigned& nx) {
    const unsigned G = gridDim.x * gridDim.y * gridDim.z;
    unsigned sum, cnt, mine, sp = 0u;
    for (;;) {
        sum = 0u; cnt = 0u; mine = 0u;
#pragma unroll
        for (unsigned j = 0; j < 16; ++j) { const unsigned c = xb_ld(&bar[XB_XCNT(j)]); sum += c; cnt += (c > 0u) ? 1u : 0u; mine = (j == x) ? c : mine; }
        if (sum == G) break;
        __builtin_amdgcn_s_sleep(1);
        if ((++sp & 255u) == 0u) { if (xb_ld(&bar[XB_TMO])) break; if (sp > XB_SPIN_CAP) { atomicAdd(&bar[XB_TMO], 1u); break; } }
    }
    nloc = mine > 0u ? mine : 1u; nx = cnt > 0u ? cnt : 1u;
}

__device__ __forceinline__ void xcd_barrier(const XcdBarrier& b) {
    asm volatile("s_waitcnt vmcnt(0)" ::: "memory");
    __syncthreads();
    if (threadIdx.x == 0) {
        unsigned* bar = b.bar;
        __builtin_amdgcn_s_waitcnt(0);
        unsigned nloc = b.st[0], nx = b.st[1];
        if (nloc == 0u) { xcd_barrier_complete(bar, b.x, nloc, nx); b.st[0] = nloc; b.st[1] = nx; }
        const unsigned old = xb_add(&bar[XB_XSUB(b.x)], 1u);
        const unsigned gen = old / nloc;
        if (old + 1u == (gen + 1u) * nloc) {
            __builtin_amdgcn_fence(__ATOMIC_RELEASE, "agent");
            asm volatile("s_waitcnt vmcnt(0)" ::: "memory");
            const unsigned og = xb_add(&bar[XB_TOP], 1u);
            const unsigned tg = og / nx;
            if (og + 1u == (tg + 1u) * nx) xb_add(&bar[XB_TOPGEN], 1u);
            else XB_SPIN(xb_ld(&bar[XB_TOPGEN]) == tg, bar);
            __builtin_amdgcn_fence(__ATOMIC_ACQUIRE, "agent");
            xb_add(&bar[XB_XGEN(b.x)], 1u);
            asm volatile("s_waitcnt vmcnt(0)" ::: "memory");
        } else {
            XB_SPIN(xb_ld(&bar[XB_XGEN(b.x)]) == gen, bar);
            __builtin_amdgcn_fence(__ATOMIC_ACQUIRE, "agent");
            asm volatile("s_waitcnt vmcnt(0)" ::: "memory");
        }
    }
    __syncthreads();
}

constexpr int LDS_BYTES = 147456;
struct InProjOrder {
    pg8::StaticOrder so; int G, c;
    __device__ bool next(int i, pg8::Unit& u) const {
        const long L = (long)i * G + c;
        if (L < 4096) return so.next(i, u);
        const int r = (int)(L - 4096); if (r >= 64) return false;
        u.pm = 128 + r / 8; u.pn = r % 8; return true;
    }
};

template <int PH> __device__ __forceinline__ void run_phase(const Params& p, unsigned char* lds_) {
    int tid_ = threadIdx.x; asm volatile("" : "+v"(tid_));
    Ctx C; C.tid = tid_; C.lane = C.tid & 63; C.wave = __builtin_amdgcn_readfirstlane(C.tid >> 6); C.G = gridDim.x; C.bid = blockIdx.x; C.ws = p.ws;
    char* lds = (char*)lds_; LAS unsigned char* ldsl = (LAS unsigned char*)lds_;
    unsigned char* ws = C.ws;
    if constexpr (PH == 0) { adaln_phase(p, C, lds); __syncthreads(); wconv_mixer_phase(p, C, lds); hdn_phase(p, C); }
    else if constexpr (PH == 1) { hx_phase(p, C); }
    else if constexpr (PH == 2) {
        pg8::Gemm g{(const bf16_t*)(ws + WS_HX), (const bf16_t*)(ws + WS_WIN), 1024, nullptr};
        InProjOrder S; S.so.init(NTOK, INW, C.G, C.bid); S.G = C.G; S.c = C.bid;
        epi::InProj E{(bf16_t*)(ws + WS_Q), (bf16_t*)(ws + WS_K), (bf16_t*)(ws + WS_V), (bf16_t*)(ws + WS_UT), (bf16_t*)p.out};
        pg8::gemm_phase<epi::InProj, InProjOrder, false>(ldsl, g, S, E);
    }
    else if constexpr (PH == 3) { att::attn_phase(C, p.in[I_SUBG], (bf16_t*)(C.ws + WS_Q), lds); }
    else if constexpr (PH == 22) { att::attn_phase(C, p.in[I_SUBG], (bf16_t*)(C.ws + WS_HX), lds); }
    else if constexpr (PH == 4) { hym::hyena_phase(p, C, lds); }
    else if constexpr (PH == 20) { hym::table_phase(p, C, lds); }
    else if constexpr (PH == 21) { hyn::hyena_naive_phase(p, C, lds); }
    else if constexpr (PH == 5) { hym::yx_transpose_phase(C, lds); __syncthreads(); wconv_moe_phase(p, C, lds); }
    else if constexpr (PH == 6) {
        pg8::Gemm g{(const bf16_t*)(ws + WS_Q), (const bf16_t*)(ws + WS_WPA), 1024, nullptr};
        pg8::StaticOrder S; S.init(NTOK, DM, C.G, C.bid);
        epi::Merge<0> E{(const bf16_t*)p.out, (bf16_t*)(ws + WS_K)};
        pg8::gemm_phase<epi::Merge<0>, pg8::StaticOrder, false>(ldsl, g, S, E);
    }
    else if constexpr (PH == 7) {
        pg8::Gemm g{(const bf16_t*)(ws + hym::WS_YX2), (const bf16_t*)(ws + WS_WPH), 1024, nullptr};
        pg8::StaticOrder S; S.init(NTOK, DM, C.G, C.bid);
        epi::Merge<1> E{(const bf16_t*)p.out, (bf16_t*)(ws + WS_K)};
        pg8::gemm_phase<epi::Merge<1>, pg8::StaticOrder, false>(ldsl, g, S, E);
    }
    else if constexpr (PH == 8) {
        pg8::Gemm g{(const bf16_t*)(ws + WS_K), (const bf16_t*)(ws + WS_WOUT), 1024, nullptr};
        pg8::StaticOrder S; S.init(NTOK, DM, C.G, C.bid);
        epi::OutProj E{p.in[I_X], (const float*)(ws + WS_MOD), p.out};
        pg8::gemm_phase<epi::OutProj, pg8::StaticOrder, false>(ldsl, g, S, E);
    }
    else if constexpr (PH == 9) { moe::route_phase(p, C, p.out, lds); }
    else if constexpr (PH == 10) { moe::place_phase(C, lds); }
    else if constexpr (PH == 11) {
        const int NT = __hip_atomic_load((const int*)(ws + WS_CNT) + 128, __ATOMIC_RELAXED, __HIP_MEMORY_SCOPE_AGENT);
        pg8::Gemm g{(const bf16_t*)(ws + WS_HX), (const bf16_t*)(ws + WS_WGU), 1024, (const int*)(ws + WS_ROWTOK)};
        moe::MoeOrder S{(const int*)(ws + WS_TILEE), NT, C.G, C.bid, 2, 2, 0};
        epi::SwiGLU E{(bf16_t*)(ws + WS_H)};
        pg8::gemm_phase<epi::SwiGLU, moe::MoeOrder, true>(ldsl, g, S, E);
    }
    else if constexpr (PH >= 12 && PH < 20 && (PH & 1) == 0) {
        constexpr int q = (PH - 12) / 2;
        const int NT = __hip_atomic_load((const int*)(ws + WS_CNT) + 128, __ATOMIC_RELAXED, __HIP_MEMORY_SCOPE_AGENT);
        pg8::Gemm g{(const bf16_t*)(ws + WS_H), (const bf16_t*)(ws + WS_WD), 256, nullptr};
        moe::MoeOrder S{(const int*)(ws + WS_TILEE), NT, C.G, C.bid, 1, 4, q};
        epi::Down E{(bf16_t*)(ws + WS_Y)};
        pg8::gemm_phase<epi::Down, moe::MoeOrder, false>(ldsl, g, S, E);
    }
    else if constexpr (PH >= 12 && PH < 20 && (PH & 1) == 1) {
        constexpr int q = (PH - 13) / 2;
        moe::combine_phase<q == 3>(p, C, q);
    }
}


__global__ void __launch_bounds__(512, 2) mega_fwd(Params p) {
    extern __shared__ __attribute__((aligned(16))) unsigned char lds[];
    cg::grid_group grid = cg::this_grid();
    volatile LAS unsigned* xst = (volatile LAS unsigned*)((LAS unsigned char*)lds + LDS_BYTES - 16);
    if (threadIdx.x < 4) xst[threadIdx.x] = 0u;
    __syncthreads();
    const XcdBarrier xbar = xcd_barrier_post((unsigned*)(p.ws + WS_BAR), xst);
#define GSYNC() xcd_barrier(xbar)
    run_phase<0>(p, lds); grid.sync();
#ifdef PROBE_REP0
    run_phase<0>(p, lds); GSYNC();
#endif
    run_phase<1>(p, lds); GSYNC();
#ifdef PROBE_REP1
    run_phase<1>(p, lds); GSYNC();
#endif
    run_phase<2>(p, lds); GSYNC();
#ifdef PROBE_REP2
    run_phase<2>(p, lds); GSYNC();
#endif
    run_phase<20>(p, lds); GSYNC();
#ifdef PROBE_REP3
    run_phase<22>(p, lds); __syncthreads();
#endif
    run_phase<3>(p, lds); __syncthreads();
    run_phase<4>(p, lds); GSYNC();
#ifdef PROBE_REP4
    run_phase<4>(p, lds); GSYNC();
#endif
    run_phase<5>(p, lds); __syncthreads();
    run_phase<6>(p, lds); GSYNC();
#ifdef PROBE_REP6
    run_phase<6>(p, lds); GSYNC();
#endif
    run_phase<7>(p, lds); GSYNC();
    run_phase<8>(p, lds); GSYNC();
#ifdef PROBE_REP9
    run_phase<23>(p, lds); GSYNC();
#endif
    run_phase<9>(p, lds); GSYNC();
    run_phase<10>(p, lds); GSYNC();
    run_phase<11>(p, lds); GSYNC();
#ifdef PROBE_REP11
    run_phase<11>(p, lds); GSYNC();
#endif
    run_phase<12>(p, lds); GSYNC();
#ifdef PROBE_REP12
    run_phase<12>(p, lds); GSYNC();
#endif
    run_phase<13>(p, lds); GSYNC();
    run_phase<14>(p, lds); GSYNC();
    run_phase<15>(p, lds); GSYNC();
    run_phase<16>(p, lds); GSYNC();
    run_phase<17>(p, lds); GSYNC();
    run_phase<18>(p, lds); GSYNC();
#ifdef PROBE_SYNC20
    for (int i = 0; i < 20; ++i) GSYNC();
#endif
    run_phase<19>(p, lds);
}

extern "C" void kernel_launch(void* const* d_in, const int* in_sizes, int n_in, void* d_out, int out_size, void* d_ws, size_t ws_size, hipStream_t stream) {
    static int grid = 0;
    if (grid == 0) {
        if (n_in != 35 || out_size != NTOK * DM || ws_size < WS_END) { fprintf(stderr, "kernel_launch: unexpected shapes: n_in %d out %d ws %zu\n", n_in, out_size, ws_size); grid = -1; return; }
        int dev = 0, cus = 0, per_cu = 0; (void)hipGetDevice(&dev); (void)hipDeviceGetAttribute(&cus, hipDeviceAttributeMultiprocessorCount, dev);
        if (hipFuncSetAttribute((const void*)mega_fwd, hipFuncAttributeMaxDynamicSharedMemorySize, LDS_BYTES) != hipSuccess) { fprintf(stderr, "kernel_launch: hipFuncSetAttribute failed\n"); grid = -1; return; }
        if (hipOccupancyMaxActiveBlocksPerMultiprocessor(&per_cu, (const void*)mega_fwd, 512, LDS_BYTES) != hipSuccess || per_cu < 1) { fprintf(stderr, "kernel_launch: occupancy query failed (%d)\n", per_cu); grid = -1; return; }
        grid = cus * 1;
    }
    if (grid < 0) return;
    Params p{};
    for (int i = 0; i < 35; ++i) p.in[i] = (const float*)d_in[i];
    p.out = (float*)d_out; p.ws = (unsigned char*)d_ws;
    (void)hipMemsetAsync((char*)d_ws + WS_ZERO, 0, WS_ZERO_BYTES, stream);
    void* args[] = {&p};
    hipError_t e = hipLaunchCooperativeKernel((const void*)mega_fwd, dim3(grid), dim3(512), args, LDS_BYTES, stream);
    if (e != hipSuccess) fprintf(stderr, "cooperative launch failed: %s (grid %d)\n", hipGetErrorString(e), grid);
}
```
